# Optimizing an MI355X kernel written in HIP

```python
import jax
import jax.numpy as jnp
from jax import lax
import numpy as np

D_MODEL = 1024
BATCH = 4
SEQ = 4096
DEPTH = 2

CTX_LEN = 256
GRID_W = 64
ROPE_BASE = 10000.0
EPS = 1e-6
HALF = 0.5
N_MOD = 9
D_FF = 2816

A_HEADS = 4
A_DK = 32
A_DV = 64
A_CHUNK = 64
B_HEADS = 6
B_Q_RANK = 256
B_KV_RANK = 128
B_NOPE = 64
B_ROPE = 32
B_DV = 64
B_DQK = B_NOPE + B_ROPE
B_SCALE = B_DQK ** -0.5
DENSE_QBLOCK = 128
C_HEADS = 6
C_KV_HEADS = 2
C_GROUP = C_HEADS // C_KV_HEADS
C_DH = 64
C_SCALE = C_DH ** -0.5
WINDOW = 128
C_BLOCK = 128

IN_SIZES = (A_HEADS * A_DK, A_HEADS * A_DK, A_HEADS * A_DV, A_HEADS * A_DV, 4 * A_HEADS,
            B_Q_RANK, B_KV_RANK, B_ROPE,
            C_HEADS * C_DH, C_KV_HEADS * C_DH, C_KV_HEADS * C_DH)
D_IN = sum(IN_SIZES)
MIX_WIDTH = A_HEADS * A_DV + B_HEADS * B_DV + C_HEADS * C_DH

kernel_name = "hybrid_mlstm_mla_swa_macaron_dit"


def rms_norm(x, g):
    xf = x.astype(jnp.float32)
    y = xf * lax.rsqrt(jnp.mean(xf * xf, axis=-1, keepdims=True) + EPS)
    return (y * g.astype(jnp.float32)).astype(x.dtype)


def modulate(h, g, shift, scale):
    return rms_norm(h, g) * (1 + scale) + shift


def swiglu(h, wi, wo):
    gt, up = jnp.split(h @ wi, 2, axis=-1)
    return (jax.nn.silu(gt) * up) @ wo


def rope_1d(x, pos):
    half = x.shape[-1] // 2
    inv = ROPE_BASE ** (-jnp.arange(half, dtype=jnp.float32) / half)
    ang = pos.astype(jnp.float32)[:, None] * inv
    cos = jnp.cos(ang)[:, None, :]
    sin = jnp.sin(ang)[:, None, :]
    xf = x.astype(jnp.float32)
    x1, x2 = xf[..., :half], xf[..., half:]
    return jnp.concatenate([x1 * cos - x2 * sin, x1 * sin + x2 * cos], axis=-1).astype(x.dtype)


def rope_2d(x, row, col):
    r = x.shape[-1] // 2
    return jnp.concatenate([rope_1d(x[..., :r], row), rope_1d(x[..., r:], col)], axis=-1)


def split_cols(p):
    return jnp.split(p, [int(i) for i in np.cumsum(IN_SIZES)[:-1]], axis=-1)


def mlstm_chunked(q, k, v, ig, lf, state):
    B, H, T, DK = q.shape
    L = A_CHUNK
    NC = T // L

    def to_chunks(a):
        return jnp.moveaxis(a.reshape((B, H, NC, L) + a.shape[3:]), 2, 0)

    mask = jnp.tril(jnp.ones((L, L), dtype=bool))

    def step(carry, inp):
        C, n, m = carry
        qq, kk, vv, ii, ff = inp
        b = jnp.cumsum(ff, axis=-1)
        dlog = jnp.where(mask, b[..., :, None] - b[..., None, :] + ii[..., None, :], -jnp.inf)
        inter = b + m[..., None]
        m_t = jnp.maximum(inter, jnp.max(dlog, axis=-1))
        w = jnp.exp(dlog - m_t[..., None])
        a_inter = jnp.exp(inter - m_t)
        s = jnp.einsum('bhtd,bhsd->bhts', qq, kk) * w
        num = a_inter[..., None] * jnp.einsum('bhtd,bhde->bhte', qq, C) + jnp.einsum('bhts,bhse->bhte', s, vv)
        den = a_inter * jnp.einsum('bhtd,bhd->bht', qq, n) + jnp.sum(s, axis=-1)
        h = num / jnp.maximum(jnp.abs(den), jnp.exp(-m_t))[..., None]
        b_last = b[..., -1]
        g = b_last[..., None] - b + ii
        m_new = jnp.maximum(b_last + m, jnp.max(g, axis=-1))
        decay = jnp.exp(b_last + m - m_new)
        wg = jnp.exp(g - m_new[..., None])
        C_new = decay[..., None, None] * C + jnp.einsum('bhs,bhsd,bhse->bhde', wg, kk, vv)
        n_new = decay[..., None] * n + jnp.einsum('bhs,bhsd->bhd', wg, kk)
        return (C_new, n_new, m_new), h

    state, hs = lax.scan(step, state, tuple(to_chunks(a) for a in (q, k, v, ig, lf)))
    h = jnp.moveaxis(hs, 0, 2).reshape(B, H, T, v.shape[-1])
    return h, state


def mlstm_branch(parts_l, parts_c, gate_b, out_norm, need_ctx):
    def prep(q, k, v, g):
        B, T, _ = q.shape

        def hd(a, d):
            return a.reshape(B, T, A_HEADS, d).transpose(0, 2, 1, 3).astype(jnp.float32)

        g = (g.astype(jnp.float32) + gate_b.astype(jnp.float32)).reshape(B, T, 4, A_HEADS).transpose(2, 0, 3, 1)
        return (hd(q, A_DK) * A_DK ** -0.5, hd(k, A_DK), hd(v, A_DV),
                g[0], jax.nn.log_sigmoid(g[1]), g[2], jax.nn.log_sigmoid(g[3]))

    def rev(a):
        return jnp.flip(a, axis=2)

    def both(q, k, v, ig_f, lf_f, ig_b, lf_b, st_f, st_b):
        h_f, st_f = mlstm_chunked(q, k, v, ig_f, lf_f, st_f)
        h_b, st_b = mlstm_chunked(rev(q), rev(k), rev(v), rev(ig_b), rev(lf_b), st_b)
        return h_f + rev(h_b), st_f, st_b

    def finish(h, o):
        B, _, T, _ = h.shape
        h = rms_norm(h.transpose(0, 2, 1, 3), out_norm.reshape(A_HEADS, A_DV))
        return (jax.nn.sigmoid(o.astype(jnp.float32)) * h.reshape(B, T, A_HEADS * A_DV)).astype(o.dtype)

    in_c = prep(parts_c[0], parts_c[1], parts_c[2], parts_c[4])
    in_l = prep(parts_l[0], parts_l[1], parts_l[2], parts_l[4])
    B = in_c[0].shape[0]
    zero = (jnp.zeros((B, A_HEADS, A_DK, A_DV), jnp.float32),
            jnp.zeros((B, A_HEADS, A_DK), jnp.float32),
            jnp.zeros((B, A_HEADS), jnp.float32))
    h_c, st_f, st_b = both(*in_c, zero, zero)
    h_l, _, _ = both(*in_l, st_f, st_b)
    y_l = finish(h_l, parts_l[3])
    y_c = finish(h_c, parts_c[3]) if need_ctx else None
    return y_l, y_c


def dense_attend(q, k, v, scale):
    s = jnp.einsum('bhqd,bhkd->bhqk', q, k).astype(jnp.float32) * scale
    p = jax.nn.softmax(s, axis=-1)
    return jnp.einsum('bhqk,bhkd->bhqd', p.astype(v.dtype), v)


def mla_branch(parts_l, parts_c, cq_norm, ckv_norm, w_uq, w_ukv, q_norm, k_norm, row, col, need_ctx):
    def heads(cq, ckv, kr, rotate):
        B, T, _ = cq.shape
        q = (rms_norm(cq, cq_norm) @ w_uq).reshape(B, T, B_HEADS, B_DQK)
        kv = (rms_norm(ckv, ckv_norm) @ w_ukv).reshape(B, T, B_HEADS, B_NOPE + B_DV)
        k = jnp.concatenate([kv[..., :B_NOPE], jnp.broadcast_to(kr[:, :, None, :], (B, T, B_HEADS, B_ROPE))], axis=-1)
        v = kv[..., B_NOPE:]
        q = rms_norm(q, q_norm)
        k = rms_norm(k, k_norm)
        if rotate:
            q = jnp.concatenate([q[..., :B_NOPE], rope_2d(q[..., B_NOPE:], row, col)], axis=-1)
            k = jnp.concatenate([k[..., :B_NOPE], rope_2d(k[..., B_NOPE:], row, col)], axis=-1)
        return q.transpose(0, 2, 1, 3), k.transpose(0, 2, 1, 3), v.transpose(0, 2, 1, 3)

    q_l, k_l, v_l = heads(parts_l[0], parts_l[1], parts_l[2], True)
    q_c, k_c, v_c = heads(parts_c[0], parts_c[1], parts_c[2], False)
    B, H, T, _ = q_l.shape
    k_all = jnp.concatenate([k_c, k_l], axis=2)
    v_all = jnp.concatenate([v_c, v_l], axis=2)
    nq = T // DENSE_QBLOCK
    qb = q_l.reshape(B, H, nq, DENSE_QBLOCK, B_DQK).transpose(2, 0, 1, 3, 4)
    ob = lax.map(lambda qq: dense_attend(qq, k_all, v_all, B_SCALE), qb)
    y_l = ob.transpose(1, 0, 3, 2, 4).reshape(B, T, H * B_DV)
    y_c = None
    if need_ctx:
        y_c = dense_attend(q_c, k_c, v_c, B_SCALE).transpose(0, 2, 1, 3).reshape(B, q_c.shape[2], H * B_DV)
    return y_l, y_c


def gqa_branch(parts_l, parts_c, q_norm, k_norm, sink, row, col, need_ctx):
    def heads(q, k, v, rotate):
        B, T, _ = q.shape
        q = rms_norm(q.reshape(B, T, C_HEADS, C_DH), q_norm)
        k = rms_norm(k.reshape(B, T, C_KV_HEADS, C_DH), k_norm)
        v = v.reshape(B, T, C_KV_HEADS, C_DH)
        if rotate:
            q = rope_2d(q, row, col)
            k = rope_2d(k, row, col)
        q = q.reshape(B, T, C_KV_HEADS, C_GROUP, C_DH).transpose(0, 2, 3, 1, 4)
        return q, k.transpose(0, 2, 1, 3), v.transpose(0, 2, 1, 3)

    q_l, k_l, v_l = heads(parts_l[0], parts_l[1], parts_l[2], True)
    q_c, k_c, v_c = heads(parts_c[0], parts_c[1], parts_c[2], False)
    B, KVH, G, T, dh = q_l.shape
    n_ctx = k_c.shape[2]
    nb = T // C_BLOCK
    sink_h = sink.astype(jnp.float32).reshape(C_KV_HEADS, C_GROUP)

    def band(a):
        ap = jnp.pad(a, ((0, 0), (0, 0), (C_BLOCK, C_BLOCK), (0, 0))).reshape(B, KVH, nb + 2, C_BLOCK, dh)
        return jnp.concatenate([ap[:, :, :-2], ap[:, :, 1:-1], ap[:, :, 2:]], axis=3)

    kb, vb = band(k_l), band(v_l)
    qb = q_l.reshape(B, KVH, G, nb, C_BLOCK, dh)
    s_band = jnp.einsum('bkgnqd,bknsd->bkgnqs', qb, kb).astype(jnp.float32) * C_SCALE
    blk = jnp.arange(nb)[:, None, None] * C_BLOCK
    qpos = blk + jnp.arange(C_BLOCK)[None, :, None]
    kpos = blk - C_BLOCK + jnp.arange(3 * C_BLOCK)[None, None, :]
    valid = (jnp.abs(qpos - kpos) <= WINDOW) & (kpos >= 0) & (kpos < T)
    s_band = jnp.where(valid, s_band, -jnp.inf)
    s_ctx = jnp.einsum('bkgnqd,bkcd->bkgnqc', qb, k_c).astype(jnp.float32) * C_SCALE
    s_sink = jnp.broadcast_to(sink_h[None, :, :, None, None, None], s_ctx.shape[:-1] + (1,))
    p = jax.nn.softmax(jnp.concatenate([s_sink, s_ctx, s_band], axis=-1), axis=-1)
    o = (jnp.einsum('bkgnqc,bkcd->bkgnqd', p[..., 1:1 + n_ctx].astype(v_c.dtype), v_c)
         + jnp.einsum('bkgnqs,bknsd->bkgnqd', p[..., 1 + n_ctx:].astype(vb.dtype), vb))
    y_l = o.reshape(B, KVH, G, T, dh).transpose(0, 3, 1, 2, 4).reshape(B, T, C_HEADS * C_DH)
    y_c = None
    if need_ctx:
        s = jnp.einsum('bkgtd,bkcd->bkgtc', q_c, k_c).astype(jnp.float32) * C_SCALE
        s0 = jnp.broadcast_to(sink_h[None, :, :, None, None], s.shape[:-1] + (1,))
        pc = jax.nn.softmax(jnp.concatenate([s0, s], axis=-1), axis=-1)[..., 1:]
        oc = jnp.einsum('bkgtc,bkcd->bkgtd', pc.astype(v_c.dtype), v_c)
        y_c = oc.transpose(0, 3, 1, 2, 4).reshape(B, n_ctx, C_HEADS * C_DH)
    return y_l, y_c


def token_mix(h_l, h_c, w_in, mlstm_gate_b, mlstm_out_norm, mla_cq_norm, mla_ckv_norm, mla_w_uq, mla_w_ukv,
              mla_q_norm, mla_k_norm, gqa_q_norm, gqa_k_norm, gqa_sink, row, col, need_ctx):
    p_l = split_cols(h_l @ w_in)
    p_c = split_cols(h_c @ w_in)
    ya_l, ya_c = mlstm_branch(p_l[0:5], p_c[0:5], mlstm_gate_b, mlstm_out_norm, need_ctx)
    yb_l, yb_c = mla_branch(p_l[5:8], p_c[5:8], mla_cq_norm, mla_ckv_norm, mla_w_uq, mla_w_ukv,
                            mla_q_norm, mla_k_norm, row, col, need_ctx)
    yc_l, yc_c = gqa_branch(p_l[8:11], p_c[8:11], gqa_q_norm, gqa_k_norm, gqa_sink, row, col, need_ctx)
    y_l = jnp.concatenate([ya_l, yb_l, yc_l], axis=-1)
    y_c = jnp.concatenate([ya_c, yb_c, yc_c], axis=-1) if need_ctx else None
    return y_l, y_c


def setup_inputs(seed: int = 0) -> dict:
    key = jax.random.key(seed)
    ks = iter(jax.random.split(key, 32))
    f32 = jnp.float32

    def nrm(shape, fan_in, scale=1.0):
        return jax.random.normal(next(ks), shape, f32) * (scale * fan_in ** -0.5)

    def gain(shape):
        return 1.0 + 0.05 * jax.random.normal(next(ks), shape, f32)

    fbias = jnp.linspace(3.0, 6.0, A_HEADS, dtype=f32)
    zb = jnp.zeros((A_HEADS,), f32)
    gate_base = jnp.concatenate([zb, fbias, zb, fbias])
    return {
        'x': jax.random.normal(next(ks), (BATCH, SEQ, D_MODEL), f32),
        'c': jax.random.normal(next(ks), (BATCH, D_MODEL), f32),
        'ctx': jax.random.normal(next(ks), (BATCH, CTX_LEN, D_MODEL), f32),
        'c_ctx': jax.random.normal(next(ks), (D_MODEL,), f32),
        'ada_w': nrm((DEPTH, D_MODEL, N_MOD * D_MODEL), D_MODEL, 0.5),
        'ada_b': 0.02 * jax.random.normal(next(ks), (DEPTH, N_MOD * D_MODEL), f32),
        'norm_g': gain((DEPTH, 3, D_MODEL)),
        'ffn1_wi': nrm((DEPTH, D_MODEL, 2 * D_FF), D_MODEL),
        'ffn1_wo': nrm((DEPTH, D_FF, D_MODEL), D_FF),
        'ffn2_wi': nrm((DEPTH, D_MODEL, 2 * D_FF), D_MODEL),
        'ffn2_wo': nrm((DEPTH, D_FF, D_MODEL), D_FF),
        'w_in': nrm((DEPTH, D_MODEL, D_IN), D_MODEL),
        'w_out': nrm((DEPTH, MIX_WIDTH, D_MODEL), MIX_WIDTH),
        'mlstm_gate_b': gate_base[None, :] + 0.1 * jax.random.normal(next(ks), (DEPTH, 4 * A_HEADS), f32),
        'mlstm_out_norm': gain((DEPTH, A_HEADS * A_DV)),
        'mla_cq_norm': gain((DEPTH, B_Q_RANK)),
        'mla_ckv_norm': gain((DEPTH, B_KV_RANK)),
        'mla_w_uq': nrm((DEPTH, B_Q_RANK, B_HEADS * B_DQK), B_Q_RANK),
        'mla_w_ukv': nrm((DEPTH, B_KV_RANK, B_HEADS * (B_NOPE + B_DV)), B_KV_RANK),
        'mla_q_norm': gain((DEPTH, B_DQK)),
        'mla_k_norm': gain((DEPTH, B_DQK)),
        'gqa_q_norm': gain((DEPTH, C_DH)),
        'gqa_k_norm': gain((DEPTH, C_DH)),
        'gqa_sink': 0.5 * jax.random.normal(next(ks), (DEPTH, C_HEADS), f32),
    }


def reference(x, c, ctx, c_ctx, ada_w, ada_b, norm_g, ffn1_wi, ffn1_wo, ffn2_wi, ffn2_wo, w_in, w_out,
              mlstm_gate_b, mlstm_out_norm, mla_cq_norm, mla_ckv_norm, mla_w_uq, mla_w_ukv, mla_q_norm, mla_k_norm,
              gqa_q_norm, gqa_k_norm, gqa_sink):
    B, T, D = x.shape
    ROWS = T // GRID_W
    row = jnp.repeat(jnp.arange(ROWS, dtype=jnp.int32), GRID_W)
    col = jnp.arange(ROWS * GRID_W, dtype=jnp.int32) % GRID_W
    xc = ctx
    for l in range(DEPTH):
        need_ctx = l < DEPTH - 1
        mod_l = (jax.nn.silu(c) @ ada_w[l] + ada_b[l]).reshape(B, N_MOD, D).transpose(1, 0, 2)[:, :, None, :]
        mod_c = (jax.nn.silu(c_ctx) @ ada_w[l] + ada_b[l]).reshape(N_MOD, 1, 1, D)
        x = x + HALF * mod_l[2] * swiglu(modulate(x, norm_g[l, 0], mod_l[0], mod_l[1]), ffn1_wi[l], ffn1_wo[l])
        xc = xc + HALF * mod_c[2] * swiglu(modulate(xc, norm_g[l, 0], mod_c[0], mod_c[1]), ffn1_wi[l], ffn1_wo[l])
        y_l, y_c = token_mix(modulate(x, norm_g[l, 1], mod_l[3], mod_l[4]),
                             modulate(xc, norm_g[l, 1], mod_c[3], mod_c[4]),
                             w_in[l], mlstm_gate_b[l], mlstm_out_norm[l], mla_cq_norm[l], mla_ckv_norm[l],
                             mla_w_uq[l], mla_w_ukv[l], mla_q_norm[l], mla_k_norm[l],
                             gqa_q_norm[l], gqa_k_norm[l], gqa_sink[l], row, col, need_ctx)
        x = x + mod_l[5] * (y_l @ w_out[l])
        x = x + HALF * mod_l[8] * swiglu(modulate(x, norm_g[l, 2], mod_l[6], mod_l[7]), ffn2_wi[l], ffn2_wo[l])
        if need_ctx:
            xc = xc + mod_c[5] * (y_c @ w_out[l])
            xc = xc + HALF * mod_c[8] * swiglu(modulate(xc, norm_g[l, 2], mod_c[6], mod_c[7]), ffn2_wi[l], ffn2_wo[l])
    return x
```

```cpp
#include <hip/hip_runtime.h>
#include <cstdio>
#include <cstdint>
#define MK_N_LAUNCHES 1
namespace pg8 {
#define PG8_LAS __attribute__((address_space(3)))
typedef unsigned short bf16_t;
typedef short bf16x8 __attribute__((ext_vector_type(8)));
typedef float f32x4 __attribute__((ext_vector_type(4)));
typedef unsigned u32x4 __attribute__((ext_vector_type(4)));
constexpr int BM = 256, BK = 64, HALF = 128, HTB = HALF * BK * 2  , STAGE_BYTES = 8 * HTB, NXCD = 8, WGM = 8;

__host__ __device__ __forceinline__ int lds_byte(int r, int c) { const int st = (r >> 4) * 2 + (c >> 5), rr = r & 15, cc = c & 31, ob = rr * 64 + cc * 2; return st * 1024 + (ob ^ (((ob >> 9) & 1) << 5)); }
__host__ __device__ __forceinline__ void stage_rc(int b, int& R, int& C) { const int st = b / 1024, sb = b % 1024, swz = sb ^ (((sb >> 9) & 1) << 5); R = (st >> 1) * 16 + swz / 64; C = (st & 1) * 32 + (swz % 64) / 2; }
__host__ __device__ __forceinline__ int perm32(int rho) { const int n = rho >> 4, i = rho & 15; return 8 * (i >> 2) + 4 * n + (i & 3); }

struct Unit { int pm, pn, kt0, nt, half; };
struct Gemm { const bf16_t* A; const bf16_t* Bt; int M, N, K; };

struct StaticOrder {
    int nM, nN, nwg, G, c, ntK;
    __host__ __device__ void init(int M, int N, int G_, int c_, int K_) { nM = M / BM; nN = N / BM; nwg = nM * nN; G = G_; c = c_; ntK = K_ / BK; }
    __host__ __device__ bool next(int i, Unit& u) const {
        const long L = (long)i * G + c; if (L >= nwg) return false;
        int wgid = (int)L; { const int q = nwg / NXCD, r = nwg % NXCD, xcd = wgid % NXCD, off = wgid / NXCD; wgid = (xcd < r ? xcd * (q + 1) : r * (q + 1) + (xcd - r) * q) + off; }
        const int nig = WGM * nN, gid = wgid / nig, fm = gid * WGM, gsz = (nM - fm) < WGM ? (nM - fm) : WGM;
        u.pm = fm + ((wgid % nig) % gsz); u.pn = (wgid % nig) / gsz; u.kt0 = 0; u.nt = ntK; u.half = 0; return true;
    }
    __device__ __forceinline__ void a_ready(const Unit&) const {}
    __device__ __forceinline__ void done(const Unit&) const {}
};

struct SplitOrder {
    StaticOrder lat; int NS, ntS;
    __host__ __device__ void init(int N, int K, int G_, int c_, int NS_) { lat.init(16384, N, G_, c_, K); NS = NS_; ntS = NS_ ? (K / BK) / NS_ : 0; }
    __host__ __device__ bool next(int i, Unit& u) const {
        if (lat.G == lat.nwg && i < 2 && lat.c < 16 * NS) i = 1 - i;
        const long L = (long)i * lat.G + lat.c; if (L < lat.nwg) return lat.next(i, u);
        const int idx = (int)(L - lat.nwg); if (idx >= 16 * NS) return false;
        const int tile = idx / NS, sl = idx % NS; u.pm = 64 + (tile >> 2); u.pn = tile & 3; u.kt0 = sl * ntS; u.nt = ntS; u.half = 0; return true;
    }
    __device__ __forceinline__ void a_ready(const Unit&) const {}
    __device__ __forceinline__ void done(const Unit&) const {}
};

struct InprojOrder {
    StaticOrder full7; int G, c;
    __host__ __device__ void init(int G_, int c_, int K) { full7.init(17408, 7 * 256, G_, c_, K); G = G_; c = c_; }
    __host__ __device__ bool next(int i, Unit& u) const {
        if (G != 256) { if (i > 0) return false; u.pm = 0; u.pn = 0; u.kt0 = 0; u.nt = full7.ntK; u.half = 0; return c == 0; }
        if (i == 0 || (i == 1 && c < 220)) { const bool ok = full7.next(i, u); if (ok && u.pn >= 3) u.pn += 1; return ok; }
        int hidx;
        if (i == 1) hidx = c - 220;
        else if (i == 2 && c >= 220 && c < 252) hidx = 36 + (c - 220);
        else return false;
        u.pm = hidx; u.pn = 3; u.kt0 = 0; u.nt = full7.ntK; u.half = 1; return true;
    }
    __device__ __forceinline__ void a_ready(const Unit&) const {}
    __device__ __forceinline__ void done(const Unit&) const {}
};

struct UpOrder {
    int G, c;
    __host__ __device__ void init(int G_, int c_) { G = G_; c = c_; }
    __host__ __device__ bool next(int i, Unit& u) const {
        const long L = (long)i * G + c; if (L >= 408) return false;
        const int kv = L >= 204, j = kv ? (int)L - 204 : (int)L;
        u.pm = j / 3; u.pn = (kv ? 3 : 0) + j % 3; u.kt0 = kv ? 4 : 0; u.nt = kv ? 2 : 4; u.half = 0; return true;
    }
    __device__ __forceinline__ void a_ready(const Unit&) const {}
    __device__ __forceinline__ void done(const Unit&) const {}
};

__device__ __forceinline__ unsigned cvt_pk_bf16(float lo, float hi) { unsigned r; asm volatile("v_cvt_pk_bf16_f32 %0, %1, %2" : "=v"(r) : "v"(lo), "v"(hi)); return r; }
template <class Epi, class Sched, bool ALIGN_EPI = false, bool SP2 = false>
__device__ __forceinline__ void gemm_phase(PG8_LAS unsigned char* lds, const Gemm g, const Sched& S, const Epi& E) {
    int tid_ = threadIdx.x; asm volatile("" : "+v"(tid_));
    const int tid = tid_, wid = __builtin_amdgcn_readfirstlane(tid >> 6), lane = tid & 63, wr = wid >> 2, wc = wid & 3, fr = lane & 15, fq = lane >> 4;
    int K_ = g.K; asm volatile("" : "+s"(K_));
    const int K = K_;
    unsigned voffA[2], voffB[2];
#pragma unroll
    for (int i = 0; i < 2; ++i) { int R, C; stage_rc(tid * 16 + i * 8192, R, C); const int Rb = Epi::PERM ? ((R & ~31) + perm32(R & 31)) : R;
        voffA[i] = (unsigned)(R * K + C) * 2u; voffB[i] = (unsigned)(Rb * K + C) * 2u; }
    const size_t kstep = (size_t)(BK * 2);
    const size_t hstep = (size_t)HALF * K * 2;
    const size_t tstep = 2 * hstep;
    const unsigned ldsw = (unsigned)wid * 1024u;
    const int aoff = lds_byte(wr * 64 + fr, fq * 8), boff = lds_byte(wc * 32 + fr, fq * 8);
#define PG8_SA(b, h) (((b) * 2 + (h)) * HTB)
#define PG8_SB(b, h) ((4 + (b) * 2 + (h)) * HTB)
#define PG8_STAGE(bufoff, gbase, voff) do { _Pragma("unroll") for (int _i = 0; _i < 2; ++_i) \
        __builtin_amdgcn_global_load_lds((const unsigned*)((const char*)(gbase) + (voff)[_i]), (PG8_LAS unsigned*)(lds + (bufoff) + ldsw + _i * 8192), 16, 0, 0); } while (0)
#define PG8_LDA(dst, b, h) do { _Pragma("unroll") for (int m = 0; m < 4; ++m) _Pragma("unroll") for (int k = 0; k < 2; ++k) dst[m][k] = *(const PG8_LAS bf16x8*)(lds + PG8_SA(b, h) + aoff + m * 2048 + k * 1024); } while (0)
#define PG8_LDB(dst, b, h) do { _Pragma("unroll") for (int n = 0; n < 2; ++n) _Pragma("unroll") for (int k = 0; k < 2; ++k) dst[n][k] = *(const PG8_LAS bf16x8*)(lds + PG8_SB(b, h) + boff + n * 2048 + k * 1024); } while (0)
#define PG8_MMA(ai, bj, At, Bt) do { __builtin_amdgcn_s_setprio(1); _Pragma("unroll") for (int m = 0; m < 4; ++m) _Pragma("unroll") for (int n = 0; n < 2; ++n) _Pragma("unroll") for (int k = 0; k < 2; ++k) \
        acc[ai][bj][m][n] = __builtin_amdgcn_mfma_f32_16x16x32_bf16(Bt[n][k], At[m][k], acc[ai][bj][m][n], 0, 0, 0); __builtin_amdgcn_s_setprio(0); } while (0)
#define PG8_WAIT_V(n) asm volatile("s_waitcnt vmcnt(" #n ")" ::: "memory")
#define PG8_WAIT_L(n) asm volatile("s_waitcnt lgkmcnt(" #n ")" ::: "memory")
#define PG8_BAR __builtin_amdgcn_s_barrier()
#define PG8_SCHED __builtin_amdgcn_sched_barrier(0)
    Unit cur, nxt; int ui = 0;
    if (!S.next(0, cur)) return;
    f32x4 acc[2][2][4][2];
#pragma unroll
    for (int a = 0; a < 2; ++a)
#pragma unroll
        for (int b = 0; b < 2; ++b)
#pragma unroll
            for (int m = 0; m < 4; ++m)
#pragma unroll
                for (int n = 0; n < 2; ++n) acc[a][b][m][n] = (f32x4){0.f, 0.f, 0.f, 0.f};
    bf16x8 At[4][2], B0[2][2], B1[2][2];
    const char* cA = (const char*)g.A + (size_t)cur.pm * tstep + (size_t)cur.kt0 * kstep; const char* cB = (const char*)g.Bt + (size_t)cur.pn * tstep + (size_t)cur.kt0 * kstep;
    S.a_ready(cur);
    if constexpr (SP2) {
        PG8_STAGE(PG8_SB(0, 0), cB, voffB); PG8_STAGE(PG8_SB(0, 1), cB + hstep, voffB); PG8_STAGE(PG8_SA(0, 0), cA, voffA); PG8_STAGE(PG8_SA(0, 1), cA + hstep, voffA);
        if (wr == 1) PG8_BAR;
        PG8_WAIT_V(2); PG8_BAR;
        PG8_STAGE(PG8_SB(1, 0), cB + kstep, voffB); PG8_STAGE(PG8_SA(1, 0), cA + kstep, voffA); PG8_STAGE(PG8_SB(1, 1), cB + hstep + kstep, voffB);
        PG8_WAIT_V(6); PG8_BAR;
    } else {
        PG8_STAGE(PG8_SB(0, 0), cB, voffB); PG8_STAGE(PG8_SA(0, 0), cA, voffA); PG8_STAGE(PG8_SB(0, 1), cB + hstep, voffB); PG8_STAGE(PG8_SA(0, 1), cA + hstep, voffA);
        if (wr == 1) PG8_BAR;
        PG8_WAIT_V(4); PG8_BAR;
        PG8_STAGE(PG8_SB(1, 0), cB + kstep, voffB); PG8_STAGE(PG8_SA(1, 0), cA + kstep, voffA); PG8_STAGE(PG8_SB(1, 1), cB + hstep + kstep, voffB);
        PG8_WAIT_V(6); PG8_BAR;
    }
    for (;;) {
        const bool has_next = S.next(ui + 1, nxt);
        const char* nA = has_next ? (const char*)g.A + (size_t)nxt.pm * tstep + (size_t)nxt.kt0 * kstep : cA; const char* nB = has_next ? (const char*)g.Bt + (size_t)nxt.pn * tstep + (size_t)nxt.kt0 * kstep : cB;
        const int ntc = cur.nt; const bool full = !cur.half;
        for (int t = 0; t < ntc; t += 2) {
            const bool last = (t == ntc - 2);
            const char* a1 = cA + (size_t)(t + 1) * kstep;
            const char* a2 = last ? nA : cA + (size_t)(t + 2) * kstep; const char* b2 = last ? nB : cB + (size_t)(t + 2) * kstep;
            const char* a3 = a2 + kstep; const char* b3 = b2 + kstep;
            if (last && has_next) S.a_ready(nxt);
            if constexpr (SP2) {
            PG8_LDB(B0, 0, 0); PG8_LDB(B1, 0, 1); PG8_SCHED; PG8_LDA(At, 0, 0); PG8_STAGE(PG8_SA(1, 1), a1 + hstep, voffA);
            PG8_WAIT_V(8); PG8_WAIT_L(0); PG8_BAR; PG8_MMA(0, 0, At, B0); if (full) PG8_MMA(0, 1, At, B1); PG8_BAR; PG8_SCHED;
            PG8_LDA(At, 0, 1); PG8_STAGE(PG8_SB(0, 0), b2, voffB); PG8_STAGE(PG8_SB(0, 1), b2 + hstep, voffB); PG8_STAGE(PG8_SA(0, 0), a2, voffA);
            PG8_WAIT_V(8); PG8_WAIT_L(0); PG8_BAR; PG8_MMA(1, 0, At, B0); if (full) PG8_MMA(1, 1, At, B1); PG8_BAR; PG8_SCHED;
            PG8_LDB(B0, 1, 0); PG8_LDB(B1, 1, 1); PG8_SCHED; PG8_LDA(At, 1, 0); PG8_STAGE(PG8_SA(0, 1), a2 + hstep, voffA);
            PG8_WAIT_V(8); PG8_WAIT_L(0); PG8_BAR; PG8_MMA(0, 0, At, B0); if (full) PG8_MMA(0, 1, At, B1); PG8_BAR; PG8_SCHED;
            PG8_LDA(At, 1, 1); PG8_STAGE(PG8_SB(1, 0), b3, voffB); PG8_STAGE(PG8_SB(1, 1), b3 + hstep, voffB); PG8_STAGE(PG8_SA(1, 0), a3, voffA);
            PG8_WAIT_V(8); PG8_WAIT_L(0); PG8_BAR; PG8_MMA(1, 0, At, B0); if (full) PG8_MMA(1, 1, At, B1); PG8_BAR; PG8_SCHED;
            } else {
            PG8_LDB(B0, 0, 0); PG8_SCHED; PG8_LDA(At, 0, 0); PG8_STAGE(PG8_SA(1, 1), a1 + hstep, voffA);
            PG8_WAIT_L(8); PG8_BAR; PG8_WAIT_L(0); PG8_MMA(0, 0, At, B0); PG8_BAR; PG8_SCHED;
            PG8_LDB(B1, 0, 1); PG8_STAGE(PG8_SB(0, 0), b2, voffB);
            PG8_BAR; PG8_WAIT_L(0); PG8_MMA(0, 1, At, B1); PG8_BAR;
            PG8_LDA(At, 0, 1); PG8_STAGE(PG8_SA(0, 0), a2, voffA);
            PG8_BAR; PG8_WAIT_L(0); PG8_MMA(1, 0, At, B0); PG8_BAR; PG8_SCHED;
            PG8_STAGE(PG8_SB(0, 1), b2 + hstep, voffB);
            PG8_WAIT_V(6); PG8_BAR; PG8_MMA(1, 1, At, B1); PG8_BAR;
            PG8_LDB(B0, 1, 0); PG8_SCHED; PG8_LDA(At, 1, 0); PG8_STAGE(PG8_SA(0, 1), a2 + hstep, voffA);
            PG8_WAIT_L(8); PG8_BAR; PG8_WAIT_L(0); PG8_MMA(0, 0, At, B0); PG8_BAR; PG8_SCHED;
            PG8_LDB(B1, 1, 1); PG8_STAGE(PG8_SB(1, 0), b3, voffB);
            PG8_BAR; PG8_WAIT_L(0); PG8_MMA(0, 1, At, B1); PG8_BAR;
            PG8_LDA(At, 1, 1); PG8_STAGE(PG8_SA(1, 0), a3, voffA);
            PG8_BAR; PG8_WAIT_L(0); PG8_MMA(1, 0, At, B0); PG8_BAR; PG8_SCHED;
            PG8_STAGE(PG8_SB(1, 1), b3 + hstep, voffB);
            PG8_WAIT_V(6); PG8_BAR; PG8_MMA(1, 1, At, B1); PG8_BAR;
            }
        }
        if constexpr (ALIGN_EPI) { if (wr == 0) PG8_BAR; }
        if constexpr (!Epi::AFTER_DRAIN) { E(acc, cur, wr, wc, fr, fq); S.done(cur); }
        if (!has_next) break;
#pragma unroll
        for (int a = 0; a < 2; ++a)
#pragma unroll
            for (int b = 0; b < 2; ++b)
#pragma unroll
                for (int m = 0; m < 4; ++m)
#pragma unroll
                    for (int n = 0; n < 2; ++n) acc[a][b][m][n] = (f32x4){0.f, 0.f, 0.f, 0.f};
        cur = nxt; cA = nA; cB = nB; ++ui;
        if constexpr (ALIGN_EPI) { if (wr == 1) PG8_BAR; }
    }
    PG8_WAIT_V(0);
    if constexpr (!ALIGN_EPI) { if (wr == 0) PG8_BAR; }
    PG8_BAR;
    if constexpr (Epi::AFTER_DRAIN) { E.fused(acc, cur, wr, wc, fr, fq, lds, wid, lane); S.done(cur); }
#undef PG8_SA
#undef PG8_SB
#undef PG8_STAGE
#undef PG8_LDA
#undef PG8_LDB
#undef PG8_MMA
#undef PG8_WAIT_V
#undef PG8_WAIT_L
#undef PG8_BAR
#undef PG8_SCHED
}
}

#ifndef MK_N_LAUNCHES
#define MK_N_LAUNCHES 1
#endif
namespace cf {
constexpr int D = 1024, NB = 4, T = 4096, TC = 256, ML = NB * T, MC = NB * TC, M = ML + MC, TS = T + TC;
constexpr int DFF = 2816, DIN = 1840, DEPTH = 2;
constexpr float EPS = 1e-6f;
constexpr int NPH = 1 + 13 * DEPTH;
}
using namespace cf;
typedef unsigned short bf16_t;
typedef float f32x4 __attribute__((ext_vector_type(4)));
typedef unsigned u32x4 __attribute__((ext_vector_type(4)));
#define GAS __attribute__((address_space(1)))
#define LAS __attribute__((address_space(3)))
typedef GAS unsigned gu32;
#define RLX_AGENT __ATOMIC_RELAXED, __HIP_MEMORY_SCOPE_AGENT
#define LDS_WAIT() asm volatile("s_waitcnt lgkmcnt(0)" ::: "memory")
#define VM_WAIT() asm volatile("s_waitcnt vmcnt(0)" ::: "memory")

constexpr size_t MiB = 1u << 20;
constexpr size_t WS_CTL = 0, CTL_ZERO_BYTES = 64 * 1024;
constexpr size_t WS_MOD = 1 * MiB;
constexpr size_t WS_XBC = 5 * MiB;
constexpr size_t WS_W = 9 * MiB;
constexpr size_t W_1I = 0, W_1O = W_1I + (size_t)5632 * 1024, W_2I = W_1O + (size_t)1024 * 2816, W_2O = W_2I + (size_t)5632 * 1024, W_IN = W_2O + (size_t)1024 * 2816,
                 W_OUT = W_IN + (size_t)2048 * 1024, W_UP = W_OUT + (size_t)1024 * 1024, WL_STRIDE = W_UP + (size_t)1536 * 384;
static_assert(WS_W + 2 * WL_STRIDE * 2 <= 90 * MiB, "weights");
constexpr size_t WS_XN = 90 * MiB;
constexpr size_t WS_HID = 124 * MiB;
constexpr size_t WS_P16A = 124 * MiB;
constexpr size_t WS_G32 = WS_P16A + (size_t)M * 768 * 2;
constexpr size_t WS_P16B = 154 * MiB;
constexpr size_t WS_MLA = 154 * MiB;
constexpr size_t WS_LOC = 205 * MiB;
constexpr size_t WS_QUP = 223 * MiB;
constexpr size_t WS_END = 274 * MiB;
static_assert(WS_G32 + (size_t)M * 64 * 4 <= WS_P16B && WS_MLA + ((size_t)NB * 6 * TS * (96 + 96 + 64)) * 2 <= WS_LOC && WS_LOC + (size_t)32 * 68 * 2112 * 4 <= WS_QUP && WS_QUP + (size_t)M * 768 * 4 <= WS_END, "ws map");
static_assert(WS_HID + (size_t)M * DFF * 2 <= WS_QUP, "ws map 2");
constexpr int CW_BAR = 1024;

constexpr int RING_OFF = 0, RING_BYTES = 131072, LDSCTL_OFF = RING_BYTES, MISC_OFF = LDSCTL_OFF + 320, LDS_BYTES = 147456;

__device__ __forceinline__ float bf2f(bf16_t v) { return __uint_as_float(((unsigned)v) << 16); }
__device__ __forceinline__ bf16_t f2bf(float f) { unsigned u = __float_as_uint(f); u += 0x7fffu + ((u >> 16) & 1u); return (bf16_t)(u >> 16); }
__device__ __forceinline__ unsigned pk2(float lo, float hi) { typedef float f2_t_ __attribute__((ext_vector_type(2))); typedef __bf16 b2_t_ __attribute__((ext_vector_type(2))); f2_t_ v = {lo, hi}; b2_t_ b = __builtin_convertvector(v, b2_t_); return __builtin_bit_cast(unsigned, b); }
__device__ __forceinline__ float siluf(float x) { return x / (1.f + expf(-x)); }
__device__ __forceinline__ float silu_fast(float x) { return x * __builtin_amdgcn_rcpf(1.f + __expf(-x)); }
__device__ __forceinline__ float sigmoidf_(float x) { return 1.f / (1.f + expf(-x)); }
__device__ __forceinline__ float logsigmoidf_(float x) { return x >= 0.f ? -log1pf(expf(-x)) : x - log1pf(expf(x)); }
struct RowInfo { int b, t, isctx, s, sp; };
__device__ __forceinline__ RowInfo rowinfo(int m) {
    RowInfo r;
    if (m < ML) { r.b = m / T; r.t = m % T; r.isctx = 0; r.s = r.b; r.sp = TC + r.t; }
    else { int q = m - ML; r.b = q / TC; r.t = q % TC; r.isctx = 1; r.s = 4; r.sp = r.t; }
    return r;
}
template <int CTRL> __device__ __forceinline__ float dpp_f(float v) { return __int_as_float(__builtin_amdgcn_update_dpp(0, __float_as_int(v), CTRL, 0xF, 0xF, true)); }
__device__ __forceinline__ float sum16(float v) { v += dpp_f<0x128>(v); v += dpp_f<0x124>(v); v += dpp_f<0x122>(v); v += dpp_f<0x121>(v); return v; }
__device__ __forceinline__ float xor16_sum(float v) { auto r = __builtin_amdgcn_permlane16_swap(__float_as_uint(v), __float_as_uint(v), false, false); return __uint_as_float(r[0]) + __uint_as_float(r[1]); }
__device__ __forceinline__ float xor32_sum(float v) { auto r = __builtin_amdgcn_permlane32_swap(__float_as_uint(v), __float_as_uint(v), false, false); return __uint_as_float(r[0]) + __uint_as_float(r[1]); }
__device__ __forceinline__ float sum32(float v) { return xor16_sum(sum16(v)); }
__device__ __forceinline__ float wave_sum(float v) { return xor32_sum(xor16_sum(sum16(v))); }
template <int CTRL, int RMASK> __device__ __forceinline__ float dpp_id(float v, float ident) { return __int_as_float(__builtin_amdgcn_update_dpp(__float_as_int(ident), __float_as_int(v), CTRL, RMASK, 0xF, false)); }
__device__ __forceinline__ float scan_sum64(float v) {
    v += dpp_id<0x111, 0xF>(v, 0.f); v += dpp_id<0x112, 0xF>(v, 0.f); v += dpp_id<0x114, 0xF>(v, 0.f); v += dpp_id<0x118, 0xF>(v, 0.f);
    v += dpp_id<0x142, 0xA>(v, 0.f); v += dpp_id<0x143, 0xC>(v, 0.f); return v; }
__device__ __forceinline__ float scan_max64(float v) {
    const float NI = -INFINITY;
    v = fmaxf(v, dpp_id<0x111, 0xF>(v, NI)); v = fmaxf(v, dpp_id<0x112, 0xF>(v, NI)); v = fmaxf(v, dpp_id<0x114, 0xF>(v, NI)); v = fmaxf(v, dpp_id<0x118, 0xF>(v, NI));
    v = fmaxf(v, dpp_id<0x142, 0xA>(v, NI)); v = fmaxf(v, dpp_id<0x143, 0xC>(v, NI)); return v; }
__device__ __forceinline__ float lane_bcast(float v, int lane_const) { return __int_as_float(__builtin_amdgcn_readlane(__float_as_int(v), lane_const)); }
__device__ __forceinline__ float xchg4(float v, int l16) { const float up = dpp_f<0x104>(v)  , dn = dpp_f<0x114>(v)  ; return (l16 & 4) ? dn : up; }
__device__ __forceinline__ float xchg2(float v) { return dpp_f<0x4E>(v); }
__device__ __forceinline__ void sincos_b(float a, float& s, float& c) {
    const float inv2pi = 0.15915494309189535f;
    float k = rintf(a * inv2pi);
    float r = fmaf(-k, 6.28125f, a);
    r = fmaf(-k, 1.9353071795864769e-3f, r);
    float rev = r * inv2pi;
    s = __builtin_amdgcn_sinf(rev); c = __builtin_amdgcn_cosf(rev);
}
__device__ __forceinline__ const float* modp(const float* MOD, int l, int s, int n) { return MOD + ((size_t)(l * 5 + s) * 9 + n) * D; }
#define XB_TMO      128
#define XB_XCNT(j)  (256  + 64 * (j))
#define XB_XSUB(j)  (1280 + 64 * (j))
#define XB_XGEN(j)  (2304 + 64 * (j))
#define XB_TOP      3328
#define XB_TOPGEN   3392
#define XCD_BAR_WORDS 3456
#define XB_SPIN_CAP (1u << 18)

__device__ __forceinline__ unsigned xb_ld(unsigned* p)              { return __hip_atomic_load(p, __ATOMIC_RELAXED, __HIP_MEMORY_SCOPE_AGENT); }
__device__ __forceinline__ unsigned xb_add(unsigned* p, unsigned v) { return __hip_atomic_fetch_add(p, v, __ATOMIC_RELAXED, __HIP_MEMORY_SCOPE_AGENT); }
__device__ __forceinline__ unsigned xb_xcc_id() { return (unsigned)__builtin_amdgcn_s_getreg((3 << 11) | 20) & 0xFu; }
#define XB_SPIN(cond, bar) do { unsigned _sp = 0; while (cond) { __builtin_amdgcn_s_sleep(1); \
    if ((++_sp & 255u) == 0u) { if (xb_ld(&(bar)[XB_TMO])) break; if (_sp > XB_SPIN_CAP) { atomicAdd(&(bar)[XB_TMO], 1u); break; } } } } while (0)

struct XcdBarrier {
    unsigned* bar; unsigned x;
    volatile LAS unsigned* st;
};

__device__ __forceinline__ XcdBarrier xcd_barrier_post(unsigned* bar, volatile LAS unsigned* st) {
    XcdBarrier b; b.bar = bar; b.x = xb_xcc_id(); b.st = st;
    if (threadIdx.x == 0) (void)xb_add(&bar[XB_XCNT(b.x)], 1u);
    return b;
}
__device__ __forceinline__ void xcd_barrier_complete(unsigned* bar, unsigned x, unsigned& nloc, unsigned& nx) {
    const unsigned G = gridDim.x * gridDim.y * gridDim.z;
    unsigned sum, cnt, mine, sp = 0u;
    for (;;) {
        sum = 0u; cnt = 0u; mine = 0u;
#pragma unroll
        for (unsigned j = 0; j < 16; ++j) { const unsigned c = xb_ld(&bar[XB_XCNT(j)]); sum += c; cnt += (c > 0u) ? 1u : 0u; mine = (j == x) ? c : mine; }
        if (sum == G) break;
        __builtin_amdgcn_s_sleep(1);
        if ((++sp & 255u) == 0u) { if (xb_ld(&bar[XB_TMO])) break; if (sp > XB_SPIN_CAP) { atomicAdd(&bar[XB_TMO], 1u); break; } }
    }
    nloc = mine > 0u ? mine : 1u; nx = cnt > 0u ? cnt : 1u;
}

__device__ __forceinline__ void xcd_barrier(const XcdBarrier& b) {
    asm volatile("s_waitcnt vmcnt(0)" ::: "memory");
    __syncthreads();
    if (threadIdx.x == 0) {
        unsigned* bar = b.bar;
        __builtin_amdgcn_s_waitcnt(0);
        unsigned nloc = b.st[0], nx = b.st[1];
        if (nloc == 0u) { xcd_barrier_complete(bar, b.x, nloc, nx); b.st[0] = nloc; b.st[1] = nx; }
        const unsigned old = xb_add(&bar[XB_XSUB(b.x)], 1u);
        const unsigned gen = old / nloc;
        if (old + 1u == (gen + 1u) * nloc) {
            __builtin_amdgcn_fence(__ATOMIC_RELEASE, "agent");
            asm volatile("s_waitcnt vmcnt(0)" ::: "memory");
            const unsigned og = xb_add(&bar[XB_TOP], 1u);
            const unsigned tg = og / nx;
            if (og + 1u == (tg + 1u) * nx) xb_add(&bar[XB_TOPGEN], 1u);
            else XB_SPIN(xb_ld(&bar[XB_TOPGEN]) == tg, bar);
            __builtin_amdgcn_fence(__ATOMIC_ACQUIRE, "agent");
            xb_add(&bar[XB_XGEN(b.x)], 1u);
            asm volatile("s_waitcnt vmcnt(0)" ::: "memory");
        } else {
            XB_SPIN(xb_ld(&bar[XB_XGEN(b.x)]) == gen, bar);
            __builtin_amdgcn_fence(__ATOMIC_ACQUIRE, "agent");
            asm volatile("s_waitcnt vmcnt(0)" ::: "memory");
        }
    }
    __syncthreads();
}

struct Args { const float* in[24]; float* out; unsigned char* ws; int ph_lo, ph_hi; };
struct Frame {
    LAS unsigned char* lds; int tid, lane, wave, vcu, G;
    const float* const* in; float* out; unsigned char* ws;
    __device__ __forceinline__ bf16_t* wl(int l, size_t off) const { return (bf16_t*)(ws + WS_W) + (size_t)l * WL_STRIDE + off; }
};
#define OPAQUE_TID(F) do { int t_ = (F).tid; asm volatile("" : "+v"(t_)); (F).tid = t_; (F).lane = t_ & 63; } while (0)
#define F_MOD   ((float*)(F.ws + WS_MOD))
#define F_XBC   ((float*)(F.ws + WS_XBC))
#define F_XN    ((bf16_t*)(F.ws + WS_XN))
#define F_HID   ((bf16_t*)(F.ws + WS_HID))
#define F_P16A  ((bf16_t*)(F.ws + WS_P16A))
#define F_G32   ((float*)(F.ws + WS_G32))
#define F_P16B  ((bf16_t*)(F.ws + WS_P16B))
#define F_Y     ((bf16_t*)(F.ws + WS_QUP))
#define F_QUP   ((bf16_t*)(F.ws + WS_QUP))
#define F_KVUP  ((bf16_t*)(F.ws + WS_QUP) + (size_t)M * 768)
#define F_QC    ((bf16_t*)(F.ws + WS_XN))
#define F_KC    (F_QC + (size_t)NB * 6 * TS * 64)
#define F_VC    (F_KC + (size_t)NB * 2 * TS * 64)
#define F_CKN   (F_VC + (size_t)NB * 2 * TS * 64)
#define F_QB    ((bf16_t*)(F.ws + WS_MLA))
#define F_KB    (F_QB + (size_t)NB * 6 * TS * 96)
#define F_VB    (F_KB + (size_t)NB * 6 * TS * 96)
enum InIdx { I_X = 0, I_C, I_CTX, I_CCTX, I_ADAW, I_ADAB, I_NORMG, I_F1WI, I_F1WO, I_F2WI, I_F2WO, I_WIN, I_WOUT, I_GATEB, I_OUTNORM, I_CQN, I_CKVN, I_WUQ, I_WUKV, I_MQN, I_MKN, I_GQN, I_GKN, I_SINK };

template <class Map>
__device__ __forceinline__ void transpose_item(const float* W, int ldw, int Nsrc, int k0, int n0, bf16_t* WT, int ldt, int koff, Map map, LAS float* scr, int lane, float sc = 1.f) {
    int nsrc = n0 + (lane & 31); nsrc = nsrc < Nsrc ? nsrc : Nsrc - 1;
    float tv[32];
#pragma unroll
    for (int i = 0; i < 32; ++i) { const int kk = 2 * i + (lane >> 5); tv[i] = W[(size_t)(k0 + kk) * ldw + nsrc]; }
#pragma unroll
    for (int i = 0; i < 32; ++i) { const int kk = 2 * i + (lane >> 5); scr[kk * 33 + (lane & 31)] = tv[i]; }
    LDS_WAIT(); asm volatile("" ::: "memory");
    const int c = lane & 7;
#pragma unroll
    for (int j = 0; j < 4; ++j) { const int nn = (lane >> 3) + 8 * j; const LAS float* s = scr + (8 * c) * 33 + nn;
        u32x4 o; o.x = pk2(s[0 * 33] * sc, s[1 * 33] * sc); o.y = pk2(s[2 * 33] * sc, s[3 * 33] * sc); o.z = pk2(s[4 * 33] * sc, s[5 * 33] * sc); o.w = pk2(s[6 * 33] * sc, s[7 * 33] * sc);
        if (n0 + nn < Nsrc) *(u32x4*)(WT + (size_t)map(n0 + nn) * ldt + koff + k0 + 8 * c) = o; }
    LDS_WAIT(); asm volatile("" ::: "memory");
}
constexpr float SW_GSC = 1.4426950408889634f, SW_USC = 0.6931471805599453f;
static_assert(DFF % 32 == 0, "a conversion item never straddles the gate/up boundary");
struct MapId { __device__ __forceinline__ int operator()(int n) const { return n; } };
struct MapWi { __device__ __forceinline__ int operator()(int n) const { return n < DFF ? 256 * (n >> 7) + (n & 127) : 256 * ((n - DFF) >> 7) + 128 + ((n - DFF) & 127); } };
__host__ __device__ __forceinline__ int pcol(int n) {
    if (n < 784) return n;
    if (n < 1040) return 1024 + (n - 784);
    if (n < 1168) return 1280 + (n - 1040);
    if (n < 1200) return 784 + (n - 1168);
    if (n < 1584) return 1408 + (n - 1200);
    if (n < 1712) return 1792 + (n - 1584);
    return 1920 + (n - 1712);
}
struct MapWin { __device__ __forceinline__ int operator()(int n) const { return pcol(n); } };
struct MapUq { __device__ __forceinline__ int operator()(int n) const { return 128 * (n / 96) + (n % 96); } };
struct MapUkv { __device__ __forceinline__ int operator()(int n) const { return 768 + n; } };

__device__ __forceinline__ void p0_prologue(Frame& F) {
    OPAQUE_TID(F);
    {
        LAS float* sc = (LAS float*)(F.lds);
        LAS float* red = (LAS float*)(F.lds + 20480);
        for (int i = F.tid; i < 5 * 1024; i += 512) { int s = i >> 10, k = i & 1023; float v = s < 4 ? F.in[I_C][s * D + k] : F.in[I_CCTX][k]; sc[i] = siluf(v); }
        __syncthreads();
        for (int it = F.vcu; it < 576; it += F.G) {
            const int l = it / 288, cb = it % 288; const int kk = F.lane >> 3, c4 = F.lane & 7; const int kb = F.wave * 128;
            const float* w = F.in[I_ADAW] + (size_t)l * D * 9216 + (size_t)(kb + kk) * 9216 + cb * 32 + 4 * c4;
            f32x4 a[5] = {{0.f, 0.f, 0.f, 0.f}, {0.f, 0.f, 0.f, 0.f}, {0.f, 0.f, 0.f, 0.f}, {0.f, 0.f, 0.f, 0.f}, {0.f, 0.f, 0.f, 0.f}};
#pragma unroll 16
            for (int i = 0; i < 16; ++i) { const f32x4 wv = *(const f32x4*)(w + (size_t)(8 * i) * 9216); const int k = kb + kk + 8 * i;
#pragma unroll
                for (int s = 0; s < 5; ++s) a[s] += wv * sc[s * 1024 + k]; }
#pragma unroll
            for (int s = 0; s < 5; ++s) {
#pragma unroll
                for (int c = 0; c < 4; ++c) { float t = a[s][c]; t += dpp_f<0x128>(t); t = xor32_sum(xor16_sum(t)); a[s][c] = t; } }
            if (kk == 0) { LAS float* r = red + F.wave * 160 + 4 * c4;
#pragma unroll
                for (int s = 0; s < 5; ++s) *(LAS f32x4*)(r + 32 * s) = a[s]; }
            __syncthreads();
            if (F.tid < 160) { const int s = F.tid >> 5, col = F.tid & 31; float acc = F.in[I_ADAB][l * 9216 + cb * 32 + col];
#pragma unroll
                for (int wv = 0; wv < 8; ++wv) acc += red[wv * 160 + s * 32 + col];
                F_MOD[(size_t)(l * 5 + s) * 9216 + cb * 32 + col] = acc; }
            __syncthreads();
        }
    }
    { const int gt = F.vcu * 512 + F.tid, NGT = F.G * 512; for (int i = gt; i < MC * D / 4; i += NGT) ((f32x4*)F_XBC)[i] = ((const f32x4*)F.in[I_CTX])[i]; }
    {
        const int gt = F.vcu * 512 + F.tid, NGT = F.G * 512; const u32x4 z = {0u, 0u, 0u, 0u};
        for (int i = gt; i < 2 * (768 * 16 + 768 * 32); i += NGT) {
            const int l = i / (768 * 48); int r = i % (768 * 48);
            bf16_t* wu = F.wl(l, W_UP);
            if (r < 768 * 16) { const int row = r >> 4, ch = r & 15; *(u32x4*)(wu + (size_t)row * 384 + 256 + 8 * ch) = z; }
            else { r -= 768 * 16; const int row = 768 + (r >> 5), ch = r & 31; *(u32x4*)(wu + (size_t)row * 384 + 8 * ch) = z; }
        }
    }
}

constexpr int CV_WI = 16 * 176, CV_WO = 44 * 32, CV_IN = 16 * 58, CV_OUT = 16 * 32, CV_UQ = 4 * 18, CV_UKV = 2 * 24;
constexpr int CV_NA = CV_WI + CV_WO + CV_IN + CV_UQ + CV_UKV, CV_NB = CV_WI + CV_WO + CV_OUT, CV_P0 = CV_NA;
static_assert(CV_P0 <= CV_NA, "phase-0 share");
__device__ __forceinline__ void p0_weights(Frame& F, int l0, int r0, int n0, int ntot, int gw, int NGW) {
    OPAQUE_TID(F);
    LAS float* scr = (LAS float*)(F.lds + F.wave * 16384);
    for (int t = gw; t < ntot; t += NGW) {
        const int l = t < n0 ? l0 : l0 + 1; int r = t < n0 ? r0 + t : t - n0;
        if (r < CV_WI) { transpose_item(F.in[I_F1WI] + (size_t)l * D * 2 * DFF, 2 * DFF, 2 * DFF, 64 * (r / 176), 32 * (r % 176), F.wl(l, W_1I), 1024, 0, MapWi(), scr, F.lane, (r % 176) < 88 ? SW_GSC : SW_USC); continue; } r -= CV_WI;
        if (r < CV_WO) { transpose_item(F.in[I_F1WO] + (size_t)l * DFF * D, D, D, 64 * (r / 32), 32 * (r % 32), F.wl(l, W_1O), DFF, 0, MapId(), scr, F.lane); continue; } r -= CV_WO;
        if (r < CV_IN) { transpose_item(F.in[I_WIN] + (size_t)l * D * DIN, DIN, DIN, 64 * (r / 58), 32 * (r % 58), F.wl(l, W_IN), 1024, 0, MapWin(), scr, F.lane); continue; } r -= CV_IN;
        if (r < CV_UQ) { transpose_item(F.in[I_WUQ] + (size_t)l * 256 * 576, 576, 576, 64 * (r / 18), 32 * (r % 18), F.wl(l, W_UP), 384, 0, MapUq(), scr, F.lane); continue; } r -= CV_UQ;
        if (r < CV_UKV) { transpose_item(F.in[I_WUKV] + (size_t)l * 128 * 768, 768, 768, 64 * (r / 24), 32 * (r % 24), F.wl(l, W_UP), 384, 256, MapUkv(), scr, F.lane); continue; } r -= CV_UKV;
        if (r < CV_WI) { transpose_item(F.in[I_F2WI] + (size_t)l * D * 2 * DFF, 2 * DFF, 2 * DFF, 64 * (r / 176), 32 * (r % 176), F.wl(l, W_2I), 1024, 0, MapWi(), scr, F.lane, (r % 176) < 88 ? SW_GSC : SW_USC); continue; } r -= CV_WI;
        if (r < CV_WO) { transpose_item(F.in[I_F2WO] + (size_t)l * DFF * D, D, D, 64 * (r / 32), 32 * (r % 32), F.wl(l, W_2O), DFF, 0, MapId(), scr, F.lane); continue; } r -= CV_WO;
        transpose_item(F.in[I_WOUT] + (size_t)l * D * D, D, D, 64 * (r / 32), 32 * (r % 32), F.wl(l, W_OUT), 1024, 0, MapId(), scr, F.lane);
    }
}
__device__ __forceinline__ void ph_modulate(Frame& F, const float* xl, int l, int which, int Mrows, int npend, const float* slab, const float* pgate, float pcoef) {
    OPAQUE_TID(F);
    const int gw = F.vcu * 8 + F.wave, NGW = F.G * 8, lane = F.lane;
    const f32x4* g4 = (const f32x4*)(F.in[I_NORMG] + (l * 3 + which) * D);
    {
        f32x4 cur[4];
        if (gw < ML) {
#pragma unroll
            for (int j = 0; j < 4; ++j) cur[j] = ((const f32x4*)(xl + (size_t)gw * D))[lane + 64 * j];
        }
        for (int m = gw; m < ML; m += NGW) {
            const int mn = (m + NGW < ML) ? m + NGW : m; f32x4 nxt[4];
#pragma unroll
            for (int j = 0; j < 4; ++j) nxt[j] = ((const f32x4*)(xl + (size_t)mn * D))[lane + 64 * j];
            const int s = m / T;
            const f32x4* sh4 = (const f32x4*)modp(F_MOD, l, s, 3 * which); const f32x4* sc4 = (const f32x4*)modp(F_MOD, l, s, 3 * which + 1);
            f32x4 gs[4], sh[4];
#pragma unroll
            for (int j = 0; j < 4; ++j) { const f32x4 g = g4[lane + 64 * j], sc = sc4[lane + 64 * j]; sh[j] = sh4[lane + 64 * j]; gs[j] = g * (sc + 1.f); }
            float ss = 0.f;
#pragma unroll
            for (int j = 0; j < 4; ++j) ss += cur[j].x * cur[j].x + cur[j].y * cur[j].y + cur[j].z * cur[j].z + cur[j].w * cur[j].w;
            ss = wave_sum(ss);
            const float rstd = rsqrtf(ss * (1.f / D) + EPS);
            uint2* o = (uint2*)(F_XN + (size_t)m * D);
#pragma unroll
            for (int j = 0; j < 4; ++j) { const f32x4 y = cur[j] * rstd * gs[j] + sh[j]; uint2 r; r.x = pk2(y.x, y.y); r.y = pk2(y.z, y.w); o[lane + 64 * j] = r; }
#pragma unroll
            for (int j = 0; j < 4; ++j) cur[j] = nxt[j];
        }
    }
    for (int m = ML + gw; m < Mrows; m += NGW) {
        f32x4 v[4]; float ss = 0.f;
        {
            f32x4* xr = (f32x4*)(F_XBC + (size_t)(m - ML) * D);
#pragma unroll
            for (int j = 0; j < 4; ++j) v[j] = xr[lane + 64 * j];
            if (npend > 0) {
                f32x4 a[4] = {{0.f, 0.f, 0.f, 0.f}, {0.f, 0.f, 0.f, 0.f}, {0.f, 0.f, 0.f, 0.f}, {0.f, 0.f, 0.f, 0.f}};
                for (int s = 0; s < npend; ++s) { const f32x4* sr = (const f32x4*)(slab + ((size_t)s * MC + (m - ML)) * D);
#pragma unroll
                    for (int j = 0; j < 4; ++j) a[j] += sr[lane + 64 * j]; }
#pragma unroll
                for (int j = 0; j < 4; ++j) { v[j] += ((const f32x4*)pgate)[lane + 64 * j] * pcoef * a[j]; xr[lane + 64 * j] = v[j]; }
            }
        }
#pragma unroll
        for (int j = 0; j < 4; ++j) ss += v[j].x * v[j].x + v[j].y * v[j].y + v[j].z * v[j].z + v[j].w * v[j].w;
        ss = wave_sum(ss);
        const float rstd = rsqrtf(ss * (1.f / D) + EPS);
        const f32x4* sh4 = (const f32x4*)modp(F_MOD, l, 4, 3 * which); const f32x4* sc4 = (const f32x4*)modp(F_MOD, l, 4, 3 * which + 1);
        uint2* o = (uint2*)(F_XN + (size_t)m * D);
#pragma unroll
        for (int j = 0; j < 4; ++j) {
            f32x4 g = g4[lane + 64 * j], sh = sh4[lane + 64 * j], sc = sc4[lane + 64 * j];
            uint2 r; r.x = pk2(v[j].x * rstd * g.x * (1.f + sc.x) + sh.x, v[j].y * rstd * g.y * (1.f + sc.y) + sh.y);
            r.y = pk2(v[j].z * rstd * g.z * (1.f + sc.z) + sh.z, v[j].w * rstd * g.w * (1.f + sc.w) + sh.w);
            o[lane + 64 * j] = r;
        }
    }
}
__device__ __forceinline__ f32x4 ld_bf4(const bf16_t* p) { uint2 w = *(const uint2*)p; f32x4 r; r.x = __uint_as_float(w.x << 16); r.y = __uint_as_float(w.x & 0xffff0000u); r.z = __uint_as_float(w.y << 16); r.w = __uint_as_float(w.y & 0xffff0000u); return r; }
__device__ __forceinline__ f32x4 cvt_bf4(uint2 w) { f32x4 r; r.x = __uint_as_float(w.x << 16); r.y = __uint_as_float(w.x & 0xffff0000u); r.z = __uint_as_float(w.y << 16); r.w = __uint_as_float(w.y & 0xffff0000u); return r; }
__device__ __forceinline__ void st_bf4(bf16_t* p, float a, float b, float c, float d) { uint2 r; r.x = pk2(a, b); r.y = pk2(c, d); *(uint2*)p = r; }

__device__ __forceinline__ void rope64(float (&v)[4], int l16, int prow, int pcolp) {
    int d0 = 4 * l16; int pos = d0 < 32 ? prow : pcolp; int dd0 = d0 & 31; bool first = dd0 < 16;
#pragma unroll
    for (int i = 0; i < 4; ++i) {
        float other = xchg4(v[i], l16);
        int fi = (dd0 & 15) + i;
        float inv = exp2f(-(float)fi * (13.287712379549449f / 16.f));
        float s, c; sincos_b((float)pos * inv, s, c);
        v[i] = first ? (v[i] * c - other * s) : (other * s + v[i] * c);
    }
}
__device__ __forceinline__ void rope32(float (&v)[4], int l8, int prow, int pcolp) {
    int rd0 = 4 * l8; int pos = rd0 < 16 ? prow : pcolp; int r16 = rd0 & 15; bool first = r16 < 8;
#pragma unroll
    for (int i = 0; i < 4; ++i) {
        float other = xchg2(v[i]);
        int fi = (r16 & 7) + i;
        float inv = exp2f(-(float)fi * (13.287712379549449f / 8.f));
        float s, c; sincos_b((float)pos * inv, s, c);
        v[i] = first ? (v[i] * c - other * s) : (other * s + v[i] * c);
    }
}
__device__ __forceinline__ void ph_prepA(Frame& F, int l) {
    OPAQUE_TID(F);
    const int gw = F.vcu * 8 + F.wave, NGW = F.G * 8, lane = F.lane, l16 = lane & 15;
    const float* cq_norm = F.in[I_CQN] + l * 256; const float* ckv_norm = F.in[I_CKVN] + l * 128; const float* gq_norm = F.in[I_GQN] + l * 64; const float* gk_norm = F.in[I_GKN] + l * 64;
    uint2 nraw[4];
    { const bf16_t* pr = F_P16B + (size_t)(gw < M ? gw : 0) * 1024 + 4 * lane;
#pragma unroll
      for (int j = 0; j < 4; ++j) nraw[j] = *(const uint2*)(pr + 256 * j); }
    for (int m = gw; m < M; m += NGW) {
        RowInfo ri = rowinfo(m); const bool lat = !ri.isctx; const int prow = ri.t >> 6, pcl = ri.t & 63;
        const f32x4 v0 = cvt_bf4(nraw[0]), v1 = cvt_bf4(nraw[1]), v2 = cvt_bf4(nraw[2]), v3 = cvt_bf4(nraw[3]);
        { const int mn = m + NGW < M ? m + NGW : m; const bf16_t* pr = F_P16B + (size_t)mn * 1024 + 4 * lane;
#pragma unroll
          for (int j = 0; j < 4; ++j) nraw[j] = *(const uint2*)(pr + 256 * j); }
        { float ss = wave_sum(v0.x * v0.x + v0.y * v0.y + v0.z * v0.z + v0.w * v0.w); float rstd = rsqrtf(ss * (1.f / 256.f) + EPS);
          f32x4 g = ((const f32x4*)cq_norm)[lane]; st_bf4(F_CKN + (size_t)m * 384 + 4 * lane, v0.x * rstd * g.x, v0.y * rstd * g.y, v0.z * rstd * g.z, v0.w * rstd * g.w); }
        { float p = lane < 32 ? (v1.x * v1.x + v1.y * v1.y + v1.z * v1.z + v1.w * v1.w) : 0.f; float ss = wave_sum(p); float rstd = rsqrtf(ss * (1.f / 128.f) + EPS);
          if (lane < 32) { f32x4 g = ((const f32x4*)ckv_norm)[lane]; st_bf4(F_CKN + (size_t)m * 384 + 256 + 4 * lane, v1.x * rstd * g.x, v1.y * rstd * g.y, v1.z * rstd * g.z, v1.w * rstd * g.w); } }
#pragma unroll
        for (int part = 0; part < 2; ++part) {
            f32x4 x = part ? v2 : v1; const bool ok = part ? true : lane >= 32; const int hq = part ? 2 + (lane >> 4) : ((lane >> 4) & 1);
            float ss = x.x * x.x + x.y * x.y + x.z * x.z + x.w * x.w;
            ss = sum16(ss);
            float rstd = rsqrtf(ss * (1.f / 64.f) + EPS); f32x4 g = ((const f32x4*)gq_norm)[l16];
            float v[4] = {x.x * rstd * g.x, x.y * rstd * g.y, x.z * rstd * g.z, x.w * rstd * g.w};
            float vr[4] = {v[0], v[1], v[2], v[3]}; rope64(vr, l16, prow, pcl);
            if (lat) { v[0] = vr[0]; v[1] = vr[1]; v[2] = vr[2]; v[3] = vr[3]; }
            constexpr float QSC = 0.125f * 1.4426950408889634f;
            if (ok) st_bf4(F_QC + (((size_t)ri.b * 6 + hq) * TS + ri.sp) * 64 + 4 * l16, v[0] * QSC, v[1] * QSC, v[2] * QSC, v[3] * QSC);
        }
        { const int kvh = (lane & 31) >> 4; const bool isk = lane < 32; f32x4 x = v3;
          float ss = x.x * x.x + x.y * x.y + x.z * x.z + x.w * x.w;
          ss = sum16(ss);
          float rstd = rsqrtf(ss * (1.f / 64.f) + EPS); f32x4 g = ((const f32x4*)gk_norm)[l16];
          float v[4] = {x.x * rstd * g.x, x.y * rstd * g.y, x.z * rstd * g.z, x.w * rstd * g.w};
          float vr[4] = {v[0], v[1], v[2], v[3]}; rope64(vr, l16, prow, pcl);
          if (lat) { v[0] = vr[0]; v[1] = vr[1]; v[2] = vr[2]; v[3] = vr[3]; }
          const size_t off = (((size_t)ri.b * 2 + kvh) * TS + ri.sp) * 64 + 4 * l16;
          if (isk) st_bf4(F_KC + off, v[0], v[1], v[2], v[3]); else st_bf4(F_VC + off, x.x, x.y, x.z, x.w); }
    }
}
__device__ __forceinline__ void ph_prepB(Frame& F, int l) {
    OPAQUE_TID(F);
    const int gw = ((F.vcu + F.G / 2) % F.G) * 8 + F.wave, NGW = F.G * 8, lane = F.lane, l32 = lane & 31, d0 = 4 * l32;
    const float* q_norm = F.in[I_MQN] + l * 96; const float* k_norm = F.in[I_MKN] + l * 96;
    f32x4 nkr; uint2 nq[3], nkv[3];
    { const int m0 = gw < M ? gw : 0; nkr = *(const f32x4*)(F_G32 + (size_t)m0 * 64 + 16 + 4 * (lane & 7));
#pragma unroll
      for (int j = 0; j < 3; ++j) { nq[j] = *(const uint2*)(F_QUP + (size_t)m0 * 768 + 256 * j + 4 * lane); nkv[j] = *(const uint2*)(F_KVUP + (size_t)m0 * 768 + 256 * j + 4 * lane); } }
    for (int m = gw; m < M; m += NGW) {
        RowInfo ri = rowinfo(m); const bool lat = !ri.isctx; const int prow = ri.t >> 6, pcl = ri.t & 63;
        f32x4 kr = nkr; if (lane >= 8) kr = (f32x4){0.f, 0.f, 0.f, 0.f};
        uint2 qraw[3], kvraw[3];
#pragma unroll
        for (int j = 0; j < 3; ++j) { qraw[j] = nq[j]; kvraw[j] = nkv[j]; }
        { const int mn = m + NGW < M ? m + NGW : m; nkr = *(const f32x4*)(F_G32 + (size_t)mn * 64 + 16 + 4 * (lane & 7));
#pragma unroll
          for (int j = 0; j < 3; ++j) { nq[j] = *(const uint2*)(F_QUP + (size_t)mn * 768 + 256 * j + 4 * lane); nkv[j] = *(const uint2*)(F_KVUP + (size_t)mn * 768 + 256 * j + 4 * lane); } }
        float krr[4];
        { f32x4 gk = ((const f32x4*)k_norm)[16 + (lane & 7)]; float kv_[4] = {kr.x * gk.x, kr.y * gk.y, kr.z * gk.z, kr.w * gk.w}; float kvr_[4] = {kv_[0], kv_[1], kv_[2], kv_[3]};
          rope32(kvr_, lane & 7, prow, pcl);
#pragma unroll
          for (int i = 0; i < 4; ++i) krr[i] = lat ? kvr_[i] : kv_[i]; }
        float sskr = kr.x * kr.x + kr.y * kr.y + kr.z * kr.z + kr.w * kr.w; sskr = __int_as_float(__builtin_amdgcn_readfirstlane(__float_as_int(sum16(sskr))));
#pragma unroll
        for (int j = 0; j < 3; ++j) {
            const int h = 2 * j + (lane >> 5);
            { f32x4 xq = cvt_bf4(qraw[j]);
              float x[4] = {xq.x, xq.y, xq.z, xq.w}; if (d0 >= 96) { x[0] = x[1] = x[2] = x[3] = 0.f; }
              float ss = x[0] * x[0] + x[1] * x[1] + x[2] * x[2] + x[3] * x[3];
              ss = sum32(ss);
              float rstd = rsqrtf(ss * (1.f / 96.f) + EPS);
              f32x4 g = {0.f, 0.f, 0.f, 0.f}; if (d0 < 96) g = ((const f32x4*)q_norm)[l32];
              float v[4] = {x[0] * rstd * g.x, x[1] * rstd * g.y, x[2] * rstd * g.z, x[3] * rstd * g.w};
              float vr[4] = {v[0], v[1], v[2], v[3]};
              rope32(vr, (l32 - 16) & 7, prow, pcl);
              if (lat && l32 >= 16 && l32 < 24) { v[0] = vr[0]; v[1] = vr[1]; v[2] = vr[2]; v[3] = vr[3]; }
              constexpr float QSB = 0.10206207261596575f * 1.4426950408889634f;
              if (d0 < 96) st_bf4(F_QB + (((size_t)ri.b * 6 + h) * TS + ri.sp) * 96 + d0, v[0] * QSB, v[1] * QSB, v[2] * QSB, v[3] * QSB); }
            { f32x4 xk = cvt_bf4(kvraw[j]);
              float x[4] = {xk.x, xk.y, xk.z, xk.w};
              float ss = d0 < 64 ? (x[0] * x[0] + x[1] * x[1] + x[2] * x[2] + x[3] * x[3]) : 0.f;
              ss = sum32(ss);
              float rstd = rsqrtf((ss + sskr) * (1.f / 96.f) + EPS);
              const size_t kbase = (((size_t)ri.b * 6 + h) * TS + ri.sp) * 96;
              if (d0 < 64) { f32x4 g = ((const f32x4*)k_norm)[l32]; st_bf4(F_KB + kbase + d0, x[0] * rstd * g.x, x[1] * rstd * g.y, x[2] * rstd * g.z, x[3] * rstd * g.w); }
              else { *(uint2*)(F_VB + (((size_t)ri.b * 6 + h) * TS + ri.sp) * 64 + (d0 - 64)) = kvraw[j]; }
#pragma unroll
              for (int hh = 0; hh < 2; ++hh) {
                  const float rs = __int_as_float(hh ? __builtin_amdgcn_readlane(__float_as_int(rstd), 32) : __builtin_amdgcn_readlane(__float_as_int(rstd), 0));
                  if (lane < 8) st_bf4(F_KB + (((size_t)ri.b * 6 + 2 * j + hh) * TS + ri.sp) * 96 + 64 + 4 * lane, krr[0] * rs, krr[1] * rs, krr[2] * rs, krr[3] * rs);
              } }
        }
    }
}
using pg8::Unit;
__device__ __forceinline__ float swg(float g, float u) { return (g * u) * __builtin_amdgcn_rcpf(1.f + __builtin_amdgcn_exp2f(-g)); }
struct EpiSwiglu { static constexpr bool PERM = true, AFTER_DRAIN = false; bf16_t* hid;
    __device__ __forceinline__ void operator()(const pg8::f32x4 (&acc)[2][2][4][2], const Unit& u, int wr, int wc, int fr_, int fq_) const {
        int fr = fr_, fq = fq_; asm volatile("" : "+v"(fr), "+v"(fq));
#ifdef PROBE_EPI2
        for (int rep_ = 0; rep_ < 2; ++rep_) { asm volatile("" ::: "memory");
#endif
        const int row0 = u.pm * 256 + wr * 64 + fr, hc = u.pn * 128 + wc * 32 + 8 * fq;
#pragma unroll
        for (int ai = 0; ai < 2; ++ai)
#pragma unroll
            for (int m = 0; m < 4; ++m) { const pg8::f32x4 g0 = acc[ai][0][m][0], g1 = acc[ai][0][m][1], u0 = acc[ai][1][m][0], u1 = acc[ai][1][m][1];
                u32x4 w; w.x = pg8::cvt_pk_bf16(swg(g0[0], u0[0]), swg(g0[1], u0[1])); w.y = pg8::cvt_pk_bf16(swg(g0[2], u0[2]), swg(g0[3], u0[3]));
                w.z = pg8::cvt_pk_bf16(swg(g1[0], u1[0]), swg(g1[1], u1[1])); w.w = pg8::cvt_pk_bf16(swg(g1[2], u1[2]), swg(g1[3], u1[3]));
                *(u32x4*)(hid + (size_t)(row0 + ai * 128 + m * 16) * DFF + hc) = w; }
#ifdef PROBE_EPI2
        }
#endif
    }
};
struct EpiResid { static constexpr bool PERM = false, AFTER_DRAIN = false; const float* baseL; float* outL; float* slab; const float* modl  ; int gate; float coef;
    __device__ __forceinline__ void operator()(const pg8::f32x4 (&acc)[2][2][4][2], const Unit& u, int wr, int wc, int fr_, int fq_) const {
        int fr = fr_, fq = fq_; asm volatile("" : "+v"(fr), "+v"(fq));
        const int col0 = u.pn * 256 + wc * 32 + 4 * fq;
        if (u.pm >= ML / 256) {
            float* sp = slab + ((size_t)(u.kt0 / u.nt) * MC + (u.pm * 256 - ML) + wr * 64 + fr) * D + col0;
#pragma unroll
            for (int ai = 0; ai < 2; ++ai)
#pragma unroll
                for (int m = 0; m < 4; ++m)
#pragma unroll
                    for (int bj = 0; bj < 2; ++bj)
#pragma unroll
                        for (int n = 0; n < 2; ++n) *(pg8::f32x4*)(sp + (size_t)(ai * 128 + m * 16) * D + bj * 128 + n * 16) = acc[ai][bj][m][n];
            return;
        }
        const int s = u.pm / (T / 256); const int rb = u.pm * 256 + wr * 64 + fr;
        const float* gp = modl + ((size_t)s * 9 + gate) * D;
        pg8::f32x4 gv[2][2];
#pragma unroll
        for (int bj = 0; bj < 2; ++bj)
#pragma unroll
            for (int n = 0; n < 2; ++n) gv[bj][n] = *(const pg8::f32x4*)(gp + col0 + bj * 128 + n * 16) * coef;
#ifdef PROBE_EPIR2
#pragma unroll 1
        for (int rep_ = 0; rep_ < 2; ++rep_) { asm volatile("" ::: "memory"); const float cz = rep_ ? 1.f : 0.f; const float* baseL = rep_ ? this->outL : this->baseL;
#pragma unroll
        for (int ai = 0; ai < 2; ++ai)
#pragma unroll
            for (int m = 0; m < 4; ++m) { const size_t off = (size_t)(rb + ai * 128 + m * 16) * D + col0;
#pragma unroll
                for (int bj = 0; bj < 2; ++bj)
#pragma unroll
                    for (int n = 0; n < 2; ++n) { const pg8::f32x4 bs = *(const pg8::f32x4*)(baseL + off + bj * 128 + n * 16); *(pg8::f32x4*)(outL + off + bj * 128 + n * 16) = bs + gv[bj][n] * cz * acc[ai][bj][m][n]; }
                if (m & 1) asm volatile("" ::: "memory"); }
        }
        return;
#endif
#pragma unroll
        for (int ai = 0; ai < 2; ++ai)
#pragma unroll
            for (int m = 0; m < 4; ++m) { const size_t off = (size_t)(rb + ai * 128 + m * 16) * D + col0;
#pragma unroll
                for (int bj = 0; bj < 2; ++bj)
#pragma unroll
                    for (int n = 0; n < 2; ++n) {
#if defined(RESID_NT)
                        const pg8::f32x4 bs = __builtin_nontemporal_load((const pg8::f32x4*)(baseL + off + bj * 128 + n * 16)); __builtin_nontemporal_store(bs + gv[bj][n] * acc[ai][bj][m][n], (pg8::f32x4*)(outL + off + bj * 128 + n * 16));
#elif defined(RESID_NTL)
                        const pg8::f32x4 bs = __builtin_nontemporal_load((const pg8::f32x4*)(baseL + off + bj * 128 + n * 16)); *(pg8::f32x4*)(outL + off + bj * 128 + n * 16) = bs + gv[bj][n] * acc[ai][bj][m][n];
#else
                        const pg8::f32x4 bs = *(const pg8::f32x4*)(baseL + off + bj * 128 + n * 16); *(pg8::f32x4*)(outL + off + bj * 128 + n * 16) = bs + gv[bj][n] * acc[ai][bj][m][n];
#endif
                    }
                if (m & 1) asm volatile("" ::: "memory"); }
    }
};
__device__ __forceinline__ u32x4 pack8(const pg8::f32x4& a, const pg8::f32x4& b) { u32x4 w; w.x = pg8::cvt_pk_bf16(a[0], a[1]); w.y = pg8::cvt_pk_bf16(a[2], a[3]); w.z = pg8::cvt_pk_bf16(b[0], b[1]); w.w = pg8::cvt_pk_bf16(b[2], b[3]); return w; }
struct EpiInproj { static constexpr bool PERM = true, AFTER_DRAIN = false; bf16_t* pa; float* g32; bf16_t* pb;
    __device__ __forceinline__ void operator()(const pg8::f32x4 (&acc)[2][2][4][2], const Unit& u, int wr, int wc, int fr_, int fq_) const {
        int fr = fr_, fq = fq_; asm volatile("" : "+v"(fr), "+v"(fq));
        const int row0 = u.pm * 256 + wr * 64 + fr, c0 = wc * 32 + 8 * fq;
        if (u.pn == 3) {
            if (wc < 2) {
#pragma unroll
                for (int ai = 0; ai < 2; ++ai)
#pragma unroll
                    for (int m = 0; m < 4; ++m) { float* p = g32 + (size_t)(row0 + ai * 128 + m * 16) * 64 + c0; *(pg8::f32x4*)p = acc[ai][0][m][0]; *(pg8::f32x4*)(p + 4) = acc[ai][0][m][1]; }
            }
            return;
        }
        bf16_t* dst = u.pn < 3 ? pa + (size_t)row0 * 768 + u.pn * 256 + c0 : pb + (size_t)row0 * 1024 + (u.pn - 4) * 256 + c0; const size_t ld = u.pn < 3 ? 768 : 1024;
#pragma unroll
        for (int ai = 0; ai < 2; ++ai)
#pragma unroll
            for (int m = 0; m < 4; ++m)
#pragma unroll
                for (int bj = 0; bj < 2; ++bj) *(u32x4*)(dst + (size_t)(ai * 128 + m * 16) * ld + bj * 128) = pack8(acc[ai][bj][m][0], acc[ai][bj][m][1]);
    }
};
struct EpiUp { static constexpr bool PERM = true, AFTER_DRAIN = false; bf16_t* qup; bf16_t* kvup;
    __device__ __forceinline__ void operator()(const pg8::f32x4 (&acc)[2][2][4][2], const Unit& u, int wr, int wc, int fr_, int fq_) const {
        int fr = fr_, fq = fq_; asm volatile("" : "+v"(fr), "+v"(fq));
        const int row0 = u.pm * 256 + wr * 64 + fr, c0 = wc * 32 + 8 * fq;
        bf16_t* dst = (u.pn < 3 ? qup + u.pn * 256 : kvup + (u.pn - 3) * 256) + (size_t)row0 * 768 + c0;
#pragma unroll
        for (int ai = 0; ai < 2; ++ai)
#pragma unroll
            for (int m = 0; m < 4; ++m)
#pragma unroll
                for (int bj = 0; bj < 2; ++bj) *(u32x4*)(dst + (size_t)(ai * 128 + m * 16) * 768 + bj * 128) = pack8(acc[ai][bj][m][0], acc[ai][bj][m][1]);
    }
};

constexpr int LOCW = 2112, NCS = 68;
#define F_LOC ((float*)(F.ws + WS_LOC))
__device__ __forceinline__ int mls_cs(int isctx, int j, int dir) { return isctx ? (dir ? 3 - j : j) : 4 + (dir ? 63 - j : j); }
template <int NE>
__device__ __forceinline__ void ph_mlstm_m2(Frame& F, int widx, int nw) {
    OPAQUE_TID(F);
    constexpr int TPS = (2080 + NE - 1) / NE;
    const int g = widx * 512 + F.tid; if (g >= 32 * TPS) return;
    const int seq = g / TPS, r = g % TPS;
    float* base = F_LOC + (size_t)seq * NCS * LOCW + r;
    bool ok[NE]; float val[NE]; float m = 0.f;
#pragma unroll
    for (int j = 0; j < NE; ++j) { ok[j] = r + j * TPS < 2080; val[j] = 0.f; }
#pragma unroll 1
    for (int c0 = 0; c0 < NCS; c0 += 17) {
        float bl[17], ml[17], x[NE][17];
#pragma unroll
        for (int i = 0; i < 17; ++i) { const float* p = base + (size_t)(c0 + i) * LOCW; bl[i] = p[2080 - r]; ml[i] = p[2081 - r];
#pragma unroll
            for (int j = 0; j < NE; ++j) x[j][i] = p[ok[j] ? j * TPS : 0]; }
#pragma unroll
        for (int i = 0; i < 17; ++i) { float* p = base + (size_t)(c0 + i) * LOCW;
#pragma unroll
            for (int j = 0; j < NE; ++j) if (ok[j]) p[j * TPS] = val[j];
            if (r == 0) p[2082] = m;
            const float mn = fmaxf(bl[i] + m, ml[i]); const float a = __expf(bl[i] + m - mn), b = __expf(ml[i] - mn);
#pragma unroll
            for (int j = 0; j < NE; ++j) val[j] = a * val[j] + b * x[j][i];
            m = mn; }
    }
}

typedef short bf16x8 __attribute__((ext_vector_type(8)));
typedef short v4i16_t __attribute__((ext_vector_type(4)));
typedef float f32x16 __attribute__((ext_vector_type(16)));
#define MFMA32(a, b, c) __builtin_amdgcn_mfma_f32_32x32x16_bf16((a), (b), (c), 0, 0, 0)
__device__ __forceinline__ int crow(int r, int h) { return (r & 3) + 8 * (r >> 2) + 4 * h; }
__device__ __forceinline__ unsigned cvtpk(float lo, float hi) { typedef float f2_t __attribute__((ext_vector_type(2))); typedef __bf16 b2_t __attribute__((ext_vector_type(2))); f2_t v = {lo, hi}; b2_t b = __builtin_convertvector(v, b2_t); return __builtin_bit_cast(unsigned, b); }
__device__ __forceinline__ v4i16_t vtr(const LAS unsigned char* p) { return __builtin_amdgcn_ds_read_tr16_b64_v4i16((LAS v4i16_t*)p); }
__device__ __forceinline__ float max3f(float a, float b, float c) { float r; asm("v_max3_f32 %0, %1, %2, %3" : "=v"(r) : "v"(a), "v"(b), "v"(c)); return r; }
#ifdef PROBE_MLA2X
constexpr int MLA_NP = 2 * (TS / 128), MLA_WRAP = TS / 128;
#else
constexpr int MLA_NP = TS / 128, MLA_WRAP = 1 << 20;
#endif
constexpr float ATT_THR = 6.0f;

template <int DQK, bool BAND, bool SINK>
__device__ __forceinline__ void attn_unit256(Frame& F, const bf16_t* Qrows, const bf16_t* Kseq, const bf16_t* Vseq, int npairs, int qpos0, float sink2, bf16_t* Yout) {
    constexpr int NCH = DQK / 8, KSTR = DQK * 2 + 16, KST = 128 * KSTR, STAGE = KST + 16384, NKI = (128 * NCH) / 512, NKS = DQK / 16;
    static_assert((128 * NCH) % 512 == 0 && 2 * STAGE <= RING_BYTES, "attention staging / LDS");
    int tid_ = F.tid; asm volatile("" : "+v"(tid_));
    const int tid = tid_, lane = tid_ & 63, wave = F.wave, r32 = lane & 31, h = lane >> 5;
    LAS unsigned char* L = F.lds;
    bf16x8 qf[NKS];
#pragma unroll
    for (int ks = 0; ks < NKS; ++ks) qf[ks] = *(const bf16x8*)(Qrows + (size_t)(32 * wave + r32) * DQK + 16 * ks + 8 * h);
    const f32x16 z16 = {0.f, 0.f, 0.f, 0.f, 0.f, 0.f, 0.f, 0.f, 0.f, 0.f, 0.f, 0.f, 0.f, 0.f, 0.f, 0.f};
    f32x16 o0 = z16, o1 = z16;
    float l_run = (SINK && h == 0) ? __builtin_amdgcn_exp2f(sink2) : 0.f;
    u32x4 kreg[NKI], vreg[2];
#define ATT_SEQ0(p) ((BAND && (p) >= 2) ? (TC + qpos0 - 128 + 128 * ((p) - 2)) : 128 * ((p) % MLA_WRAP))
#define ATT_LOAD(p) do { const int seq0_ = ATT_SEQ0(p); \
        _Pragma("unroll") for (int i_ = 0; i_ < NKI; ++i_) { const int cid = tid + 512 * i_; const int key = cid / NCH, ch = cid % NCH; int sr = seq0_ + key; sr = sr < 0 ? 0 : (sr > TS - 1 ? TS - 1 : sr); \
            kreg[i_] = *(const u32x4*)(Kseq + (size_t)sr * DQK + ch * 8); } \
        _Pragma("unroll") for (int i_ = 0; i_ < 2; ++i_) { const int cid = tid + 512 * i_; const int key = cid >> 3, ch = cid & 7; int sr = seq0_ + key; sr = sr < 0 ? 0 : (sr > TS - 1 ? TS - 1 : sr); \
            vreg[i_] = *(const u32x4*)(Vseq + (size_t)sr * 64 + ch * 8); } } while (0)
#define ATT_STORE(st) do { LAS unsigned char* sb_ = L + (st) * STAGE; \
        _Pragma("unroll") for (int i_ = 0; i_ < NKI; ++i_) { const int cid = tid + 512 * i_; const int key = cid / NCH, ch = cid % NCH; *(LAS u32x4*)(sb_ + key * KSTR + ch * 16) = kreg[i_]; } \
        _Pragma("unroll") for (int i_ = 0; i_ < 2; ++i_) { const int cid = tid + 512 * i_; const int key = cid >> 3, ch = cid & 7; \
            *(LAS u32x4*)(sb_ + KST + (key >> 6) * 8192 + (ch >> 2) * 4096 + (key & 63) * 64 + (ch & 3) * 16) = vreg[i_]; } } while (0)
    ATT_LOAD(0); ATT_STORE(0); if (npairs > 1) ATT_LOAD(1);
    __syncthreads();
    const int trcol = ((lane >> 4) & 1) * 32 + (lane & 3) * 8, q4 = (lane & 15) >> 2;
    const int qpos = qpos0 + 32 * wave + r32;
    if (wave >= 4) __builtin_amdgcn_s_setprio(1);
#pragma unroll 1
    for (int p = 0; p < npairs; ++p) {
        const int st = p & 1;
        bool need = true;
        if (BAND && p >= 2) { const int k0 = qpos0 - 128 + 128 * (p - 2); const int r0 = qpos0 + 32 * wave; need = (k0 <= r0 + 31 + 128) && (k0 + 127 >= r0 - 128) && (k0 + 127 >= 0) && (k0 < T); }
        if (need) {
#ifdef ATT_ROT
            const int boff = (wave >> 2) * 2;
#else
            const int boff = 0;
#endif
            const LAS unsigned char* Kt = L + st * STAGE + r32 * KSTR + 16 * h;
            const LAS unsigned char* Vb = L + st * STAGE + KST + (4 * h + q4) * 64 + trcol;
            f32x16 sa, sb;
            bf16x8 kf[NKS];
#pragma unroll
            for (int ks = 0; ks < NKS; ++ks) kf[ks] = *(const LAS bf16x8*)(Kt + (32 * boff) * KSTR + 32 * ks);
            __builtin_amdgcn_sched_barrier(0);
            sa = MFMA32(kf[0], qf[0], z16);
#pragma unroll
            for (int ks = 1; ks < NKS; ++ks) sa = MFMA32(kf[ks], qf[ks], sa);
            float rs = 0.f;
#pragma unroll
            for (int blk = 0; blk < 4; ++blk) {
                const int bb = (blk + boff) & 3, bn = (blk + 1 + boff) & 3;
                const LAS unsigned char* vp = Vb + (bb >> 1) * 8192 + (32 * (bb & 1)) * 64;
                v4i16_t vl[2][2], vh[2][2];
#pragma unroll
                for (int s = 0; s < 2; ++s) { vl[0][s] = vtr(vp + (16 * s) * 64); vh[0][s] = vtr(vp + (16 * s + 8) * 64); vl[1][s] = vtr(vp + 4096 + (16 * s) * 64); vh[1][s] = vtr(vp + 4096 + (16 * s + 8) * 64); }
                if (blk < 3) {
#pragma unroll
                    for (int ks = 0; ks < NKS; ++ks) kf[ks] = *(const LAS bf16x8*)(Kt + (32 * bn) * KSTR + 32 * ks);
                }
#ifdef PROBE_LDS2
                { bf16x8 dk[NKS];
#pragma unroll
                  for (int ks = 0; ks < NKS; ++ks) { dk[ks] = *(const LAS bf16x8*)(Kt + (32 * bb) * KSTR + 32 * ks); asm volatile("" :: "v"(dk[ks])); } }
#endif
                __builtin_amdgcn_sched_barrier(0);
                if (BAND && p >= 2) {
                    const int kb0 = qpos0 - 128 + 128 * (p - 2) + 32 * bb;
#pragma unroll
                    for (int i = 0; i < 16; ++i) { const int kp = kb0 + crow(i, h); const int d0 = qpos - kp; if (!(kp >= 0 && kp < T && d0 <= 128 && d0 >= -128)) sa[i] = -INFINITY; }
                }
#pragma unroll
                for (int ks = 0; ks < NKS; ++ks) {
                    if (blk < 3) sb = MFMA32(kf[ks], qf[ks], ks == 0 ? z16 : sb);
#ifndef ATT_NOPIN
                    __builtin_amdgcn_sched_barrier(0);
#endif
#pragma unroll
                    for (int i = (16 * ks) / NKS; i < (16 * (ks + 1)) / NKS; ++i) { sa[i] = __builtin_amdgcn_exp2f(sa[i]); rs += sa[i]; }
#ifndef ATT_NOPIN
                    __builtin_amdgcn_sched_barrier(0);
#else
                    __builtin_amdgcn_sched_group_barrier(0x8, 1, 0); __builtin_amdgcn_sched_group_barrier(0x2, 6, 0);
#endif
                }
                bf16x8 pf[2];
#pragma unroll
                for (int s = 0; s < 2; ++s) { u32x4 a = {cvtpk(sa[8 * s], sa[8 * s + 1]), cvtpk(sa[8 * s + 2], sa[8 * s + 3]), cvtpk(sa[8 * s + 4], sa[8 * s + 5]), cvtpk(sa[8 * s + 6], sa[8 * s + 7])}; pf[s] = __builtin_bit_cast(bf16x8, a); }
                __builtin_amdgcn_sched_barrier(0);
#pragma unroll
                for (int s = 0; s < 2; ++s) {
                    const v4i16_t lo0 = vl[0][s], hi0 = vh[0][s], lo1 = vl[1][s], hi1 = vh[1][s];
                    const bf16x8 va0 = {lo0[0], lo0[1], lo0[2], lo0[3], hi0[0], hi0[1], hi0[2], hi0[3]}; const bf16x8 va1 = {lo1[0], lo1[1], lo1[2], lo1[3], hi1[0], hi1[1], hi1[2], hi1[3]};
                    o0 = MFMA32(va0, pf[s], o0); o1 = MFMA32(va1, pf[s], o1);
                }
                if (blk < 3) sa = sb;
            }
            l_run += rs;
        }
        if (p + 1 < npairs) ATT_STORE(st ^ 1);
        if (p + 2 < npairs) ATT_LOAD(p + 2);
        __syncthreads();
    }
#undef ATT_SEQ0
#undef ATT_LOAD
#undef ATT_STORE
    if (wave >= 4) __builtin_amdgcn_s_setprio(0);
    {
        const float inv = 1.f / xor32_sum(l_run);
        LAS unsigned char* osc = L + wave * (32 * 144) + r32 * 144;
#pragma unroll
        for (int i = 0; i < 16; i += 2) { *(LAS unsigned*)(osc + crow(i, h) * 2) = cvtpk(o0[i] * inv, o0[i + 1] * inv); *(LAS unsigned*)(osc + (32 + crow(i, h)) * 2) = cvtpk(o1[i] * inv, o1[i + 1] * inv); }
        LDS_WAIT();
        const LAS unsigned char* osr = L + wave * (32 * 144);
#pragma unroll
        for (int i = 0; i < 4; ++i) { const int row = i * 8 + (lane >> 3), ch = lane & 7; const u32x4 v = *(const LAS u32x4*)(osr + row * 144 + ch * 16);
            *(u32x4*)(Yout + (size_t)(32 * wave + row) * D + ch * 8) = v; }
    }
    __syncthreads();
}

__device__ __forceinline__ void mlstm_m1_mfma(Frame& F, int l, int item) {
    constexpr int KT = 0, VT = 4096, SW = 12288, SST = 12800;
    int tid_ = F.tid; asm volatile("" : "+v"(tid_)); const int tid = tid_, lane = tid & 63, wave = F.wave, hh = lane >> 5;
    LAS unsigned char* L = F.lds;
    int isctx, b, h, j;
    if (item < 1024) { isctx = 0; b = item >> 8; h = (item >> 6) & 3; j = item & 63; } else { const int r = item - 1024; isctx = 1; b = r >> 4; h = (r >> 2) & 3; j = r & 3; }
    const int rbase = (isctx ? ML + b * TC : b * T) + 64 * j;
    const float* gate_b = F.in[I_GATEB] + l * 16;
    if (tid < 256) { const int tok = tid >> 2, ch = tid & 3; *(LAS u32x4*)(L + KT + tok * 64 + ch * 16) = *(const u32x4*)(F_P16A + (size_t)(rbase + tok) * 768 + 128 + h * 32 + ch * 8); }
    { const int tok = tid >> 3, ch = tid & 7; *(LAS u32x4*)(L + VT + (ch >> 2) * 4096 + tok * 64 + (ch & 3) * 16) = *(const u32x4*)(F_P16A + (size_t)(rbase + tok) * 768 + 256 + h * 64 + ch * 8); }
    if (wave < 2) {
        const int dir = wave, p = lane, tok = dir ? 63 - p : p; const int gi = dir ? 2 : 0;
        const float* pr = F_G32 + (size_t)(rbase + tok) * 64; const float ig = pr[gi * 4 + h] + gate_b[gi * 4 + h]; const float lf = logsigmoidf_(pr[(gi + 1) * 4 + h] + gate_b[(gi + 1) * 4 + h]);
        const float v = scan_sum64(lf); const float blast = lane_bcast(v, 63); const float g = blast - v + ig; const float gm = lane_bcast(scan_max64(g), 63);
        ((LAS float*)(L + SW))[dir * 64 + tok] = __expf(g - gm);
        if (p == 0) { ((LAS float*)(L + SST))[2 * dir] = blast; ((LAS float*)(L + SST))[2 * dir + 1] = gm; }
    }
    __syncthreads();
    if (wave < 4) {
        const int dir = wave >> 1, eb = wave & 1;
        const int trcol = ((lane >> 4) & 1) * 32 + (lane & 3) * 8, q4 = (lane & 15) >> 2;
        const LAS float* wp = (const LAS float*)(L + SW) + dir * 64;
        const f32x16 z16 = {0.f, 0.f, 0.f, 0.f, 0.f, 0.f, 0.f, 0.f, 0.f, 0.f, 0.f, 0.f, 0.f, 0.f, 0.f, 0.f};
        f32x16 acc = z16, accn = z16;
        const bf16x8 ones = {0x3f80, 0x3f80, 0x3f80, 0x3f80, 0x3f80, 0x3f80, 0x3f80, 0x3f80};
#pragma unroll
        for (int ks = 0; ks < 4; ++ks) {
            const int s0 = 16 * ks + 8 * hh;
            const v4i16_t klo = vtr(L + KT + (s0 + q4) * 64 + trcol), khi = vtr(L + KT + (s0 + 4 + q4) * 64 + trcol);
            const v4i16_t vlo = vtr(L + VT + eb * 4096 + (s0 + q4) * 64 + trcol), vhi = vtr(L + VT + eb * 4096 + (s0 + 4 + q4) * 64 + trcol);
            const f32x4 w0 = *(const LAS f32x4*)(wp + s0), w1 = *(const LAS f32x4*)(wp + s0 + 4);
            u32x4 aw; aw.x = cvtpk(bf2f((bf16_t)klo[0]) * w0[0], bf2f((bf16_t)klo[1]) * w0[1]); aw.y = cvtpk(bf2f((bf16_t)klo[2]) * w0[2], bf2f((bf16_t)klo[3]) * w0[3]);
            aw.z = cvtpk(bf2f((bf16_t)khi[0]) * w1[0], bf2f((bf16_t)khi[1]) * w1[1]); aw.w = cvtpk(bf2f((bf16_t)khi[2]) * w1[2], bf2f((bf16_t)khi[3]) * w1[3]);
            const bf16x8 af = __builtin_bit_cast(bf16x8, aw); const bf16x8 vf = {vlo[0], vlo[1], vlo[2], vlo[3], vhi[0], vhi[1], vhi[2], vhi[3]};
            acc = MFMA32(af, vf, acc);
            if (eb == 0) accn = MFMA32(af, ones, accn);
        }
        float* Lp = F_LOC + ((size_t)((b * 4 + h) * 2 + dir) * NCS + mls_cs(isctx, j, dir)) * LOCW;
        const int e = 32 * eb + (lane & 31);
#pragma unroll
        for (int i = 0; i < 16; ++i) Lp[crow(i, hh) * 64 + e] = acc[i];
        if (eb == 0) {
            if ((lane & 31) == 0) {
#pragma unroll
                for (int i = 0; i < 16; ++i) Lp[2048 + crow(i, hh)] = accn[i];
            }
            if (lane == 0) { Lp[2080] = ((LAS float*)(L + SST))[2 * dir]; Lp[2081] = ((LAS float*)(L + SST))[2 * dir + 1]; }
        }
    }
    __syncthreads();
}
__device__ __forceinline__ void ph_mlstm_m1b(Frame& F, int l) { for (int it = F.vcu; it < 1024 + 64; it += F.G) mlstm_m1_mfma(F, l, it); }

__device__ __forceinline__ void mlstm_m3_mfma(Frame& F, int l, int item0) {
    constexpr int KT = 0, VT = 5120, CT = 13312, SN = 23552, SU = 23808, SM = 24320, SB = 24832, SMST = 25344, HB = 25600, HALFB = 45056;
    constexpr float QS = 0.17677669529663687f;
    int tid_ = F.tid; asm volatile("" : "+v"(tid_)); const int tid = tid_, lane = tid & 63, wave = F.wave, r32 = lane & 31, hh = lane >> 5;
    const int half = wave >> 2, hw = wave & 3, htid = tid & 255, tb = hw >> 1, eb = hw & 1;
    LAS unsigned char* L = F.lds + half * HALFB;
    const int item = item0 + half;
    int isctx, b, h, j;
    if (item < 1024) { isctx = 0; b = item >> 8; h = (item >> 6) & 3; j = item & 63; } else { const int r = item - 1024; isctx = 1; b = r >> 4; h = (r >> 2) & 3; j = r & 3; }
    const int rbase = (isctx ? ML + b * TC : b * T) + 64 * j;
    const float* gate_b = F.in[I_GATEB] + l * 16;
    const float* stf = F_LOC + ((size_t)((b * 4 + h) * 2) * NCS + mls_cs(isctx, j, 0)) * LOCW; const float* stb = F_LOC + ((size_t)((b * 4 + h) * 2 + 1) * NCS + mls_cs(isctx, j, 1)) * LOCW;
    bf16x8 qf[2][2];
#pragma unroll
    for (int dir = 0; dir < 2; ++dir) { const int tposq = 32 * (dir ? 1 - tb : tb) + r32; const int ttokq = dir ? 63 - tposq : tposq;
#pragma unroll
        for (int ks = 0; ks < 2; ++ks) qf[dir][ks] = *(const bf16x8*)(F_P16A + (size_t)(rbase + ttokq) * 768 + h * 32 + 16 * ks + 8 * hh); }
    { const int tok = htid >> 2, ch = htid & 3; *(LAS u32x4*)(L + KT + tok * 80 + ch * 16) = *(const u32x4*)(F_P16A + (size_t)(rbase + tok) * 768 + 128 + h * 32 + ch * 8); }
#pragma unroll
    for (int i = 0; i < 2; ++i) { const int cid = htid + 256 * i, tok = cid >> 3, ch = cid & 7; *(LAS u32x4*)(L + VT + (ch >> 2) * 4096 + tok * 64 + (ch & 3) * 16) = *(const u32x4*)(F_P16A + (size_t)(rbase + tok) * 768 + 256 + h * 64 + ch * 8); }
#pragma unroll
    for (int dir = 0; dir < 2; ++dir) { const float* st = dir ? stb : stf;
#pragma unroll
        for (int i = 0; i < 2; ++i) { const int idx = htid + 256 * i, d = idx >> 4, e0 = (idx & 15) * 4; const f32x4 c = *(const f32x4*)(st + d * 64 + e0);
            LAS unsigned char* cp = L + CT + dir * 5120 + e0 * 80 + d * 2;
            *(LAS bf16_t*)(cp) = f2bf(c.x); *(LAS bf16_t*)(cp + 80) = f2bf(c.y); *(LAS bf16_t*)(cp + 160) = f2bf(c.z); *(LAS bf16_t*)(cp + 240) = f2bf(c.w); } }
    if (htid < 64) { const int dir = htid >> 5, d = htid & 31; ((LAS float*)(L + SN))[dir * 32 + d] = (dir ? stb : stf)[2048 + d]; }
    if (hw < 2) { const int dir = hw, p = lane, tok = dir ? 63 - p : p; const int gi = dir ? 2 : 0;
        const float* pr = F_G32 + (size_t)(rbase + tok) * 64; const float ig = pr[gi * 4 + h] + gate_b[gi * 4 + h]; const float lf = logsigmoidf_(pr[(gi + 1) * 4 + h] + gate_b[(gi + 1) * 4 + h]);
        const float v = scan_sum64(lf);
        const float u0 = ig - v; const float cm = scan_max64(u0);
        const float m = (dir ? stb : stf)[2082];
        ((LAS float*)(L + SU))[dir * 64 + p] = u0; ((LAS float*)(L + SM))[dir * 64 + p] = fmaxf(m, cm); ((LAS float*)(L + SB))[dir * 64 + p] = v;
        if (p == 0) ((LAS float*)(L + SMST))[dir] = m; }
    const u32x4 og0 = *(const u32x4*)(F_P16A + (size_t)(rbase + (htid >> 2)) * 768 + 512 + h * 64 + (htid & 3) * 16), og1 = *(const u32x4*)(F_P16A + (size_t)(rbase + (htid >> 2)) * 768 + 512 + h * 64 + (htid & 3) * 16 + 8);
    __syncthreads();
    const int trcol = ((lane >> 4) & 1) * 32 + (lane & 3) * 8, q4 = (lane & 15) >> 2;
#pragma unroll
    for (int dir = 0; dir < 2; ++dir) {
        const int tbd = dir ? 1 - tb : tb; const int tpos = 32 * tbd + r32; const int ttok = dir ? 63 - tpos : tpos;
        const float Mt = ((LAS float*)(L + SM))[dir * 64 + tpos], bt = ((LAS float*)(L + SB))[dir * 64 + tpos], mst = ((LAS float*)(L + SMST))[dir];
        float nq = 0.f;
#pragma unroll
        for (int ks = 0; ks < 2; ++ks) { const LAS float* np = (LAS float*)(L + SN) + dir * 32 + 16 * ks + 8 * hh;
#pragma unroll
            for (int jj = 0; jj < 8; ++jj) nq += bf2f((bf16_t)qf[dir][ks][jj]) * np[jj]; }
        nq = xor32_sum(nq);
        const float at = __expf(mst - Mt) * QS;
        f32x16 o;
#pragma unroll
        for (int i = 0; i < 16; ++i) o[i] = 0.f;
#pragma unroll
        for (int ks = 0; ks < 2; ++ks) { const bf16x8 cf = *(const LAS bf16x8*)(L + CT + dir * 5120 + (32 * eb + r32) * 80 + (16 * ks + 8 * hh) * 2); o = MFMA32(cf, qf[dir][ks], o); }
#pragma unroll
        for (int i = 0; i < 16; ++i) o[i] *= at;
        float rs = 0.f;
#pragma unroll
        for (int sb = 0; sb < 2; ++sb) {
            if (sb <= tbd) {
                const int srow = 32 * sb + r32; const int stok = dir ? 63 - srow : srow;
                f32x16 s;
#pragma unroll
                for (int i = 0; i < 16; ++i) s[i] = 0.f;
#pragma unroll
                for (int ks = 0; ks < 2; ++ks) { const bf16x8 kf = *(const LAS bf16x8*)(L + KT + stok * 80 + (16 * ks + 8 * hh) * 2); s = MFMA32(kf, qf[dir][ks], s); }
#pragma unroll
                for (int g = 0; g < 4; ++g) { const f32x4 uv = *(const LAS f32x4*)((LAS float*)(L + SU) + dir * 64 + 32 * sb + 8 * g + 4 * hh);
#pragma unroll
                    for (int c = 0; c < 4; ++c) { const int spos = 32 * sb + 8 * g + 4 * hh + c; const float w = spos <= tpos ? __expf(uv[c] - Mt) * QS : 0.f; const float sw = s[4 * g + c] * w; s[4 * g + c] = sw; rs += sw; } }
#pragma unroll
                for (int s2 = 0; s2 < 2; ++s2) {
                    u32x4 pw = {cvtpk(s[8 * s2], s[8 * s2 + 1]), cvtpk(s[8 * s2 + 2], s[8 * s2 + 3]), cvtpk(s[8 * s2 + 4], s[8 * s2 + 5]), cvtpk(s[8 * s2 + 6], s[8 * s2 + 7])};
                    const bf16x8 pf = __builtin_bit_cast(bf16x8, pw);
                    const int p0 = 32 * sb + 16 * s2 + 4 * hh + q4, p1 = p0 + 8; const int t0 = dir ? 63 - p0 : p0, t1 = dir ? 63 - p1 : p1;
                    const v4i16_t lo = vtr(L + VT + eb * 4096 + t0 * 64 + trcol), hi = vtr(L + VT + eb * 4096 + t1 * 64 + trcol);
                    const bf16x8 va = {lo[0], lo[1], lo[2], lo[3], hi[0], hi[1], hi[2], hi[3]};
                    o = MFMA32(va, pf, o);
                }
            }
        }
        rs = xor32_sum(rs);
        const float den = (at * nq) + rs; const float idn = 1.f / fmaxf(fabsf(den), __expf(-(bt + Mt)));
        LAS float* hp = (LAS float*)(L + HB) + ttok * 65 + 32 * eb;
        if (dir == 0) {
#pragma unroll
            for (int i = 0; i < 16; ++i) hp[crow(i, hh)] = o[i] * idn;
        } else {
#pragma unroll
            for (int i = 0; i < 16; ++i) hp[crow(i, hh)] += o[i] * idn;
        }
    }
    __syncthreads();
    { const int t = htid >> 2, e0 = (htid & 3) * 16; const float* out_norm = F.in[I_OUTNORM] + l * 256 + h * 64 + e0; float hv[16]; float ss = 0.f;
      const LAS float* hb = (LAS float*)(L + HB) + t * 65 + e0;
#pragma unroll
      for (int i = 0; i < 16; ++i) { hv[i] = hb[i]; ss += hv[i] * hv[i]; }
      ss += dpp_f<0xB1>(ss); ss += dpp_f<0x4E>(ss);
      const float rstd = rsqrtf(ss * (1.f / 64.f) + EPS);
      const unsigned ogw[8] = {og0.x, og0.y, og0.z, og0.w, og1.x, og1.y, og1.z, og1.w};
      unsigned ow[8];
#pragma unroll
      for (int i = 0; i < 8; ++i) { const float g0 = __uint_as_float(ogw[i] << 16), g1 = __uint_as_float(ogw[i] & 0xffff0000u);
          const float r0 = hv[2 * i] * rstd * out_norm[2 * i] * __builtin_amdgcn_rcpf(1.f + __expf(-g0)), r1 = hv[2 * i + 1] * rstd * out_norm[2 * i + 1] * __builtin_amdgcn_rcpf(1.f + __expf(-g1));
          ow[i] = cvtpk(r0, r1); }
      u32x4 w0 = {ow[0], ow[1], ow[2], ow[3]}, w1 = {ow[4], ow[5], ow[6], ow[7]};
      bf16_t* yp = F_Y + (size_t)(rbase + t) * D + h * 64 + e0; *(u32x4*)yp = w0; *(u32x4*)(yp + 8) = w1; }
    __syncthreads();
}

__device__ __forceinline__ void attn_dispatch(Frame& F, int l, int idx) {
    constexpr float LOG2E = 1.4426950408889634f;
    if (idx < 384) { const int bh6 = idx >> 4, qb = idx & 15; const int b = bh6 / 6, h = bh6 % 6; const size_t bh = (size_t)bh6;
        attn_unit256<96, false, false>(F, F_QB + (bh * TS + TC + 256 * qb) * 96, F_KB + bh * TS * 96, F_VB + bh * TS * 64, MLA_NP, 0, 0.f, F_Y + (size_t)(b * T + 256 * qb) * D + 256 + h * 64); return; }
    idx -= 384;
    if (idx < 384) { const int bh6 = idx >> 4, qb = idx & 15; const int b = bh6 / 6, hq = bh6 % 6; const int kvh = hq / 3; const size_t bk = (size_t)b * 2 + kvh;
        attn_unit256<64, true, true>(F, F_QC + ((size_t)bh6 * TS + TC + 256 * qb) * 64, F_KC + bk * TS * 64, F_VC + bk * TS * 64, 6, 256 * qb, F.in[I_SINK][l * 6 + hq] * LOG2E, F_Y + (size_t)(b * T + 256 * qb) * D + 640 + hq * 64); return; }
    idx -= 384;
    if (idx < 24) { const int b = idx / 6, h = idx % 6; const size_t bh = (size_t)idx;
        attn_unit256<96, false, false>(F, F_QB + (bh * TS) * 96, F_KB + bh * TS * 96, F_VB + bh * TS * 64, 2, 0, 0.f, F_Y + (size_t)(ML + b * TC) * D + 256 + h * 64); return; }
    idx -= 24;
    { const int b = idx / 6, hq = idx % 6; const int kvh = hq / 3; const size_t bk = (size_t)b * 2 + kvh;
        attn_unit256<64, false, true>(F, F_QC + ((size_t)idx * TS) * 64, F_KC + bk * TS * 64, F_VC + bk * TS * 64, 2, 0, F.in[I_SINK][l * 6 + hq] * LOG2E, F_Y + (size_t)(ML + b * TC) * D + 640 + hq * 64); }
}
constexpr int CW_Q = 8192;
__device__ __forceinline__ void mix_unit(Frame& F, int l, int x, int li) {
    int idx; bool m3 = false; const int b = x >> 1, kvh = x & 1;
    if (li < 48) idx = (x + 8 * (li >> 4)) * 16 + (li & 15);
    else if (li < 96) { const int r = li - 48; idx = 384 + (b * 6 + kvh * 3 + (r >> 4)) * 16 + (r & 15); }
    else if (li < 160) { m3 = true; idx = x * 128 + 2 * (li - 96); }
    else if (li < 164) { m3 = true; idx = 1024 + x * 8 + 2 * (li - 160); }
    else if (li < 167) idx = 768 + x + 8 * (li - 164);
    else idx = 792 + b * 6 + kvh * 3 + (li - 167);
    if (m3) mlstm_m3_mfma(F, l, idx); else attn_dispatch(F, l, idx);
}
__device__ __forceinline__ void ph_mixers(Frame& F, int l, int rep) {
    OPAQUE_TID(F);
    const bool need_ctx = l + 1 < DEPTH;
    const int nloc = 160 + (need_ctx ? 10 : 0);
    unsigned* ctr0 = (unsigned*)(F.ws + WS_CTL) + CW_Q + 64 * 8 * (l + 2 * rep);
    volatile LAS int* slot = (volatile LAS int*)(F.lds + MISC_OFF + 64);
    const int x0 = (int)(xb_xcc_id() & 7u);
    for (int xs = 0; xs < 8; ++xs) {
        const int x = (x0 + xs) & 7;
        for (;;) {
            if (F.tid == 0) slot[0] = (int)__hip_atomic_fetch_add(ctr0 + 64 * x, 1u, __ATOMIC_RELAXED, __HIP_MEMORY_SCOPE_AGENT);
            __syncthreads();
            const int li = slot[0];
            __syncthreads();
            if (li >= nloc) break;
            mix_unit(F, l, x, li);
        }
    }
}

__global__ void __launch_bounds__(512, 2) fwd_mk(Args args) {
    extern __shared__ __attribute__((aligned(16))) unsigned char lds[];
    Frame F;
    F.lds = (LAS unsigned char*)lds;
    volatile LAS unsigned* MISC = (volatile LAS unsigned*)(F.lds + MISC_OFF);
    F.tid = threadIdx.x; F.lane = F.tid & 63; F.wave = __builtin_amdgcn_readfirstlane(F.tid >> 6);
    F.G = gridDim.x; { const int bx = blockIdx.x; F.vcu = (F.G % 8 == 0) ? (bx % 8) * (F.G / 8) + bx / 8 : bx; }
    F.in = args.in; F.out = args.out; F.ws = args.ws; unsigned char* ws = args.ws;
    for (int u = F.tid; u < (LDS_BYTES - LDSCTL_OFF) / 4; u += 512) ((LAS unsigned*)(F.lds + LDSCTL_OFF))[u] = 0u;
    __syncthreads();
    gu32* ctl = (gu32*)(ws + WS_CTL);
    XcdBarrier bar; bar.bar = (unsigned*)(ctl + CW_BAR); bar.x = 0; bar.st = nullptr;
    if (MK_N_LAUNCHES == 1) bar = xcd_barrier_post((unsigned*)(ctl + CW_BAR), MISC + 8);

    const int lo = args.ph_lo, hi = args.ph_hi;
    int rep = 0;
    for (int ph = lo; ph < hi; ++ph) {
        {
        int cv_l0 = 0, cv_r0 = 0, cv_n0 = 0, cv_nt = 0, cv_gw = 0, cv_ngw = 1;
        if (ph == 0) { p0_prologue(F);
            if (F.G == 256 && F.vcu >= 64) { cv_n0 = CV_P0; cv_nt = CV_P0; cv_gw = (F.vcu - 64) * 8 + F.wave; cv_ngw = 192 * 8; } }
        else {
            const int l = (ph - 1) / 13, sp = (ph - 1) % 13;
            const float* modl = F_MOD + (size_t)l * 5 * 9 * D;
            const bool first = (l == 0 && sp <= 2);
            const float* xl = first ? F.in[I_X] : F.out;
            const int Mrows = (l + 1 == DEPTH && sp >= 9) ? ML : M;
            float* slabD = (float*)(F.ws + WS_QUP); float* slabO = (float*)(F.ws + WS_QUP + 34 * MiB);
            switch (sp) {
            case 0: case 3: case 10: {
                int npend = 0; const float* pg = F_MOD; float pc = 0.f; const float* sl = slabD;
                if (sp == 0 && l > 0) { npend = 11; pg = modp(F_MOD, l - 1, 4, 8); pc = 0.5f; }
                if (sp == 3) { npend = 11; pg = modp(F_MOD, l, 4, 2); pc = 0.5f; }
                if (sp == 10 && Mrows == M) { npend = 4; pg = modp(F_MOD, l, 4, 5); pc = 1.0f; sl = slabO; }
                ph_modulate(F, xl, l, sp == 0 ? 0 : (sp == 3 ? 1 : 2), Mrows, rep ? 0 : npend, sl, pg, pc);
                if (l == 0 && sp == 0) {
                    static_assert(DEPTH == 2, "conversion lists");
                    const bool hosted = (F.G == 256); cv_r0 = hosted ? CV_P0 : 0; cv_n0 = hosted ? CV_NA - CV_P0 : CV_NA + CV_NB; cv_nt = hosted ? CV_NA - CV_P0 : 2 * (CV_NA + CV_NB); cv_gw = F.vcu * 8 + F.wave; cv_ngw = F.G * 8; } } break;
            case 1: case 11: {
                pg8::Gemm g{F_XN, F.wl(l, sp == 1 ? W_1I : W_2I), Mrows, 2 * DFF, D}; pg8::StaticOrder S; S.init(Mrows, 2 * DFF, F.G, (int)blockIdx.x, D);
                EpiSwiglu E{F_HID};
                #ifdef UP_SP2_OFF
                pg8::gemm_phase<EpiSwiglu, pg8::StaticOrder, true, false>(F.lds + RING_OFF, g, S, E);
#elif defined(UP_ALIGN_OFF)
                pg8::gemm_phase<EpiSwiglu, pg8::StaticOrder, false, true>(F.lds + RING_OFF, g, S, E);
#else
                pg8::gemm_phase<EpiSwiglu, pg8::StaticOrder, true, true>(F.lds + RING_OFF, g, S, E);
#endif
                } break;
            case 2: case 12: case 9: {
                const bool isout = sp == 9; const int K = isout ? D : DFF;
                pg8::Gemm g{isout ? F_Y : F_HID, F.wl(l, isout ? W_OUT : (sp == 2 ? W_1O : W_2O)), Mrows, D, K}; pg8::SplitOrder S; S.init(D, K, F.G, (int)blockIdx.x, Mrows == M ? (isout ? 4 : 11) : 0);
                EpiResid E{xl, F.out, isout ? slabO : slabD, modl, isout ? 5 : (sp == 2 ? 2 : 8), isout ? 1.0f : 0.5f};
#ifdef PROBE_DUP
                if (rep == 0 && sp == PROBE_DUP) E.coef = 0.f;
#endif
                pg8::gemm_phase<EpiResid, pg8::SplitOrder, true, true>(F.lds + RING_OFF, g, S, E); } break;
            case 4: {
                const bool split = (F.G == 256); const int Gg = split ? 184 : F.G;
                if ((int)blockIdx.x >= Gg) { cv_l0 = l; cv_r0 = CV_NA; cv_n0 = CV_NB; cv_nt = CV_NB + (l + 1 < DEPTH ? CV_NA : 0); cv_gw = ((int)blockIdx.x - Gg) * 8 + F.wave; cv_ngw = (F.G - Gg) * 8; break; }
                pg8::Gemm g{F_XN, F.wl(l, W_IN), M, 2048, D}; pg8::StaticOrder S; S.init(M, 2048, Gg, (int)blockIdx.x, D);
                EpiInproj E{F_P16A, F_G32, F_P16B};
                pg8::gemm_phase<EpiInproj, pg8::StaticOrder, true, true>(F.lds + RING_OFF, g, S, E); } break;
            case 5: { ph_prepA(F, l);
#ifdef PROBE_PREPA2
                __syncthreads(); ph_prepA(F, l);
#endif
                __syncthreads(); ph_mlstm_m1b(F, l);
#ifdef PROBE_M1X2
                __syncthreads(); ph_mlstm_m1b(F, l);
#endif
                } break;
            case 6: {
                const int Gg = (F.G == 256) ? 204 : F.G;
                if ((int)blockIdx.x >= Gg) { ph_mlstm_m2<3>(F, (int)blockIdx.x - Gg, F.G - Gg); break; }
                pg8::Gemm g{F_CKN, F.wl(l, W_UP), M, 1536, 384}; pg8::UpOrder S; S.init(Gg, (int)blockIdx.x);
                EpiUp E{F_QUP, F_KVUP};
                pg8::gemm_phase<EpiUp, pg8::UpOrder, true, true>(F.lds + RING_OFF, g, S, E); } break;
            case 7: { if (F.G != 256) ph_mlstm_m2<1>(F, F.vcu, F.G); ph_prepB(F, l);
#ifdef PROBE_PREPB2
                __syncthreads(); ph_prepB(F, l);
#endif
                } break;
            case 8: { ph_mixers(F, l, rep); } break;
            default: break;
            }
        }
        if (cv_nt > 0) { __syncthreads(); p0_weights(F, cv_l0, cv_r0, cv_n0, cv_nt, cv_gw, cv_ngw); }
        }
#ifdef PROBE_DUP
        if (rep == 0 && ((ph > 0 && (ph - 1) % 13 == PROBE_DUP) || (ph == 0 && PROBE_DUP == 100))) { rep = 1; --ph; xcd_barrier(bar); continue; }
        rep = 0;
#endif
        if (ph + 1 < hi) xcd_barrier(bar);
    }
}

extern "C" void kernel_launch(void* const* d_in, const int* in_sizes, int n_in, void* d_out, int out_size, void* d_ws, size_t ws_size, hipStream_t stream) {
    static int grid = 0;
    if (grid == 0) {
        if (n_in != 24 || ws_size < WS_END) { fprintf(stderr, "kernel_launch: unexpected n_in %d or ws_size %zu (< %zu)\n", n_in, ws_size, (size_t)WS_END); grid = -1; return; }
        int dev = 0, cus = 0, per_cu = 0;
        if (hipGetDevice(&dev) != hipSuccess || hipDeviceGetAttribute(&cus, hipDeviceAttributeMultiprocessorCount, dev) != hipSuccess) { grid = -1; return; }
        if (hipFuncSetAttribute((const void*)fwd_mk, hipFuncAttributeMaxDynamicSharedMemorySize, LDS_BYTES) != hipSuccess) { fprintf(stderr, "kernel_launch: hipFuncSetAttribute failed\n"); grid = -1; return; }
        if (hipOccupancyMaxActiveBlocksPerMultiprocessor(&per_cu, (const void*)fwd_mk, 512, LDS_BYTES) != hipSuccess || per_cu < 1) fprintf(stderr, "kernel_launch: occupancy query says %d per CU\n", per_cu);
        (void)hipGetLastError();
        grid = cus;
    }
    if (grid < 0) return;
    (void)hipMemsetAsync((char*)d_ws + WS_CTL, 0, CTL_ZERO_BYTES, stream);
    Args a{};
    for (int i = 0; i < 24; ++i) a.in[i] = (const float*)d_in[i];
    a.out = (float*)d_out; a.ws = (unsigned char*)d_ws;
#if MK_N_LAUNCHES == 1
    a.ph_lo = 0; a.ph_hi = NPH;
    hipLaunchKernelGGL(fwd_mk, dim3(grid), dim3(512), LDS_BYTES, stream, a);
#else
    for (int p = 0; p < NPH; ++p) { a.ph_lo = p; a.ph_hi = p + 1; hipLaunchKernelGGL(fwd_mk, dim3(grid), dim3(512), LDS_BYTES, stream, a); }
#endif
}
```

```cpp
#include <hip/hip_runtime.h>
#include <cstdio>
#include <cstdint>
#define MK_N_LAUNCHES 1
namespace pg8 {
#define PG8_LAS __attribute__((address_space(3)))
typedef unsigned short bf16_t;
typedef short bf16x8 __attribute__((ext_vector_type(8)));
typedef float f32x4 __attribute__((ext_vector_type(4)));
typedef unsigned u32x4 __attribute__((ext_vector_type(4)));
constexpr int BM = 256, BK = 64, HALF = 128, HTB = HALF * BK * 2  , STAGE_BYTES = 8 * HTB, NXCD = 8, WGM = 8;

__host__ __device__ __forceinline__ int lds_byte(int r, int c) { const int st = (r >> 4) * 2 + (c >> 5), rr = r & 15, cc = c & 31, ob = rr * 64 + cc * 2; return st * 1024 + (ob ^ (((ob >> 9) & 1) << 5)); }
__host__ __device__ __forceinline__ void stage_rc(int b, int& R, int& C) { const int st = b / 1024, sb = b % 1024, swz = sb ^ (((sb >> 9) & 1) << 5); R = (st >> 1) * 16 + swz / 64; C = (st & 1) * 32 + (swz % 64) / 2; }
__host__ __device__ __forceinline__ int perm32(int rho) { const int n = rho >> 4, i = rho & 15; return 8 * (i >> 2) + 4 * n + (i & 3); }

struct Unit { int pm, pn, kt0, nt, half; };
struct Gemm { const bf16_t* A; const bf16_t* Bt; int M, N, K; };

struct StaticOrder {
    int nM, nN, nwg, G, c, ntK;
    __host__ __device__ void init(int M, int N, int G_, int c_, int K_) { nM = M / BM; nN = N / BM; nwg = nM * nN; G = G_; c = c_; ntK = K_ / BK; }
    __host__ __device__ bool next(int i, Unit& u) const {
        const long L = (long)i * G + c; if (L >= nwg) return false;
        int wgid = (int)L; { const int q = nwg / NXCD, r = nwg % NXCD, xcd = wgid % NXCD, off = wgid / NXCD; wgid = (xcd < r ? xcd * (q + 1) : r * (q + 1) + (xcd - r) * q) + off; }
        const int nig = WGM * nN, gid = wgid / nig, fm = gid * WGM, gsz = (nM - fm) < WGM ? (nM - fm) : WGM;
        u.pm = fm + ((wgid % nig) % gsz); u.pn = (wgid % nig) / gsz; u.kt0 = 0; u.nt = ntK; u.half = 0; return true;
    }
    __device__ __forceinline__ void a_ready(const Unit&) const {}
    __device__ __forceinline__ void done(const Unit&) const {}
};

struct SplitOrder {
    StaticOrder lat; int NS, ntS;
    __host__ __device__ void init(int N, int K, int G_, int c_, int NS_) { lat.init(16384, N, G_, c_, K); NS = NS_; ntS = NS_ ? (K / BK) / NS_ : 0; }
    __host__ __device__ bool next(int i, Unit& u) const {
        if (lat.G == lat.nwg && i < 2 && lat.c < 16 * NS) i = 1 - i;
        const long L = (long)i * lat.G + lat.c; if (L < lat.nwg) return lat.next(i, u);
        const int idx = (int)(L - lat.nwg); if (idx >= 16 * NS) return false;
        const int tile = idx / NS, sl = idx % NS; u.pm = 64 + (tile >> 2); u.pn = tile & 3; u.kt0 = sl * ntS; u.nt = ntS; u.half = 0; return true;
    }
    __device__ __forceinline__ void a_ready(const Unit&) const {}
    __device__ __forceinline__ void done(const Unit&) const {}
};

struct InprojOrder {
    StaticOrder full7; int G, c;
    __host__ __device__ void init(int G_, int c_, int K) { full7.init(17408, 7 * 256, G_, c_, K); G = G_; c = c_; }
    __host__ __device__ bool next(int i, Unit& u) const {
        if (G != 256) { if (i > 0) return false; u.pm = 0; u.pn = 0; u.kt0 = 0; u.nt = full7.ntK; u.half = 0; return c == 0; }
        if (i == 0 || (i == 1 && c < 220)) { const bool ok = full7.next(i, u); if (ok && u.pn >= 3) u.pn += 1; return ok; }
        int hidx;
        if (i == 1) hidx = c - 220;
        else if (i == 2 && c >= 220 && c < 252) hidx = 36 + (c - 220);
        else return false;
        u.pm = hidx; u.pn = 3; u.kt0 = 0; u.nt = full7.ntK; u.half = 1; return true;
    }
    __device__ __forceinline__ void a_ready(const Unit&) const {}
    __device__ __forceinline__ void done(const Unit&) const {}
};

struct UpOrder {
    int G, c;
    __host__ __device__ void init(int G_, int c_) { G = G_; c = c_; }
    __host__ __device__ bool next(int i, Unit& u) const {
        const long L = (long)i * G + c; if (L >= 408) return false;
        const int kv = L >= 204, j = kv ? (int)L - 204 : (int)L;
        u.pm = j / 3; u.pn = (kv ? 3 : 0) + j % 3; u.kt0 = kv ? 4 : 0; u.nt = kv ? 2 : 4; u.half = 0; return true;
    }
    __device__ __forceinline__ void a_ready(const Unit&) const {}
    __device__ __forceinline__ void done(const Unit&) const {}
};

__device__ __forceinline__ unsigned cvt_pk_bf16(float lo, float hi) { unsigned r; asm volatile("v_cvt_pk_bf16_f32 %0, %1, %2" : "=v"(r) : "v"(lo), "v"(hi)); return r; }
template <class Epi, class Sched, bool ALIGN_EPI = false, bool SP2 = false>
__device__ __forceinline__ void gemm_phase(PG8_LAS unsigned char* lds, const Gemm g, const Sched& S, const Epi& E) {
    int tid_ = threadIdx.x; asm volatile("" : "+v"(tid_));
    const int tid = tid_, wid = __builtin_amdgcn_readfirstlane(tid >> 6), lane = tid & 63, wr = wid >> 2, wc = wid & 3, fr = lane & 15, fq = lane >> 4;
    int K_ = g.K; asm volatile("" : "+s"(K_));
    const int K = K_;
    unsigned voffA[2], voffB[2];
#pragma unroll
    for (int i = 0; i < 2; ++i) { int R, C; stage_rc(tid * 16 + i * 8192, R, C); const int Rb = Epi::PERM ? ((R & ~31) + perm32(R & 31)) : R;
        voffA[i] = (unsigned)(R * K + C) * 2u; voffB[i] = (unsigned)(Rb * K + C) * 2u; }
    const size_t kstep = (size_t)(BK * 2);
    const size_t hstep = (size_t)HALF * K * 2;
    const size_t tstep = 2 * hstep;
    const unsigned ldsw = (unsigned)wid * 1024u;
    const int aoff = lds_byte(wr * 64 + fr, fq * 8), boff = lds_byte(wc * 32 + fr, fq * 8);
#define PG8_SA(b, h) (((b) * 2 + (h)) * HTB)
#define PG8_SB(b, h) ((4 + (b) * 2 + (h)) * HTB)
#define PG8_STAGE(bufoff, gbase, voff) do { _Pragma("unroll") for (int _i = 0; _i < 2; ++_i) \
        __builtin_amdgcn_global_load_lds((const unsigned*)((const char*)(gbase) + (voff)[_i]), (PG8_LAS unsigned*)(lds + (bufoff) + ldsw + _i * 8192), 16, 0, 0); } while (0)
#define PG8_LDA(dst, b, h) do { _Pragma("unroll") for (int m = 0; m < 4; ++m) _Pragma("unroll") for (int k = 0; k < 2; ++k) dst[m][k] = *(const PG8_LAS bf16x8*)(lds + PG8_SA(b, h) + aoff + m * 2048 + k * 1024); } while (0)
#define PG8_LDB(dst, b, h) do { _Pragma("unroll") for (int n = 0; n < 2; ++n) _Pragma("unroll") for (int k = 0; k < 2; ++k) dst[n][k] = *(const PG8_LAS bf16x8*)(lds + PG8_SB(b, h) + boff + n * 2048 + k * 1024); } while (0)
#define PG8_MMA(ai, bj, At, Bt) do { __builtin_amdgcn_s_setprio(1); _Pragma("unroll") for (int m = 0; m < 4; ++m) _Pragma("unroll") for (int n = 0; n < 2; ++n) _Pragma("unroll") for (int k = 0; k < 2; ++k) \
        acc[ai][bj][m][n] = __builtin_amdgcn_mfma_f32_16x16x32_bf16(Bt[n][k], At[m][k], acc[ai][bj][m][n], 0, 0, 0); __builtin_amdgcn_s_setprio(0); } while (0)
#define PG8_WAIT_V(n) asm volatile("s_waitcnt vmcnt(" #n ")" ::: "memory")
#define PG8_WAIT_L(n) asm volatile("s_waitcnt lgkmcnt(" #n ")" ::: "memory")
#define PG8_BAR __builtin_amdgcn_s_barrier()
#define PG8_SCHED __builtin_amdgcn_sched_barrier(0)
    Unit cur, nxt; int ui = 0;
    if (!S.next(0, cur)) return;
    f32x4 acc[2][2][4][2];
#pragma unroll
    for (int a = 0; a < 2; ++a)
#pragma unroll
        for (int b = 0; b < 2; ++b)
#pragma unroll
            for (int m = 0; m < 4; ++m)
#pragma unroll
                for (int n = 0; n < 2; ++n) acc[a][b][m][n] = (f32x4){0.f, 0.f, 0.f, 0.f};
    bf16x8 At[4][2], B0[2][2], B1[2][2];
    const char* cA = (const char*)g.A + (size_t)cur.pm * tstep + (size_t)cur.kt0 * kstep; const char* cB = (const char*)g.Bt + (size_t)cur.pn * tstep + (size_t)cur.kt0 * kstep;
    S.a_ready(cur);
    if constexpr (SP2) {
        PG8_STAGE(PG8_SB(0, 0), cB, voffB); PG8_STAGE(PG8_SB(0, 1), cB + hstep, voffB); PG8_STAGE(PG8_SA(0, 0), cA, voffA); PG8_STAGE(PG8_SA(0, 1), cA + hstep, voffA);
        if (wr == 1) PG8_BAR;
        PG8_WAIT_V(2); PG8_BAR;
        PG8_STAGE(PG8_SB(1, 0), cB + kstep, voffB); PG8_STAGE(PG8_SA(1, 0), cA + kstep, voffA); PG8_STAGE(PG8_SB(1, 1), cB + hstep + kstep, voffB);
        PG8_WAIT_V(6); PG8_BAR;
    } else {
        PG8_STAGE(PG8_SB(0, 0), cB, voffB); PG8_STAGE(PG8_SA(0, 0), cA, voffA); PG8_STAGE(PG8_SB(0, 1), cB + hstep, voffB); PG8_STAGE(PG8_SA(0, 1), cA + hstep, voffA);
        if (wr == 1) PG8_BAR;
        PG8_WAIT_V(4); PG8_BAR;
        PG8_STAGE(PG8_SB(1, 0), cB + kstep, voffB); PG8_STAGE(PG8_SA(1, 0), cA + kstep, voffA); PG8_STAGE(PG8_SB(1, 1), cB + hstep + kstep, voffB);
        PG8_WAIT_V(6); PG8_BAR;
    }
    for (;;) {
        const bool has_next = S.next(ui + 1, nxt);
        const char* nA = has_next ? (const char*)g.A + (size_t)nxt.pm * tstep + (size_t)nxt.kt0 * kstep : cA; const char* nB = has_next ? (const char*)g.Bt + (size_t)nxt.pn * tstep + (size_t)nxt.kt0 * kstep : cB;
        const int ntc = cur.nt; const bool full = !cur.half;
        for (int t = 0; t < ntc; t += 2) {
            const bool last = (t == ntc - 2);
            const char* a1 = cA + (size_t)(t + 1) * kstep;
            const char* a2 = last ? nA : cA + (size_t)(t + 2) * kstep; const char* b2 = last ? nB : cB + (size_t)(t + 2) * kstep;
            const char* a3 = a2 + kstep; const char* b3 = b2 + kstep;
            if (last && has_next) S.a_ready(nxt);
            if constexpr (SP2) {
            PG8_LDB(B0, 0, 0); PG8_LDB(B1, 0, 1); PG8_SCHED; PG8_LDA(At, 0, 0); PG8_STAGE(PG8_SA(1, 1), a1 + hstep, voffA);
            PG8_WAIT_V(8); PG8_WAIT_L(0); PG8_BAR; PG8_MMA(0, 0, At, B0); if (full) PG8_MMA(0, 1, At, B1); PG8_BAR; PG8_SCHED;
            PG8_LDA(At, 0, 1); PG8_STAGE(PG8_SB(0, 0), b2, voffB); PG8_STAGE(PG8_SB(0, 1), b2 + hstep, voffB); PG8_STAGE(PG8_SA(0, 0), a2, voffA);
            PG8_WAIT_V(8); PG8_WAIT_L(0); PG8_BAR; PG8_MMA(1, 0, At, B0); if (full) PG8_MMA(1, 1, At, B1); PG8_BAR; PG8_SCHED;
            PG8_LDB(B0, 1, 0); PG8_LDB(B1, 1, 1); PG8_SCHED; PG8_LDA(At, 1, 0); PG8_STAGE(PG8_SA(0, 1), a2 + hstep, voffA);
            PG8_WAIT_V(8); PG8_WAIT_L(0); PG8_BAR; PG8_MMA(0, 0, At, B0); if (full) PG8_MMA(0, 1, At, B1); PG8_BAR; PG8_SCHED;
            PG8_LDA(At, 1, 1); PG8_STAGE(PG8_SB(1, 0), b3, voffB); PG8_STAGE(PG8_SB(1, 1), b3 + hstep, voffB); PG8_STAGE(PG8_SA(1, 0), a3, voffA);
            PG8_WAIT_V(8); PG8_WAIT_L(0); PG8_BAR; PG8_MMA(1, 0, At, B0); if (full) PG8_MMA(1, 1, At, B1); PG8_BAR; PG8_SCHED;
            } else {
            PG8_LDB(B0, 0, 0); PG8_SCHED; PG8_LDA(At, 0, 0); PG8_STAGE(PG8_SA(1, 1), a1 + hstep, voffA);
            PG8_WAIT_L(8); PG8_BAR; PG8_WAIT_L(0); PG8_MMA(0, 0, At, B0); PG8_BAR; PG8_SCHED;
            PG8_LDB(B1, 0, 1); PG8_STAGE(PG8_SB(0, 0), b2, voffB);
            PG8_BAR; PG8_WAIT_L(0); PG8_MMA(0, 1, At, B1); PG8_BAR;
            PG8_LDA(At, 0, 1); PG8_STAGE(PG8_SA(0, 0), a2, voffA);
            PG8_BAR; PG8_WAIT_L(0); PG8_MMA(1, 0, At, B0); PG8_BAR; PG8_SCHED;
            PG8_STAGE(PG8_SB(0, 1), b2 + hstep, voffB);
            PG8_WAIT_V(6); PG8_BAR; PG8_MMA(1, 1, At, B1); PG8_BAR;
            PG8_LDB(B0, 1, 0); PG8_SCHED; PG8_LDA(At, 1, 0); PG8_STAGE(PG8_SA(0, 1), a2 + hstep, voffA);
            PG8_WAIT_L(8); PG8_BAR; PG8_WAIT_L(0); PG8_MMA(0, 0, At, B0); PG8_BAR; PG8_SCHED;
            PG8_LDB(B1, 1, 1); PG8_STAGE(PG8_SB(1, 0), b3, voffB);
            PG8_BAR; PG8_WAIT_L(0); PG8_MMA(0, 1, At, B1); PG8_BAR;
            PG8_LDA(At, 1, 1); PG8_STAGE(PG8_SA(1, 0), a3, voffA);
            PG8_BAR; PG8_WAIT_L(0); PG8_MMA(1, 0, At, B0); PG8_BAR; PG8_SCHED;
            PG8_STAGE(PG8_SB(1, 1), b3 + hstep, voffB);
            PG8_WAIT_V(6); PG8_BAR; PG8_MMA(1, 1, At, B1); PG8_BAR;
            }
        }
        if constexpr (ALIGN_EPI) { if (wr == 0) PG8_BAR; }
        if constexpr (!Epi::AFTER_DRAIN) { E(acc, cur, wr, wc, fr, fq); S.done(cur); }
        if (!has_next) break;
#pragma unroll
        for (int a = 0; a < 2; ++a)
#pragma unroll
            for (int b = 0; b < 2; ++b)
#pragma unroll
                for (int m = 0; m < 4; ++m)
#pragma unroll
                    for (int n = 0; n < 2; ++n) acc[a][b][m][n] = (f32x4){0.f, 0.f, 0.f, 0.f};
        cur = nxt; cA = nA; cB = nB; ++ui;
        if constexpr (ALIGN_EPI) { if (wr == 1) PG8_BAR; }
    }
    PG8_WAIT_V(0);
    if constexpr (!ALIGN_EPI) { if (wr == 0) PG8_BAR; }
    PG8_BAR;
    if constexpr (Epi::AFTER_DRAIN) { E.fused(acc, cur, wr, wc, fr, fq, lds, wid, lane); S.done(cur); }
#undef PG8_SA
#undef PG8_SB
#undef PG8_STAGE
#undef PG8_LDA
#undef PG8_LDB
#undef PG8_MMA
#undef PG8_WAIT_V
#undef PG8_WAIT_L
#undef PG8_BAR
#undef PG8_SCHED
}
}

#ifndef MK_N_LAUNCHES
#define MK_N_LAUNCHES 1
#endif
namespace cf {
constexpr int D = 1024, NB = 4, T = 4096, TC = 256, ML = NB * T, MC = NB * TC, M = ML + MC, TS = T + TC;
constexpr int DFF = 2816, DIN = 1840, DEPTH = 2;
constexpr float EPS = 1e-6f;
constexpr int NPH = 1 + 13 * DEPTH;
}
using namespace cf;
typedef unsigned short bf16_t;
typedef float f32x4 __attribute__((ext_vector_type(4)));
typedef unsigned u32x4 __attribute__((ext_vector_type(4)));
#define GAS __attribute__((address_space(1)))
#define LAS __attribute__((address_space(3)))
typedef GAS unsigned gu32;
#define RLX_AGENT __ATOMIC_RELAXED, __HIP_MEMORY_SCOPE_AGENT
#define LDS_WAIT() asm volatile("s_waitcnt lgkmcnt(0)" ::: "memory")
#define VM_WAIT() asm volatile("s_waitcnt vmcnt(0)" ::: "memory")

constexpr size_t MiB = 1u << 20;
constexpr size_t WS_CTL = 0, CTL_ZERO_BYTES = 64 * 1024;
constexpr size_t WS_MOD = 1 * MiB;
constexpr size_t WS_XBC = 5 * MiB;
constexpr size_t WS_W = 9 * MiB;
constexpr size_t W_1I = 0, W_1O = W_1I + (size_t)5632 * 1024, W_2I = W_1O + (size_t)1024 * 2816, W_2O = W_2I + (size_t)5632 * 1024, W_IN = W_2O + (size_t)1024 * 2816,
                 W_OUT = W_IN + (size_t)2048 * 1024, W_UP = W_OUT + (size_t)1024 * 1024, WL_STRIDE = W_UP + (size_t)1536 * 384;
static_assert(WS_W + 2 * WL_STRIDE * 2 <= 90 * MiB, "weights");
constexpr size_t WS_XN = 90 * MiB;
constexpr size_t WS_HID = 124 * MiB;
constexpr size_t WS_P16A = 124 * MiB;
constexpr size_t WS_G32 = WS_P16A + (size_t)M * 768 * 2;
constexpr size_t WS_P16B = 154 * MiB;
constexpr size_t WS_MLA = 154 * MiB;
constexpr size_t WS_LOC = 205 * MiB;
constexpr size_t WS_QUP = 223 * MiB;
constexpr size_t WS_END = 274 * MiB;
static_assert(WS_G32 + (size_t)M * 64 * 4 <= WS_P16B && WS_MLA + ((size_t)NB * 6 * TS * (96 + 96 + 64)) * 2 <= WS_LOC && WS_LOC + (size_t)32 * 68 * 2112 * 4 <= WS_QUP && WS_QUP + (size_t)M * 768 * 4 <= WS_END, "ws map");
static_assert(WS_HID + (size_t)M * DFF * 2 <= WS_QUP, "ws map 2");
constexpr int CW_BAR = 1024;

constexpr int RING_OFF = 0, RING_BYTES = 131072, LDSCTL_OFF = RING_BYTES, MISC_OFF = LDSCTL_OFF + 320, LDS_BYTES = 147456;

__device__ __forceinline__ float bf2f(bf16_t v) { return __uint_as_float(((unsigned)v) << 16); }
__device__ __forceinline__ bf16_t f2bf(float f) { unsigned u = __float_as_uint(f); u += 0x7fffu + ((u >> 16) & 1u); return (bf16_t)(u >> 16); }
__device__ __forceinline__ unsigned pk2(float lo, float hi) { typedef float f2_t_ __attribute__((ext_vector_type(2))); typedef __bf16 b2_t_ __attribute__((ext_vector_type(2))); f2_t_ v = {lo, hi}; b2_t_ b = __builtin_convertvector(v, b2_t_); return __builtin_bit_cast(unsigned, b); }
__device__ __forceinline__ float siluf(float x) { return x / (1.f + expf(-x)); }
__device__ __forceinline__ float silu_fast(float x) { return x * __builtin_amdgcn_rcpf(1.f + __expf(-x)); }
__device__ __forceinline__ float sigmoidf_(float x) { return 1.f / (1.f + expf(-x)); }
__device__ __forceinline__ float logsigmoidf_(float x) { return x >= 0.f ? -log1pf(expf(-x)) : x - log1pf(expf(x)); }
struct RowInfo { int b, t, isctx, s, sp; };
__device__ __forceinline__ RowInfo rowinfo(int m) {
    RowInfo r;
    if (m < ML) { r.b = m / T; r.t = m % T; r.isctx = 0; r.s = r.b; r.sp = TC + r.t; }
    else { int q = m - ML; r.b = q / TC; r.t = q % TC; r.isctx = 1; r.s = 4; r.sp = r.t; }
    return r;
}
template <int CTRL> __device__ __forceinline__ float dpp_f(float v) { return __int_as_float(__builtin_amdgcn_update_dpp(0, __float_as_int(v), CTRL, 0xF, 0xF, true)); }
__device__ __forceinline__ float sum16(float v) { v += dpp_f<0x128>(v); v += dpp_f<0x124>(v); v += dpp_f<0x122>(v); v += dpp_f<0x121>(v); return v; }
__device__ __forceinline__ float xor16_sum(float v) { auto r = __builtin_amdgcn_permlane16_swap(__float_as_uint(v), __float_as_uint(v), false, false); return __uint_as_float(r[0]) + __uint_as_float(r[1]); }
__device__ __forceinline__ float xor32_sum(float v) { auto r = __builtin_amdgcn_permlane32_swap(__float_as_uint(v), __float_as_uint(v), false, false); return __uint_as_float(r[0]) + __uint_as_float(r[1]); }
__device__ __forceinline__ float sum32(float v) { return xor16_sum(sum16(v)); }
__device__ __forceinline__ float wave_sum(float v) { return xor32_sum(xor16_sum(sum16(v))); }
template <int CTRL, int RMASK> __device__ __forceinline__ float dpp_id(float v, float ident) { return __int_as_float(__builtin_amdgcn_update_dpp(__float_as_int(ident), __float_as_int(v), CTRL, RMASK, 0xF, false)); }
__device__ __forceinline__ float scan_sum64(float v) {
    v += dpp_id<0x111, 0xF>(v, 0.f); v += dpp_id<0x112, 0xF>(v, 0.f); v += dpp_id<0x114, 0xF>(v, 0.f); v += dpp_id<0x118, 0xF>(v, 0.f);
    v += dpp_id<0x142, 0xA>(v, 0.f); v += dpp_id<0x143, 0xC>(v, 0.f); return v; }
__device__ __forceinline__ float scan_max64(float v) {
    const float NI = -INFINITY;
    v = fmaxf(v, dpp_id<0x111, 0xF>(v, NI)); v = fmaxf(v, dpp_id<0x112, 0xF>(v, NI)); v = fmaxf(v, dpp_id<0x114, 0xF>(v, NI)); v = fmaxf(v, dpp_id<0x118, 0xF>(v, NI));
    v = fmaxf(v, dpp_id<0x142, 0xA>(v, NI)); v = fmaxf(v, dpp_id<0x143, 0xC>(v, NI)); return v; }
__device__ __forceinline__ float lane_bcast(float v, int lane_const) { return __int_as_float(__builtin_amdgcn_readlane(__float_as_int(v), lane_const)); }
__device__ __forceinline__ float xchg4(float v, int l16) { const float up = dpp_f<0x104>(v)  , dn = dpp_f<0x114>(v)  ; return (l16 & 4) ? dn : up; }
__device__ __forceinline__ float xchg2(float v) { return dpp_f<0x4E>(v); }
__device__ __forceinline__ void sincos_b(float a, float& s, float& c) {
    const float inv2pi = 0.15915494309189535f;
    float k = rintf(a * inv2pi);
    float r = fmaf(-k, 6.28125f, a);
    r = fmaf(-k, 1.9353071795864769e-3f, r);
    float rev = r * inv2pi;
    s = __builtin_amdgcn_sinf(rev); c = __builtin_amdgcn_cosf(rev);
}
__device__ __forceinline__ const float* modp(const float* MOD, int l, int s, int n) { return MOD + ((size_t)(l * 5 + s) * 9 + n) * D; }
#define XB_TMO      128
#define XB_XCNT(j)  (256  + 64 * (j))
#define XB_XSUB(j)  (1280 + 64 * (j))
#define XB_XGEN(j)  (2304 + 64 * (j))
#define XB_TOP      3328
#define XB_TOPGEN   3392
#define XCD_BAR_WORDS 3456
#define XB_SPIN_CAP (1u << 18)

__device__ __forceinline__ unsigned xb_ld(unsigned* p)              { return __hip_atomic_load(p, __ATOMIC_RELAXED, __HIP_MEMORY_SCOPE_AGENT); }
__device__ __forceinline__ unsigned xb_add(unsigned* p, unsigned v) { return __hip_atomic_fetch_add(p, v, __ATOMIC_RELAXED, __HIP_MEMORY_SCOPE_AGENT); }
__device__ __forceinline__ unsigned xb_xcc_id() { return (unsigned)__builtin_amdgcn_s_getreg((3 << 11) | 20) & 0xFu; }
#define XB_SPIN(cond, bar) do { unsigned _sp = 0; while (cond) { __builtin_amdgcn_s_sleep(1); \
    if ((++_sp & 255u) == 0u) { if (xb_ld(&(bar)[XB_TMO])) break; if (_sp > XB_SPIN_CAP) { atomicAdd(&(bar)[XB_TMO], 1u); break; } } } } while (0)

struct XcdBarrier {
    unsigned* bar; unsigned x;
    volatile LAS unsigned* st;
};

__device__ __forceinline__ XcdBarrier xcd_barrier_post(unsigned* bar, volatile LAS unsigned* st) {
    XcdBarrier b; b.bar = bar; b.x = xb_xcc_id(); b.st = st;
    if (threadIdx.x == 0) (void)xb_add(&bar[XB_XCNT(b.x)], 1u);
    return b;
}
__device__ __forceinline__ void xcd_barrier_complete(unsigned* bar, unsigned x, unsigned& nloc, unsigned& nx) {
    const unsigned G = gridDim.x * gridDim.y * gridDim.z;
    unsigned sum, cnt, mine, sp = 0u;
    for (;;) {
        sum = 0u; cnt = 0u; mine = 0u;
#pragma unroll
        for (unsigned j = 0; j < 16; ++j) { const unsigned c = xb_ld(&bar[XB_XCNT(j)]); sum += c; cnt += (c > 0u) ? 1u : 0u; mine = (j == x) ? c : mine; }
        if (sum == G) break;
        __builtin_amdgcn_s_sleep(1);
        if ((++sp & 255u) == 0u) { if (xb_ld(&bar[XB_TMO])) break; if (sp > XB_SPIN_CAP) { atomicAdd(&bar[XB_TMO], 1u); break; } }
    }
    nloc = mine > 0u ? mine : 1u; nx = cnt > 0u ? cnt : 1u;
}

__device__ __forceinline__ void xcd_barrier(const XcdBarrier& b) {
    asm volatile("s_waitcnt vmcnt(0)" ::: "memory");
    __syncthreads();
    if (threadIdx.x == 0) {
        unsigned* bar = b.bar;
        __builtin_amdgcn_s_waitcnt(0);
        unsigned nloc = b.st[0], nx = b.st[1];
        if (nloc == 0u) { xcd_barrier_complete(bar, b.x, nloc, nx); b.st[0] = nloc; b.st[1] = nx; }
        const unsigned old = xb_add(&bar[XB_XSUB(b.x)], 1u);
        const unsigned gen = old / nloc;
        if (old + 1u == (gen + 1u) * nloc) {
            __builtin_amdgcn_fence(__ATOMIC_RELEASE, "agent");
            asm volatile("s_waitcnt vmcnt(0)" ::: "memory");
            const unsigned og = xb_add(&bar[XB_TOP], 1u);
            const unsigned tg = og / nx;
            if (og + 1u == (tg + 1u) * nx) xb_add(&bar[XB_TOPGEN], 1u);
            else XB_SPIN(xb_ld(&bar[XB_TOPGEN]) == tg, bar);
            __builtin_amdgcn_fence(__ATOMIC_ACQUIRE, "agent");
            xb_add(&bar[XB_XGEN(b.x)], 1u);
            asm volatile("s_waitcnt vmcnt(0)" ::: "memory");
        } else {
            XB_SPIN(xb_ld(&bar[XB_XGEN(b.x)]) == gen, bar);
            __builtin_amdgcn_fence(__ATOMIC_ACQUIRE, "agent");
            asm volatile("s_waitcnt vmcnt(0)" ::: "memory");
        }
    }
    __syncthreads();
}

struct Args { const float* in[24]; float* out; unsigned char* ws; int ph_lo, ph_hi; };
struct Frame {
    LAS unsigned char* lds; int tid, lane, wave, vcu, G;
    const float* const* in; float* out; unsigned char* ws;
    __device__ __forceinline__ bf16_t* wl(int l, size_t off) const { return (bf16_t*)(ws + WS_W) + (size_t)l * WL_STRIDE + off; }
};
#define OPAQUE_TID(F) do { int t_ = (F).tid; asm volatile("" : "+v"(t_)); (F).tid = t_; (F).lane = t_ & 63; } while (0)
#define F_MOD   ((float*)(F.ws + WS_MOD))
#define F_XBC   ((float*)(F.ws + WS_XBC))
#define F_XN    ((bf16_t*)(F.ws + WS_XN))
#define F_HID   ((bf16_t*)(F.ws + WS_HID))
#define F_P16A  ((bf16_t*)(F.ws + WS_P16A))
#define F_G32   ((float*)(F.ws + WS_G32))
#define F_P16B  ((bf16_t*)(F.ws + WS_P16B))
#define F_Y     ((bf16_t*)(F.ws + WS_QUP))
#define F_QUP   ((bf16_t*)(F.ws + WS_QUP))
#define F_KVUP  ((bf16_t*)(F.ws + WS_QUP) + (size_t)M * 768)
#define F_QC    ((bf16_t*)(F.ws + WS_XN))
#define F_KC    (F_QC + (size_t)NB * 6 * TS * 64)
#define F_VC    (F_KC + (size_t)NB * 2 * TS * 64)
#define F_CKN   (F_VC + (size_t)NB * 2 * TS * 64)
#define F_QB    ((bf16_t*)(F.ws + WS_MLA))
#define F_KB    (F_QB + (size_t)NB * 6 * TS * 96)
#define F_VB    (F_KB + (size_t)NB * 6 * TS * 96)
enum InIdx { I_X = 0, I_C, I_CTX, I_CCTX, I_ADAW, I_ADAB, I_NORMG, I_F1WI, I_F1WO, I_F2WI, I_F2WO, I_WIN, I_WOUT, I_GATEB, I_OUTNORM, I_CQN, I_CKVN, I_WUQ, I_WUKV, I_MQN, I_MKN, I_GQN, I_GKN, I_SINK };

template <class Map>
__device__ __forceinline__ void transpose_item(const float* W, int ldw, int Nsrc, int k0, int n0, bf16_t* WT, int ldt, int koff, Map map, LAS float* scr, int lane, float sc = 1.f) {
    int nsrc = n0 + (lane & 31); nsrc = nsrc < Nsrc ? nsrc : Nsrc - 1;
    float tv[32];
#pragma unroll
    for (int i = 0; i < 32; ++i) { const int kk = 2 * i + (lane >> 5); tv[i] = W[(size_t)(k0 + kk) * ldw + nsrc]; }
#pragma unroll
    for (int i = 0; i < 32; ++i) { const int kk = 2 * i + (lane >> 5); scr[kk * 33 + (lane & 31)] = tv[i]; }
    LDS_WAIT(); asm volatile("" ::: "memory");
    const int c = lane & 7;
#pragma unroll
    for (int j = 0; j < 4; ++j) { const int nn = (lane >> 3) + 8 * j; const LAS float* s = scr + (8 * c) * 33 + nn;
        u32x4 o; o.x = pk2(s[0 * 33] * sc, s[1 * 33] * sc); o.y = pk2(s[2 * 33] * sc, s[3 * 33] * sc); o.z = pk2(s[4 * 33] * sc, s[5 * 33] * sc); o.w = pk2(s[6 * 33] * sc, s[7 * 33] * sc);
        if (n0 + nn < Nsrc) *(u32x4*)(WT + (size_t)map(n0 + nn) * ldt + koff + k0 + 8 * c) = o; }
    LDS_WAIT(); asm volatile("" ::: "memory");
}
constexpr float SW_GSC = 1.4426950408889634f, SW_USC = 0.6931471805599453f;
static_assert(DFF % 32 == 0, "a conversion item never straddles the gate/up boundary");
struct MapId { __device__ __forceinline__ int operator()(int n) const { return n; } };
struct MapWi { __device__ __forceinline__ int operator()(int n) const { return n < DFF ? 256 * (n >> 7) + (n & 127) : 256 * ((n - DFF) >> 7) + 128 + ((n - DFF) & 127); } };
__host__ __device__ __forceinline__ int pcol(int n) {
    if (n < 784) return n;
    if (n < 1040) return 1024 + (n - 784);
    if (n < 1168) return 1280 + (n - 1040);
    if (n < 1200) return 784 + (n - 1168);
    if (n < 1584) return 1408 + (n - 1200);
    if (n < 1712) return 1792 + (n - 1584);
    return 1920 + (n - 1712);
}
struct MapWin { __device__ __forceinline__ int operator()(int n) const { return pcol(n); } };
struct MapUq { __device__ __forceinline__ int operator()(int n) const { return 128 * (n / 96) + (n % 96); } };
struct MapUkv { __device__ __forceinline__ int operator()(int n) const { return 768 + n; } };

__device__ __forceinline__ void p0_prologue(Frame& F) {
    OPAQUE_TID(F);
    {
        LAS float* sc = (LAS float*)(F.lds);
        LAS float* red = (LAS float*)(F.lds + 20480);
        for (int i = F.tid; i < 5 * 1024; i += 512) { int s = i >> 10, k = i & 1023; float v = s < 4 ? F.in[I_C][s * D + k] : F.in[I_CCTX][k]; sc[i] = siluf(v); }
        __syncthreads();
        for (int it = F.vcu; it < 576; it += F.G) {
            const int l = it / 288, cb = it % 288; const int kk = F.lane >> 3, c4 = F.lane & 7; const int kb = F.wave * 128;
            const float* w = F.in[I_ADAW] + (size_t)l * D * 9216 + (size_t)(kb + kk) * 9216 + cb * 32 + 4 * c4;
            f32x4 a[5] = {{0.f, 0.f, 0.f, 0.f}, {0.f, 0.f, 0.f, 0.f}, {0.f, 0.f, 0.f, 0.f}, {0.f, 0.f, 0.f, 0.f}, {0.f, 0.f, 0.f, 0.f}};
#pragma unroll 16
            for (int i = 0; i < 16; ++i) { const f32x4 wv = *(const f32x4*)(w + (size_t)(8 * i) * 9216); const int k = kb + kk + 8 * i;
#pragma unroll
                for (int s = 0; s < 5; ++s) a[s] += wv * sc[s * 1024 + k]; }
#pragma unroll
            for (int s = 0; s < 5; ++s) {
#pragma unroll
                for (int c = 0; c < 4; ++c) { float t = a[s][c]; t += dpp_f<0x128>(t); t = xor32_sum(xor16_sum(t)); a[s][c] = t; } }
            if (kk == 0) { LAS float* r = red + F.wave * 160 + 4 * c4;
#pragma unroll
                for (int s = 0; s < 5; ++s) *(LAS f32x4*)(r + 32 * s) = a[s]; }
            __syncthreads();
            if (F.tid < 160) { const int s = F.tid >> 5, col = F.tid & 31; float acc = F.in[I_ADAB][l * 9216 + cb * 32 + col];
#pragma unroll
                for (int wv = 0; wv < 8; ++wv) acc += red[wv * 160 + s * 32 + col];
                F_MOD[(size_t)(l * 5 + s) * 9216 + cb * 32 + col] = acc; }
            __syncthreads();
        }
    }
    { const int gt = F.vcu * 512 + F.tid, NGT = F.G * 512; for (int i = gt; i < MC * D / 4; i += NGT) ((f32x4*)F_XBC)[i] = ((const f32x4*)F.in[I_CTX])[i]; }
    {
        const int gt = F.vcu * 512 + F.tid, NGT = F.G * 512; const u32x4 z = {0u, 0u, 0u, 0u};
        for (int i = gt; i < 2 * (768 * 16 + 768 * 32); i += NGT) {
            const int l = i / (768 * 48); int r = i % (768 * 48);
            bf16_t* wu = F.wl(l, W_UP);
            if (r < 768 * 16) { const int row = r >> 4, ch = r & 15; *(u32x4*)(wu + (size_t)row * 384 + 256 + 8 * ch) = z; }
            else { r -= 768 * 16; const int row = 768 + (r >> 5), ch = r & 31; *(u32x4*)(wu + (size_t)row * 384 + 8 * ch) = z; }
        }
    }
}

constexpr int CV_WI = 16 * 176, CV_WO = 44 * 32, CV_IN = 16 * 58, CV_OUT = 16 * 32, CV_UQ = 4 * 18, CV_UKV = 2 * 24;
constexpr int CV_NA = CV_WI + CV_WO + CV_IN + CV_UQ + CV_UKV, CV_NB = CV_WI + CV_WO + CV_OUT, CV_P0 = CV_NA;
static_assert(CV_P0 <= CV_NA, "phase-0 share");
__device__ __forceinline__ void p0_weights(Frame& F, int l0, int r0, int n0, int ntot, int gw, int NGW) {
    OPAQUE_TID(F);
    LAS float* scr = (LAS float*)(F.lds + F.wave * 16384);
    for (int t = gw; t < ntot; t += NGW) {
        const int l = t < n0 ? l0 : l0 + 1; int r = t < n0 ? r0 + t : t - n0;
        if (r < CV_WI) { transpose_item(F.in[I_F1WI] + (size_t)l * D * 2 * DFF, 2 * DFF, 2 * DFF, 64 * (r / 176), 32 * (r % 176), F.wl(l, W_1I), 1024, 0, MapWi(), scr, F.lane, (r % 176) < 88 ? SW_GSC : SW_USC); continue; } r -= CV_WI;
        if (r < CV_WO) { transpose_item(F.in[I_F1WO] + (size_t)l * DFF * D, D, D, 64 * (r / 32), 32 * (r % 32), F.wl(l, W_1O), DFF, 0, MapId(), scr, F.lane); continue; } r -= CV_WO;
        if (r < CV_IN) { transpose_item(F.in[I_WIN] + (size_t)l * D * DIN, DIN, DIN, 64 * (r / 58), 32 * (r % 58), F.wl(l, W_IN), 1024, 0, MapWin(), scr, F.lane); continue; } r -= CV_IN;
        if (r < CV_UQ) { transpose_item(F.in[I_WUQ] + (size_t)l * 256 * 576, 576, 576, 64 * (r / 18), 32 * (r % 18), F.wl(l, W_UP), 384, 0, MapUq(), scr, F.lane); continue; } r -= CV_UQ;
        if (r < CV_UKV) { transpose_item(F.in[I_WUKV] + (size_t)l * 128 * 768, 768, 768, 64 * (r / 24), 32 * (r % 24), F.wl(l, W_UP), 384, 256, MapUkv(), scr, F.lane); continue; } r -= CV_UKV;
        if (r < CV_WI) { transpose_item(F.in[I_F2WI] + (size_t)l * D * 2 * DFF, 2 * DFF, 2 * DFF, 64 * (r / 176), 32 * (r % 176), F.wl(l, W_2I), 1024, 0, MapWi(), scr, F.lane, (r % 176) < 88 ? SW_GSC : SW_USC); continue; } r -= CV_WI;
        if (r < CV_WO) { transpose_item(F.in[I_F2WO] + (size_t)l * DFF * D, D, D, 64 * (r / 32), 32 * (r % 32), F.wl(l, W_2O), DFF, 0, MapId(), scr, F.lane); continue; } r -= CV_WO;
        transpose_item(F.in[I_WOUT] + (size_t)l * D * D, D, D, 64 * (r / 32), 32 * (r % 32), F.wl(l, W_OUT), 1024, 0, MapId(), scr, F.lane);
    }
}
__device__ __forceinline__ void ph_modulate(Frame& F, const float* xl, int l, int which, int Mrows, int npend, const float* slab, const float* pgate, float pcoef) {
    OPAQUE_TID(F);
    const int gw = F.vcu * 8 + F.wave, NGW = F.G * 8, lane = F.lane;
    const f32x4* g4 = (const f32x4*)(F.in[I_NORMG] + (l * 3 + which) * D);
    {
        f32x4 cur[4];
        if (gw < ML) {
#pragma unroll
            for (int j = 0; j < 4; ++j) cur[j] = ((const f32x4*)(xl + (size_t)gw * D))[lane + 64 * j];
        }
        for (int m = gw; m < ML; m += NGW) {
            const int mn = (m + NGW < ML) ? m + NGW : m; f32x4 nxt[4];
#pragma unroll
            for (int j = 0; j < 4; ++j) nxt[j] = ((const f32x4*)(xl + (size_t)mn * D))[lane + 64 * j];
            const int s = m / T;
            const f32x4* sh4 = (const f32x4*)modp(F_MOD, l, s, 3 * which); const f32x4* sc4 = (const f32x4*)modp(F_MOD, l, s, 3 * which + 1);
            f32x4 gs[4], sh[4];
#pragma unroll
            for (int j = 0; j < 4; ++j) { const f32x4 g = g4[lane + 64 * j], sc = sc4[lane + 64 * j]; sh[j] = sh4[lane + 64 * j]; gs[j] = g * (sc + 1.f); }
            float ss = 0.f;
#pragma unroll
            for (int j = 0; j < 4; ++j) ss += cur[j].x * cur[j].x + cur[j].y * cur[j].y + cur[j].z * cur[j].z + cur[j].w * cur[j].w;
            ss = wave_sum(ss);
            const float rstd = rsqrtf(ss * (1.f / D) + EPS);
            uint2* o = (uint2*)(F_XN + (size_t)m * D);
#pragma unroll
            for (int j = 0; j < 4; ++j) { const f32x4 y = cur[j] * rstd * gs[j] + sh[j]; uint2 r; r.x = pk2(y.x, y.y); r.y = pk2(y.z, y.w); o[lane + 64 * j] = r; }
#pragma unroll
            for (int j = 0; j < 4; ++j) cur[j] = nxt[j];
        }
    }
    for (int m = ML + gw; m < Mrows; m += NGW) {
        f32x4 v[4]; float ss = 0.f;
        {
            f32x4* xr = (f32x4*)(F_XBC + (size_t)(m - ML) * D);
#pragma unroll
            for (int j = 0; j < 4; ++j) v[j] = xr[lane + 64 * j];
            if (npend > 0) {
                f32x4 a[4] = {{0.f, 0.f, 0.f, 0.f}, {0.f, 0.f, 0.f, 0.f}, {0.f, 0.f, 0.f, 0.f}, {0.f, 0.f, 0.f, 0.f}};
                for (int s = 0; s < npend; ++s) { const f32x4* sr = (const f32x4*)(slab + ((size_t)s * MC + (m - ML)) * D);
#pragma unroll
                    for (int j = 0; j < 4; ++j) a[j] += sr[lane + 64 * j]; }
#pragma unroll
                for (int j = 0; j < 4; ++j) { v[j] += ((const f32x4*)pgate)[lane + 64 * j] * pcoef * a[j]; xr[lane + 64 * j] = v[j]; }
            }
        }
#pragma unroll
        for (int j = 0; j < 4; ++j) ss += v[j].x * v[j].x + v[j].y * v[j].y + v[j].z * v[j].z + v[j].w * v[j].w;
        ss = wave_sum(ss);
        const float rstd = rsqrtf(ss * (1.f / D) + EPS);
        const f32x4* sh4 = (const f32x4*)modp(F_MOD, l, 4, 3 * which); const f32x4* sc4 = (const f32x4*)modp(F_MOD, l, 4, 3 * which + 1);
        uint2* o = (uint2*)(F_XN + (size_t)m * D);
#pragma unroll
        for (int j = 0; j < 4; ++j) {
            f32x4 g = g4[lane + 64 * j], sh = sh4[lane + 64 * j], sc = sc4[lane + 64 * j];
            uint2 r; r.x = pk2(v[j].x * rstd * g.x * (1.f + sc.x) + sh.x, v[j].y * rstd * g.y * (1.f + sc.y) + sh.y);
            r.y = pk2(v[j].z * rstd * g.z * (1.f + sc.z) + sh.z, v[j].w * rstd * g.w * (1.f + sc.w) + sh.w);
            o[lane + 64 * j] = r;
        }
    }
}
__device__ __forceinline__ f32x4 ld_bf4(const bf16_t* p) { uint2 w = *(const uint2*)p; f32x4 r; r.x = __uint_as_float(w.x << 16); r.y = __uint_as_float(w.x & 0xffff0000u); r.z = __uint_as_float(w.y << 16); r.w = __uint_as_float(w.y & 0xffff0000u); return r; }
__device__ __forceinline__ f32x4 cvt_bf4(uint2 w) { f32x4 r; r.x = __uint_as_float(w.x << 16); r.y = __uint_as_float(w.x & 0xffff0000u); r.z = __uint_as_float(w.y << 16); r.w = __uint_as_float(w.y & 0xffff0000u); return r; }
__device__ __forceinline__ void st_bf4(bf16_t* p, float a, float b, float c, float d) { uint2 r; r.x = pk2(a, b); r.y = pk2(c, d); *(uint2*)p = r; }

__device__ __forceinline__ void rope64(float (&v)[4], int l16, int prow, int pcolp) {
    int d0 = 4 * l16; int pos = d0 < 32 ? prow : pcolp; int dd0 = d0 & 31; bool first = dd0 < 16;
#pragma unroll
    for (int i = 0; i < 4; ++i) {
        float other = xchg4(v[i], l16);
        int fi = (dd0 & 15) + i;
        float inv = exp2f(-(float)fi * (13.287712379549449f / 16.f));
        float s, c; sincos_b((float)pos * inv, s, c);
        v[i] = first ? (v[i] * c - other * s) : (other * s + v[i] * c);
    }
}
__device__ __forceinline__ void rope32(float (&v)[4], int l8, int prow, int pcolp) {
    int rd0 = 4 * l8; int pos = rd0 < 16 ? prow : pcolp; int r16 = rd0 & 15; bool first = r16 < 8;
#pragma unroll
    for (int i = 0; i < 4; ++i) {
        float other = xchg2(v[i]);
        int fi = (r16 & 7) + i;
        float inv = exp2f(-(float)fi * (13.287712379549449f / 8.f));
        float s, c; sincos_b((float)pos * inv, s, c);
        v[i] = first ? (v[i] * c - other * s) : (other * s + v[i] * c);
    }
}
__device__ __forceinline__ void ph_prepA(Frame& F, int l) {
    OPAQUE_TID(F);
    const int gw = F.vcu * 8 + F.wave, NGW = F.G * 8, lane = F.lane, l16 = lane & 15;
    const float* cq_norm = F.in[I_CQN] + l * 256; const float* ckv_norm = F.in[I_CKVN] + l * 128; const float* gq_norm = F.in[I_GQN] + l * 64; const float* gk_norm = F.in[I_GKN] + l * 64;
    uint2 nraw[4];
    { const bf16_t* pr = F_P16B + (size_t)(gw < M ? gw : 0) * 1024 + 4 * lane;
#pragma unroll
      for (int j = 0; j < 4; ++j) nraw[j] = *(const uint2*)(pr + 256 * j); }
    for (int m = gw; m < M; m += NGW) {
        RowInfo ri = rowinfo(m); const bool lat = !ri.isctx; const int prow = ri.t >> 6, pcl = ri.t & 63;
        const f32x4 v0 = cvt_bf4(nraw[0]), v1 = cvt_bf4(nraw[1]), v2 = cvt_bf4(nraw[2]), v3 = cvt_bf4(nraw[3]);
        { const int mn = m + NGW < M ? m + NGW : m; const bf16_t* pr = F_P16B + (size_t)mn * 1024 + 4 * lane;
#pragma unroll
          for (int j = 0; j < 4; ++j) nraw[j] = *(const uint2*)(pr + 256 * j); }
        { float ss = wave_sum(v0.x * v0.x + v0.y * v0.y + v0.z * v0.z + v0.w * v0.w); float rstd = rsqrtf(ss * (1.f / 256.f) + EPS);
          f32x4 g = ((const f32x4*)cq_norm)[lane]; st_bf4(F_CKN + (size_t)m * 384 + 4 * lane, v0.x * rstd * g.x, v0.y * rstd * g.y, v0.z * rstd * g.z, v0.w * rstd * g.w); }
        { float p = lane < 32 ? (v1.x * v1.x + v1.y * v1.y + v1.z * v1.z + v1.w * v1.w) : 0.f; float ss = wave_sum(p); float rstd = rsqrtf(ss * (1.f / 128.f) + EPS);
          if (lane < 32) { f32x4 g = ((const f32x4*)ckv_norm)[lane]; st_bf4(F_CKN + (size_t)m * 384 + 256 + 4 * lane, v1.x * rstd * g.x, v1.y * rstd * g.y, v1.z * rstd * g.z, v1.w * rstd * g.w); } }
#pragma unroll
        for (int part = 0; part < 2; ++part) {
            f32x4 x = part ? v2 : v1; const bool ok = part ? true : lane >= 32; const int hq = part ? 2 + (lane >> 4) : ((lane >> 4) & 1);
            float ss = x.x * x.x + x.y * x.y + x.z * x.z + x.w * x.w;
            ss = sum16(ss);
            float rstd = rsqrtf(ss * (1.f / 64.f) + EPS); f32x4 g = ((const f32x4*)gq_norm)[l16];
            float v[4] = {x.x * rstd * g.x, x.y * rstd * g.y, x.z * rstd * g.z, x.w * rstd * g.w};
            float vr[4] = {v[0], v[1], v[2], v[3]}; rope64(vr, l16, prow, pcl);
            if (lat) { v[0] = vr[0]; v[1] = vr[1]; v[2] = vr[2]; v[3] = vr[3]; }
            constexpr float QSC = 0.125f * 1.4426950408889634f;
            if (ok) st_bf4(F_QC + (((size_t)ri.b * 6 + hq) * TS + ri.sp) * 64 + 4 * l16, v[0] * QSC, v[1] * QSC, v[2] * QSC, v[3] * QSC);
        }
        { const int kvh = (lane & 31) >> 4; const bool isk = lane < 32; f32x4 x = v3;
          float ss = x.x * x.x + x.y * x.y + x.z * x.z + x.w * x.w;
          ss = sum16(ss);
          float rstd = rsqrtf(ss * (1.f / 64.f) + EPS); f32x4 g = ((const f32x4*)gk_norm)[l16];
          float v[4] = {x.x * rstd * g.x, x.y * rstd * g.y, x.z * rstd * g.z, x.w * rstd * g.w};
          float vr[4] = {v[0], v[1], v[2], v[3]}; rope64(vr, l16, prow, pcl);
          if (lat) { v[0] = vr[0]; v[1] = vr[1]; v[2] = vr[2]; v[3] = vr[3]; }
          const size_t off = (((size_t)ri.b * 2 + kvh) * TS + ri.sp) * 64 + 4 * l16;
          if (isk) st_bf4(F_KC + off, v[0], v[1], v[2], v[3]); else st_bf4(F_VC + off, x.x, x.y, x.z, x.w); }
    }
}
__device__ __forceinline__ void ph_prepB(Frame& F, int l) {
    OPAQUE_TID(F);
    const int gw = ((F.vcu + F.G / 2) % F.G) * 8 + F.wave, NGW = F.G * 8, lane = F.lane, l32 = lane & 31, d0 = 4 * l32;
    const float* q_norm = F.in[I_MQN] + l * 96; const float* k_norm = F.in[I_MKN] + l * 96;
    f32x4 nkr; uint2 nq[3], nkv[3];
    { const int m0 = gw < M ? gw : 0; nkr = *(const f32x4*)(F_G32 + (size_t)m0 * 64 + 16 + 4 * (lane & 7));
#pragma unroll
      for (int j = 0; j < 3; ++j) { nq[j] = *(const uint2*)(F_QUP + (size_t)m0 * 768 + 256 * j + 4 * lane); nkv[j] = *(const uint2*)(F_KVUP + (size_t)m0 * 768 + 256 * j + 4 * lane); } }
    for (int m = gw; m < M; m += NGW) {
        RowInfo ri = rowinfo(m); const bool lat = !ri.isctx; const int prow = ri.t >> 6, pcl = ri.t & 63;
        f32x4 kr = nkr; if (lane >= 8) kr = (f32x4){0.f, 0.f, 0.f, 0.f};
        uint2 qraw[3], kvraw[3];
#pragma unroll
        for (int j = 0; j < 3; ++j) { qraw[j] = nq[j]; kvraw[j] = nkv[j]; }
        { const int mn = m + NGW < M ? m + NGW : m; nkr = *(const f32x4*)(F_G32 + (size_t)mn * 64 + 16 + 4 * (lane & 7));
#pragma unroll
          for (int j = 0; j < 3; ++j) { nq[j] = *(const uint2*)(F_QUP + (size_t)mn * 768 + 256 * j + 4 * lane); nkv[j] = *(const uint2*)(F_KVUP + (size_t)mn * 768 + 256 * j + 4 * lane); } }
        float krr[4];
        { f32x4 gk = ((const f32x4*)k_norm)[16 + (lane & 7)]; float kv_[4] = {kr.x * gk.x, kr.y * gk.y, kr.z * gk.z, kr.w * gk.w}; float kvr_[4] = {kv_[0], kv_[1], kv_[2], kv_[3]};
          rope32(kvr_, lane & 7, prow, pcl);
#pragma unroll
          for (int i = 0; i < 4; ++i) krr[i] = lat ? kvr_[i] : kv_[i]; }
        float sskr = kr.x * kr.x + kr.y * kr.y + kr.z * kr.z + kr.w * kr.w; sskr = __int_as_float(__builtin_amdgcn_readfirstlane(__float_as_int(sum16(sskr))));
#pragma unroll
        for (int j = 0; j < 3; ++j) {
            const int h = 2 * j + (lane >> 5);
            { f32x4 xq = cvt_bf4(qraw[j]);
              float x[4] = {xq.x, xq.y, xq.z, xq.w}; if (d0 >= 96) { x[0] = x[1] = x[2] = x[3] = 0.f; }
              float ss = x[0] * x[0] + x[1] * x[1] + x[2] * x[2] + x[3] * x[3];
              ss = sum32(ss);
              float rstd = rsqrtf(ss * (1.f / 96.f) + EPS);
              f32x4 g = {0.f, 0.f, 0.f, 0.f}; if (d0 < 96) g = ((const f32x4*)q_norm)[l32];
              float v[4] = {x[0] * rstd * g.x, x[1] * rstd * g.y, x[2] * rstd * g.z, x[3] * rstd * g.w};
              float vr[4] = {v[0], v[1], v[2], v[3]};
              rope32(vr, (l32 - 16) & 7, prow, pcl);
              if (lat && l32 >= 16 && l32 < 24) { v[0] = vr[0]; v[1] = vr[1]; v[2] = vr[2]; v[3] = vr[3]; }
              constexpr float QSB = 0.10206207261596575f * 1.4426950408889634f;
              if (d0 < 96) st_bf4(F_QB + (((size_t)ri.b * 6 + h) * TS + ri.sp) * 96 + d0, v[0] * QSB, v[1] * QSB, v[2] * QSB, v[3] * QSB); }
            { f32x4 xk = cvt_bf4(kvraw[j]);
              float x[4] = {xk.x, xk.y, xk.z, xk.w};
              float ss = d0 < 64 ? (x[0] * x[0] + x[1] * x[1] + x[2] * x[2] + x[3] * x[3]) : 0.f;
              ss = sum32(ss);
              float rstd = rsqrtf((ss + sskr) * (1.f / 96.f) + EPS);
              const size_t kbase = (((size_t)ri.b * 6 + h) * TS + ri.sp) * 96;
              if (d0 < 64) { f32x4 g = ((const f32x4*)k_norm)[l32]; st_bf4(F_KB + kbase + d0, x[0] * rstd * g.x, x[1] * rstd * g.y, x[2] * rstd * g.z, x[3] * rstd * g.w); }
              else { *(uint2*)(F_VB + (((size_t)ri.b * 6 + h) * TS + ri.sp) * 64 + (d0 - 64)) = kvraw[j]; }
#pragma unroll
              for (int hh = 0; hh < 2; ++hh) {
                  const float rs = __int_as_float(hh ? __builtin_amdgcn_readlane(__float_as_int(rstd), 32) : __builtin_amdgcn_readlane(__float_as_int(rstd), 0));
                  if (lane < 8) st_bf4(F_KB + (((size_t)ri.b * 6 + 2 * j + hh) * TS + ri.sp) * 96 + 64 + 4 * lane, krr[0] * rs, krr[1] * rs, krr[2] * rs, krr[3] * rs);
              } }
        }
    }
}
using pg8::Unit;
__device__ __forceinline__ float swg(float g, float u) { return (g * u) * __builtin_amdgcn_rcpf(1.f + __builtin_amdgcn_exp2f(-g)); }
struct EpiSwiglu { static constexpr bool PERM = true, AFTER_DRAIN = false; bf16_t* hid;
    __device__ __forceinline__ void operator()(const pg8::f32x4 (&acc)[2][2][4][2], const Unit& u, int wr, int wc, int fr_, int fq_) const {
        int fr = fr_, fq = fq_; asm volatile("" : "+v"(fr), "+v"(fq));
#ifdef PROBE_EPI2
        for (int rep_ = 0; rep_ < 2; ++rep_) { asm volatile("" ::: "memory");
#endif
        const int row0 = u.pm * 256 + wr * 64 + fr, hc = u.pn * 128 + wc * 32 + 8 * fq;
#pragma unroll
        for (int ai = 0; ai < 2; ++ai)
#pragma unroll
            for (int m = 0; m < 4; ++m) { const pg8::f32x4 g0 = acc[ai][0][m][0], g1 = acc[ai][0][m][1], u0 = acc[ai][1][m][0], u1 = acc[ai][1][m][1];
                u32x4 w; w.x = pg8::cvt_pk_bf16(swg(g0[0], u0[0]), swg(g0[1], u0[1])); w.y = pg8::cvt_pk_bf16(swg(g0[2], u0[2]), swg(g0[3], u0[3]));
                w.z = pg8::cvt_pk_bf16(swg(g1[0], u1[0]), swg(g1[1], u1[1])); w.w = pg8::cvt_pk_bf16(swg(g1[2], u1[2]), swg(g1[3], u1[3]));
                *(u32x4*)(hid + (size_t)(row0 + ai * 128 + m * 16) * DFF + hc) = w; }
#ifdef PROBE_EPI2
        }
#endif
    }
};
struct EpiResid { static constexpr bool PERM = false, AFTER_DRAIN = false; const float* baseL; float* outL; float* slab; const float* modl  ; int gate; float coef;
    __device__ __forceinline__ void operator()(const pg8::f32x4 (&acc)[2][2][4][2], const Unit& u, int wr, int wc, int fr_, int fq_) const {
        int fr = fr_, fq = fq_; asm volatile("" : "+v"(fr), "+v"(fq));
        const int col0 = u.pn * 256 + wc * 32 + 4 * fq;
        if (u.pm >= ML / 256) {
            float* sp = slab + ((size_t)(u.kt0 / u.nt) * MC + (u.pm * 256 - ML) + wr * 64 + fr) * D + col0;
#pragma unroll
            for (int ai = 0; ai < 2; ++ai)
#pragma unroll
                for (int m = 0; m < 4; ++m)
#pragma unroll
                    for (int bj = 0; bj < 2; ++bj)
#pragma unroll
                        for (int n = 0; n < 2; ++n) *(pg8::f32x4*)(sp + (size_t)(ai * 128 + m * 16) * D + bj * 128 + n * 16) = acc[ai][bj][m][n];
            return;
        }
        const int s = u.pm / (T / 256); const int rb = u.pm * 256 + wr * 64 + fr;
        const float* gp = modl + ((size_t)s * 9 + gate) * D;
        pg8::f32x4 gv[2][2];
#pragma unroll
        for (int bj = 0; bj < 2; ++bj)
#pragma unroll
            for (int n = 0; n < 2; ++n) gv[bj][n] = *(const pg8::f32x4*)(gp + col0 + bj * 128 + n * 16) * coef;
#ifdef PROBE_EPIR2
#pragma unroll 1
        for (int rep_ = 0; rep_ < 2; ++rep_) { asm volatile("" ::: "memory"); const float cz = rep_ ? 1.f : 0.f; const float* baseL = rep_ ? this->outL : this->baseL;
#pragma unroll
        for (int ai = 0; ai < 2; ++ai)
#pragma unroll
            for (int m = 0; m < 4; ++m) { const size_t off = (size_t)(rb + ai * 128 + m * 16) * D + col0;
#pragma unroll
                for (int bj = 0; bj < 2; ++bj)
#pragma unroll
                    for (int n = 0; n < 2; ++n) { const pg8::f32x4 bs = *(const pg8::f32x4*)(baseL + off + bj * 128 + n * 16); *(pg8::f32x4*)(outL + off + bj * 128 + n * 16) = bs + gv[bj][n] * cz * acc[ai][bj][m][n]; }
                if (m & 1) asm volatile("" ::: "memory"); }
        }
        return;
#endif
#pragma unroll
        for (int ai = 0; ai < 2; ++ai)
#pragma unroll
            for (int m = 0; m < 4; ++m) { const size_t off = (size_t)(rb + ai * 128 + m * 16) * D + col0;
#pragma unroll
                for (int bj = 0; bj < 2; ++bj)
#pragma unroll
                    for (int n = 0; n < 2; ++n) {
#if defined(RESID_NT)
                        const pg8::f32x4 bs = __builtin_nontemporal_load((const pg8::f32x4*)(baseL + off + bj * 128 + n * 16)); __builtin_nontemporal_store(bs + gv[bj][n] * acc[ai][bj][m][n], (pg8::f32x4*)(outL + off + bj * 128 + n * 16));
#elif defined(RESID_NTL)
                        const pg8::f32x4 bs = __builtin_nontemporal_load((const pg8::f32x4*)(baseL + off + bj * 128 + n * 16)); *(pg8::f32x4*)(outL + off + bj * 128 + n * 16) = bs + gv[bj][n] * acc[ai][bj][m][n];
#else
                        const pg8::f32x4 bs = *(const pg8::f32x4*)(baseL + off + bj * 128 + n * 16); *(pg8::f32x4*)(outL + off + bj * 128 + n * 16) = bs + gv[bj][n] * acc[ai][bj][m][n];
#endif
                    }
                if (m & 1) asm volatile("" ::: "memory"); }
    }
};
__device__ __forceinline__ u32x4 pack8(const pg8::f32x4& a, const pg8::f32x4& b) { u32x4 w; w.x = pg8::cvt_pk_bf16(a[0], a[1]); w.y = pg8::cvt_pk_bf16(a[2], a[3]); w.z = pg8::cvt_pk_bf16(b[0], b[1]); w.w = pg8::cvt_pk_bf16(b[2], b[3]); return w; }
struct EpiInproj { static constexpr bool PERM = true, AFTER_DRAIN = false; bf16_t* pa; float* g32; bf16_t* pb;
    __device__ __forceinline__ void operator()(const pg8::f32x4 (&acc)[2][2][4][2], const Unit& u, int wr, int wc, int fr_, int fq_) const {
        int fr = fr_, fq = fq_; asm volatile("" : "+v"(fr), "+v"(fq));
        const int row0 = u.pm * 256 + wr * 64 + fr, c0 = wc * 32 + 8 * fq;
        if (u.pn == 3) {
            if (wc < 2) {
#pragma unroll
                for (int ai = 0; ai < 2; ++ai)
#pragma unroll
                    for (int m = 0; m < 4; ++m) { float* p = g32 + (size_t)(row0 + ai * 128 + m * 16) * 64 + c0; *(pg8::f32x4*)p = acc[ai][0][m][0]; *(pg8::f32x4*)(p + 4) = acc[ai][0][m][1]; }
            }
            return;
        }
        bf16_t* dst = u.pn < 3 ? pa + (size_t)row0 * 768 + u.pn * 256 + c0 : pb + (size_t)row0 * 1024 + (u.pn - 4) * 256 + c0; const size_t ld = u.pn < 3 ? 768 : 1024;
#pragma unroll
        for (int ai = 0; ai < 2; ++ai)
#pragma unroll
            for (int m = 0; m < 4; ++m)
#pragma unroll
                for (int bj = 0; bj < 2; ++bj) *(u32x4*)(dst + (size_t)(ai * 128 + m * 16) * ld + bj * 128) = pack8(acc[ai][bj][m][0], acc[ai][bj][m][1]);
    }
};
struct EpiUp { static constexpr bool PERM = true, AFTER_DRAIN = false; bf16_t* qup; bf16_t* kvup;
    __device__ __forceinline__ void operator()(const pg8::f32x4 (&acc)[2][2][4][2], const Unit& u, int wr, int wc, int fr_, int fq_) const {
        int fr = fr_, fq = fq_; asm volatile("" : "+v"(fr), "+v"(fq));
        const int row0 = u.pm * 256 + wr * 64 + fr, c0 = wc * 32 + 8 * fq;
        bf16_t* dst = (u.pn < 3 ? qup + u.pn * 256 : kvup + (u.pn - 3) * 256) + (size_t)row0 * 768 + c0;
#pragma unroll
        for (int ai = 0; ai < 2; ++ai)
#pragma unroll
            for (int m = 0; m < 4; ++m)
#pragma unroll
                for (int bj = 0; bj < 2; ++bj) *(u32x4*)(dst + (size_t)(ai * 128 + m * 16) * 768 + bj * 128) = pack8(acc[ai][bj][m][0], acc[ai][bj][m][1]);
    }
};

constexpr int LOCW = 2112, NCS = 68;
#define F_LOC ((float*)(F.ws + WS_LOC))
__device__ __forceinline__ int mls_cs(int isctx, int j, int dir) { return isctx ? (dir ? 3 - j : j) : 4 + (dir ? 63 - j : j); }
template <int NE>
__device__ __forceinline__ void ph_mlstm_m2(Frame& F, int widx, int nw) {
    OPAQUE_TID(F);
    constexpr int TPS = (2080 + NE - 1) / NE;
    const int g = widx * 512 + F.tid; if (g >= 32 * TPS) return;
    const int seq = g / TPS, r = g % TPS;
    float* base = F_LOC + (size_t)seq * NCS * LOCW + r;
    bool ok[NE]; float val[NE]; float m = 0.f;
#pragma unroll
    for (int j = 0; j < NE; ++j) { ok[j] = r + j * TPS < 2080; val[j] = 0.f; }
#pragma unroll 1
    for (int c0 = 0; c0 < NCS; c0 += 17) {
        float bl[17], ml[17], x[NE][17];
#pragma unroll
        for (int i = 0; i < 17; ++i) { const float* p = base + (size_t)(c0 + i) * LOCW; bl[i] = p[2080 - r]; ml[i] = p[2081 - r];
#pragma unroll
            for (int j = 0; j < NE; ++j) x[j][i] = p[ok[j] ? j * TPS : 0]; }
#pragma unroll
        for (int i = 0; i < 17; ++i) { float* p = base + (size_t)(c0 + i) * LOCW;
#pragma unroll
            for (int j = 0; j < NE; ++j) if (ok[j]) p[j * TPS] = val[j];
            if (r == 0) p[2082] = m;
            const float mn = fmaxf(bl[i] + m, ml[i]); const float a = __expf(bl[i] + m - mn), b = __expf(ml[i] - mn);
#pragma unroll
            for (int j = 0; j < NE; ++j) val[j] = a * val[j] + b * x[j][i];
            m = mn; }
    }
}

typedef short bf16x8 __attribute__((ext_vector_type(8)));
typedef short v4i16_t __attribute__((ext_vector_type(4)));
typedef float f32x16 __attribute__((ext_vector_type(16)));
#define MFMA32(a, b, c) __builtin_amdgcn_mfma_f32_32x32x16_bf16((a), (b), (c), 0, 0, 0)
__device__ __forceinline__ int crow(int r, int h) { return (r & 3) + 8 * (r >> 2) + 4 * h; }
__device__ __forceinline__ unsigned cvtpk(float lo, float hi) { typedef float f2_t __attribute__((ext_vector_type(2))); typedef __bf16 b2_t __attribute__((ext_vector_type(2))); f2_t v = {lo, hi}; b2_t b = __builtin_convertvector(v, b2_t); return __builtin_bit_cast(unsigned, b); }
__device__ __forceinline__ v4i16_t vtr(const LAS unsigned char* p) { return __builtin_amdgcn_ds_read_tr16_b64_v4i16((LAS v4i16_t*)p); }
__device__ __forceinline__ float max3f(float a, float b, float c) { float r; asm("v_max3_f32 %0, %1, %2, %3" : "=v"(r) : "v"(a), "v"(b), "v"(c)); return r; }
#ifdef PROBE_MLA2X
constexpr int MLA_NP = 2 * (TS / 128), MLA_WRAP = TS / 128;
#else
constexpr int MLA_NP = TS / 128, MLA_WRAP = 1 << 20;
#endif
constexpr float ATT_THR = 6.0f;

template <int DQK, bool BAND, bool SINK>
__device__ __forceinline__ void attn_unit256(Frame& F, const bf16_t* Qrows, const bf16_t* Kseq, const bf16_t* Vseq, int npairs, int qpos0, float sink2, bf16_t* Yout) {
    constexpr int NCH = DQK / 8, KSTR = DQK * 2 + 16, KST = 128 * KSTR, STAGE = KST + 16384, NKI = (128 * NCH) / 512, NKS = DQK / 16;
    static_assert((128 * NCH) % 512 == 0 && 2 * STAGE <= RING_BYTES, "attention staging / LDS");
    int tid_ = F.tid; asm volatile("" : "+v"(tid_));
    const int tid = tid_, lane = tid_ & 63, wave = F.wave, r32 = lane & 31, h = lane >> 5;
    LAS unsigned char* L = F.lds;
    bf16x8 qf[NKS];
#pragma unroll
    for (int ks = 0; ks < NKS; ++ks) qf[ks] = *(const bf16x8*)(Qrows + (size_t)(32 * wave + r32) * DQK + 16 * ks + 8 * h);
    const f32x16 z16 = {0.f, 0.f, 0.f, 0.f, 0.f, 0.f, 0.f, 0.f, 0.f, 0.f, 0.f, 0.f, 0.f, 0.f, 0.f, 0.f};
    f32x16 o0 = z16, o1 = z16;
    float l_run = (SINK && h == 0) ? __builtin_amdgcn_exp2f(sink2) : 0.f;
    u32x4 kreg[NKI], vreg[2];
#define ATT_SEQ0(p) ((BAND && (p) >= 2) ? (TC + qpos0 - 128 + 128 * ((p) - 2)) : 128 * ((p) % MLA_WRAP))
#define ATT_LOAD(p) do { const int seq0_ = ATT_SEQ0(p); \
        _Pragma("unroll") for (int i_ = 0; i_ < NKI; ++i_) { const int cid = tid + 512 * i_; const int key = cid / NCH, ch = cid % NCH; int sr = seq0_ + key; sr = sr < 0 ? 0 : (sr > TS - 1 ? TS - 1 : sr); \
            kreg[i_] = *(const u32x4*)(Kseq + (size_t)sr * DQK + ch * 8); } \
        _Pragma("unroll") for (int i_ = 0; i_ < 2; ++i_) { const int cid = tid + 512 * i_; const int key = cid >> 3, ch = cid & 7; int sr = seq0_ + key; sr = sr < 0 ? 0 : (sr > TS - 1 ? TS - 1 : sr); \
            vreg[i_] = *(const u32x4*)(Vseq + (size_t)sr * 64 + ch * 8); } } while (0)
#define ATT_STORE(st) do { LAS unsigned char* sb_ = L + (st) * STAGE; \
        _Pragma("unroll") for (int i_ = 0; i_ < NKI; ++i_) { const int cid = tid + 512 * i_; const int key = cid / NCH, ch = cid % NCH; *(LAS u32x4*)(sb_ + key * KSTR + ch * 16) = kreg[i_]; } \
        _Pragma("unroll") for (int i_ = 0; i_ < 2; ++i_) { const int cid = tid + 512 * i_; const int key = cid >> 3, ch = cid & 7; \
            *(LAS u32x4*)(sb_ + KST + (key >> 6) * 8192 + (ch >> 2) * 4096 + (key & 63) * 64 + (ch & 3) * 16) = vreg[i_]; } } while (0)
    ATT_LOAD(0); ATT_STORE(0); if (npairs > 1) ATT_LOAD(1);
    __syncthreads();
    const int trcol = ((lane >> 4) & 1) * 32 + (lane & 3) * 8, q4 = (lane & 15) >> 2;
    const int qpos = qpos0 + 32 * wave + r32;
    if (wave >= 4) __builtin_amdgcn_s_setprio(1);
#pragma unroll 1
    for (int p = 0; p < npairs; ++p) {
        const int st = p & 1;
        bool need = true;
        if (BAND && p >= 2) { const int k0 = qpos0 - 128 + 128 * (p - 2); const int r0 = qpos0 + 32 * wave; need = (k0 <= r0 + 31 + 128) && (k0 + 127 >= r0 - 128) && (k0 + 127 >= 0) && (k0 < T); }
        if (need) {
#ifdef ATT_ROT
            const int boff = (wave >> 2) * 2;
#else
            const int boff = 0;
#endif
            const LAS unsigned char* Kt = L + st * STAGE + r32 * KSTR + 16 * h;
            const LAS unsigned char* Vb = L + st * STAGE + KST + (4 * h + q4) * 64 + trcol;
            f32x16 sa, sb;
            bf16x8 kf[NKS];
#pragma unroll
            for (int ks = 0; ks < NKS; ++ks) kf[ks] = *(const LAS bf16x8*)(Kt + (32 * boff) * KSTR + 32 * ks);
            __builtin_amdgcn_sched_barrier(0);
            sa = MFMA32(kf[0], qf[0], z16);
#pragma unroll
            for (int ks = 1; ks < NKS; ++ks) sa = MFMA32(kf[ks], qf[ks], sa);
            float rs = 0.f;
#pragma unroll
            for (int blk = 0; blk < 4; ++blk) {
                const int bb = (blk + boff) & 3, bn = (blk + 1 + boff) & 3;
                const LAS unsigned char* vp = Vb + (bb >> 1) * 8192 + (32 * (bb & 1)) * 64;
                v4i16_t vl[2][2], vh[2][2];
#pragma unroll
                for (int s = 0; s < 2; ++s) { vl[0][s] = vtr(vp + (16 * s) * 64); vh[0][s] = vtr(vp + (16 * s + 8) * 64); vl[1][s] = vtr(vp + 4096 + (16 * s) * 64); vh[1][s] = vtr(vp + 4096 + (16 * s + 8) * 64); }
                if (blk < 3) {
#pragma unroll
                    for (int ks = 0; ks < NKS; ++ks) kf[ks] = *(const LAS bf16x8*)(Kt + (32 * bn) * KSTR + 32 * ks);
                }
#ifdef PROBE_LDS2
                { bf16x8 dk[NKS];
#pragma unroll
                  for (int ks = 0; ks < NKS; ++ks) { dk[ks] = *(const LAS bf16x8*)(Kt + (32 * bb) * KSTR + 32 * ks); asm volatile("" :: "v"(dk[ks])); } }
#endif
                __builtin_amdgcn_sched_barrier(0);
                if (BAND && p >= 2) {
                    const int kb0 = qpos0 - 128 + 128 * (p - 2) + 32 * bb;
#pragma unroll
                    for (int i = 0; i < 16; ++i) { const int kp = kb0 + crow(i, h); const int d0 = qpos - kp; if (!(kp >= 0 && kp < T && d0 <= 128 && d0 >= -128)) sa[i] = -INFINITY; }
                }
#pragma unroll
                for (int ks = 0; ks < NKS; ++ks) {
                    if (blk < 3) sb = MFMA32(kf[ks], qf[ks], ks == 0 ? z16 : sb);
#ifndef ATT_NOPIN
                    __builtin_amdgcn_sched_barrier(0);
#endif
#pragma unroll
                    for (int i = (16 * ks) / NKS; i < (16 * (ks + 1)) / NKS; ++i) { sa[i] = __builtin_amdgcn_exp2f(sa[i]); rs += sa[i]; }
#ifndef ATT_NOPIN
                    __builtin_amdgcn_sched_barrier(0);
#else
                    __builtin_amdgcn_sched_group_barrier(0x8, 1, 0); __builtin_amdgcn_sched_group_barrier(0x2, 6, 0);
#endif
                }
                bf16x8 pf[2];
#pragma unroll
                for (int s = 0; s < 2; ++s) { u32x4 a = {cvtpk(sa[8 * s], sa[8 * s + 1]), cvtpk(sa[8 * s + 2], sa[8 * s + 3]), cvtpk(sa[8 * s + 4], sa[8 * s + 5]), cvtpk(sa[8 * s + 6], sa[8 * s + 7])}; pf[s] = __builtin_bit_cast(bf16x8, a); }
                __builtin_amdgcn_sched_barrier(0);
#pragma unroll
                for (int s = 0; s < 2; ++s) {
                    const v4i16_t lo0 = vl[0][s], hi0 = vh[0][s], lo1 = vl[1][s], hi1 = vh[1][s];
                    const bf16x8 va0 = {lo0[0], lo0[1], lo0[2], lo0[3], hi0[0], hi0[1], hi0[2], hi0[3]}; const bf16x8 va1 = {lo1[0], lo1[1], lo1[2], lo1[3], hi1[0], hi1[1], hi1[2], hi1[3]};
                    o0 = MFMA32(va0, pf[s], o0); o1 = MFMA32(va1, pf[s], o1);
                }
                if (blk < 3) sa = sb;
            }
            l_run += rs;
        }
        if (p + 1 < npairs) ATT_STORE(st ^ 1);
        if (p + 2 < npairs) ATT_LOAD(p + 2);
        __syncthreads();
    }
#undef ATT_SEQ0
#undef ATT_LOAD
#undef ATT_STORE
    if (wave >= 4) __builtin_amdgcn_s_setprio(0);
    {
        const float inv = 1.f / xor32_sum(l_run);
        LAS unsigned char* osc = L + wave * (32 * 144) + r32 * 144;
#pragma unroll
        for (int i = 0; i < 16; i += 2) { *(LAS unsigned*)(osc + crow(i, h) * 2) = cvtpk(o0[i] * inv, o0[i + 1] * inv); *(LAS unsigned*)(osc + (32 + crow(i, h)) * 2) = cvtpk(o1[i] * inv, o1[i + 1] * inv); }
        LDS_WAIT();
        const LAS unsigned char* osr = L + wave * (32 * 144);
#pragma unroll
        for (int i = 0; i < 4; ++i) { const int row = i * 8 + (lane >> 3), ch = lane & 7; const u32x4 v = *(const LAS u32x4*)(osr + row * 144 + ch * 16);
            *(u32x4*)(Yout + (size_t)(32 * wave + row) * D + ch * 8) = v; }
    }
    __syncthreads();
}

__device__ __forceinline__ void mlstm_m1_mfma(Frame& F, int l, int item) {
    constexpr int KT = 0, VT = 4096, SW = 12288, SST = 12800;
    int tid_ = F.tid; asm volatile("" : "+v"(tid_)); const int tid = tid_, lane = tid & 63, wave = F.wave, hh = lane >> 5;
    LAS unsigned char* L = F.lds;
    int isctx, b, h, j;
    if (item < 1024) { isctx = 0; b = item >> 8; h = (item >> 6) & 3; j = item & 63; } else { const int r = item - 1024; isctx = 1; b = r >> 4; h = (r >> 2) & 3; j = r & 3; }
    const int rbase = (isctx ? ML + b * TC : b * T) + 64 * j;
    const float* gate_b = F.in[I_GATEB] + l * 16;
    if (tid < 256) { const int tok = tid >> 2, ch = tid & 3; *(LAS u32x4*)(L + KT + tok * 64 + ch * 16) = *(const u32x4*)(F_P16A + (size_t)(rbase + tok) * 768 + 128 + h * 32 + ch * 8); }
    { const int tok = tid >> 3, ch = tid & 7; *(LAS u32x4*)(L + VT + (ch >> 2) * 4096 + tok * 64 + (ch & 3) * 16) = *(const u32x4*)(F_P16A + (size_t)(rbase + tok) * 768 + 256 + h * 64 + ch * 8); }
    if (wave < 2) {
        const int dir = wave, p = lane, tok = dir ? 63 - p : p; const int gi = dir ? 2 : 0;
        const float* pr = F_G32 + (size_t)(rbase + tok) * 64; const float ig = pr[gi * 4 + h] + gate_b[gi * 4 + h]; const float lf = logsigmoidf_(pr[(gi + 1) * 4 + h] + gate_b[(gi + 1) * 4 + h]);
        const float v = scan_sum64(lf); const float blast = lane_bcast(v, 63); const float g = blast - v + ig; const float gm = lane_bcast(scan_max64(g), 63);
        ((LAS float*)(L + SW))[dir * 64 + tok] = __expf(g - gm);
        if (p == 0) { ((LAS float*)(L + SST))[2 * dir] = blast; ((LAS float*)(L + SST))[2 * dir + 1] = gm; }
    }
    __syncthreads();
    if (wave < 4) {
        const int dir = wave >> 1, eb = wave & 1;
        const int trcol = ((lane >> 4) & 1) * 32 + (lane & 3) * 8, q4 = (lane & 15) >> 2;
        const LAS float* wp = (const LAS float*)(L + SW) + dir * 64;
        const f32x16 z16 = {0.f, 0.f, 0.f, 0.f, 0.f, 0.f, 0.f, 0.f, 0.f, 0.f, 0.f, 0.f, 0.f, 0.f, 0.f, 0.f};
        f32x16 acc = z16, accn = z16;
        const bf16x8 ones = {0x3f80, 0x3f80, 0x3f80, 0x3f80, 0x3f80, 0x3f80, 0x3f80, 0x3f80};
#pragma unroll
        for (int ks = 0; ks < 4; ++ks) {
            const int s0 = 16 * ks + 8 * hh;
            const v4i16_t klo = vtr(L + KT + (s0 + q4) * 64 + trcol), khi = vtr(L + KT + (s0 + 4 + q4) * 64 + trcol);
            const v4i16_t vlo = vtr(L + VT + eb * 4096 + (s0 + q4) * 64 + trcol), vhi = vtr(L + VT + eb * 4096 + (s0 + 4 + q4) * 64 + trcol);
            const f32x4 w0 = *(const LAS f32x4*)(wp + s0), w1 = *(const LAS f32x4*)(wp + s0 + 4);
            u32x4 aw; aw.x = cvtpk(bf2f((bf16_t)klo[0]) * w0[0], bf2f((bf16_t)klo[1]) * w0[1]); aw.y = cvtpk(bf2f((bf16_t)klo[2]) * w0[2], bf2f((bf16_t)klo[3]) * w0[3]);
            aw.z = cvtpk(bf2f((bf16_t)khi[0]) * w1[0], bf2f((bf16_t)khi[1]) * w1[1]); aw.w = cvtpk(bf2f((bf16_t)khi[2]) * w1[2], bf2f((bf16_t)khi[3]) * w1[3]);
            const bf16x8 af = __builtin_bit_cast(bf16x8, aw); const bf16x8 vf = {vlo[0], vlo[1], vlo[2], vlo[3], vhi[0], vhi[1], vhi[2], vhi[3]};
            acc = MFMA32(af, vf, acc);
            if (eb == 0) accn = MFMA32(af, ones, accn);
        }
        float* Lp = F_LOC + ((size_t)((b * 4 + h) * 2 + dir) * NCS + mls_cs(isctx, j, dir)) * LOCW;
        const int e = 32 * eb + (lane & 31);
#pragma unroll
        for (int i = 0; i < 16; ++i) Lp[crow(i, hh) * 64 + e] = acc[i];
        if (eb == 0) {
            if ((lane & 31) == 0) {
#pragma unroll
                for (int i = 0; i < 16; ++i) Lp[2048 + crow(i, hh)] = accn[i];
            }
            if (lane == 0) { Lp[2080] = ((LAS float*)(L + SST))[2 * dir]; Lp[2081] = ((LAS float*)(L + SST))[2 * dir + 1]; }
        }
    }
    __syncthreads();
}
__device__ __forceinline__ void ph_mlstm_m1b(Frame& F, int l) { for (int it = F.vcu; it < 1024 + 64; it += F.G) mlstm_m1_mfma(F, l, it); }

__device__ __forceinline__ void mlstm_m3_mfma(Frame& F, int l, int item0) {
    constexpr int KT = 0, VT = 5120, CT = 13312, SN = 23552, SU = 23808, SM = 24320, SB = 24832, SMST = 25344, HB = 25600, HALFB = 45056;
    constexpr float QS = 0.17677669529663687f;
    int tid_ = F.tid; asm volatile("" : "+v"(tid_)); const int tid = tid_, lane = tid & 63, wave = F.wave, r32 = lane & 31, hh = lane >> 5;
    const int half = wave >> 2, hw = wave & 3, htid = tid & 255, tb = hw >> 1, eb = hw & 1;
    LAS unsigned char* L = F.lds + half * HALFB;
    const int item = item0 + half;
    int isctx, b, h, j;
    if (item < 1024) { isctx = 0; b = item >> 8; h = (item >> 6) & 3; j = item & 63; } else { const int r = item - 1024; isctx = 1; b = r >> 4; h = (r >> 2) & 3; j = r & 3; }
    const int rbase = (isctx ? ML + b * TC : b * T) + 64 * j;
    const float* gate_b = F.in[I_GATEB] + l * 16;
    const float* stf = F_LOC + ((size_t)((b * 4 + h) * 2) * NCS + mls_cs(isctx, j, 0)) * LOCW; const float* stb = F_LOC + ((size_t)((b * 4 + h) * 2 + 1) * NCS + mls_cs(isctx, j, 1)) * LOCW;
    bf16x8 qf[2][2];
#pragma unroll
    for (int dir = 0; dir < 2; ++dir) { const int tposq = 32 * (dir ? 1 - tb : tb) + r32; const int ttokq = dir ? 63 - tposq : tposq;
#pragma unroll
        for (int ks = 0; ks < 2; ++ks) qf[dir][ks] = *(const bf16x8*)(F_P16A + (size_t)(rbase + ttokq) * 768 + h * 32 + 16 * ks + 8 * hh); }
    { const int tok = htid >> 2, ch = htid & 3; *(LAS u32x4*)(L + KT + tok * 80 + ch * 16) = *(const u32x4*)(F_P16A + (size_t)(rbase + tok) * 768 + 128 + h * 32 + ch * 8); }
#pragma unroll
    for (int i = 0; i < 2; ++i) { const int cid = htid + 256 * i, tok = cid >> 3, ch = cid & 7; *(LAS u32x4*)(L + VT + (ch >> 2) * 4096 + tok * 64 + (ch & 3) * 16) = *(const u32x4*)(F_P16A + (size_t)(rbase + tok) * 768 + 256 + h * 64 + ch * 8); }
#pragma unroll
    for (int dir = 0; dir < 2; ++dir) { const float* st = dir ? stb : stf;
#pragma unroll
        for (int i = 0; i < 2; ++i) { const int idx = htid + 256 * i, d = idx >> 4, e0 = (idx & 15) * 4; const f32x4 c = *(const f32x4*)(st + d * 64 + e0);
            LAS unsigned char* cp = L + CT + dir * 5120 + e0 * 80 + d * 2;
            *(LAS bf16_t*)(cp) = f2bf(c.x); *(LAS bf16_t*)(cp + 80) = f2bf(c.y); *(LAS bf16_t*)(cp + 160) = f2bf(c.z); *(LAS bf16_t*)(cp + 240) = f2bf(c.w); } }
    if (htid < 64) { const int dir = htid >> 5, d = htid & 31; ((LAS float*)(L + SN))[dir * 32 + d] = (dir ? stb : stf)[2048 + d]; }
    if (hw < 2) { const int dir = hw, p = lane, tok = dir ? 63 - p : p; const int gi = dir ? 2 : 0;
        const float* pr = F_G32 + (size_t)(rbase + tok) * 64; const float ig = pr[gi * 4 + h] + gate_b[gi * 4 + h]; const float lf = logsigmoidf_(pr[(gi + 1) * 4 + h] + gate_b[(gi + 1) * 4 + h]);
        const float v = scan_sum64(lf);
        const float u0 = ig - v; const float cm = scan_max64(u0);
        const float m = (dir ? stb : stf)[2082];
        ((LAS float*)(L + SU))[dir * 64 + p] = u0; ((LAS float*)(L + SM))[dir * 64 + p] = fmaxf(m, cm); ((LAS float*)(L + SB))[dir * 64 + p] = v;
        if (p == 0) ((LAS float*)(L + SMST))[dir] = m; }
    const u32x4 og0 = *(const u32x4*)(F_P16A + (size_t)(rbase + (htid >> 2)) * 768 + 512 + h * 64 + (htid & 3) * 16), og1 = *(const u32x4*)(F_P16A + (size_t)(rbase + (htid >> 2)) * 768 + 512 + h * 64 + (htid & 3) * 16 + 8);
    __syncthreads();
    const int trcol = ((lane >> 4) & 1) * 32 + (lane & 3) * 8, q4 = (lane & 15) >> 2;
#pragma unroll
    for (int dir = 0; dir < 2; ++dir) {
        const int tbd = dir ? 1 - tb : tb; const int tpos = 32 * tbd + r32; const int ttok = dir ? 63 - tpos : tpos;
        const float Mt = ((LAS float*)(L + SM))[dir * 64 + tpos], bt = ((LAS float*)(L + SB))[dir * 64 + tpos], mst = ((LAS float*)(L + SMST))[dir];
        float nq = 0.f;
#pragma unroll
        for (int ks = 0; ks < 2; ++ks) { const LAS float* np = (LAS float*)(L + SN) + dir * 32 + 16 * ks + 8 * hh;
#pragma unroll
            for (int jj = 0; jj < 8; ++jj) nq += bf2f((bf16_t)qf[dir][ks][jj]) * np[jj]; }
        nq = xor32_sum(nq);
        const float at = __expf(mst - Mt) * QS;
        f32x16 o;
#pragma unroll
        for (int i = 0; i < 16; ++i) o[i] = 0.f;
#pragma unroll
        for (int ks = 0; ks < 2; ++ks) { const bf16x8 cf = *(const LAS bf16x8*)(L + CT + dir * 5120 + (32 * eb + r32) * 80 + (16 * ks + 8 * hh) * 2); o = MFMA32(cf, qf[dir][ks], o); }
#pragma unroll
        for (int i = 0; i < 16; ++i) o[i] *= at;
        float rs = 0.f;
#pragma unroll
        for (int sb = 0; sb < 2; ++sb) {
            if (sb <= tbd) {
                const int srow = 32 * sb + r32; const int stok = dir ? 63 - srow : srow;
                f32x16 s;
#pragma unroll
                for (int i = 0; i < 16; ++i) s[i] = 0.f;
#pragma unroll
                for (int ks = 0; ks < 2; ++ks) { const bf16x8 kf = *(const LAS bf16x8*)(L + KT + stok * 80 + (16 * ks + 8 * hh) * 2); s = MFMA32(kf, qf[dir][ks], s); }
#pragma unroll
                for (int g = 0; g < 4; ++g) { const f32x4 uv = *(const LAS f32x4*)((LAS float*)(L + SU) + dir * 64 + 32 * sb + 8 * g + 4 * hh);
#pragma unroll
                    for (int c = 0; c < 4; ++c) { const int spos = 32 * sb + 8 * g + 4 * hh + c; const float w = spos <= tpos ? __expf(uv[c] - Mt) * QS : 0.f; const float sw = s[4 * g + c] * w; s[4 * g + c] = sw; rs += sw; } }
#pragma unroll
                for (int s2 = 0; s2 < 2; ++s2) {
                    u32x4 pw = {cvtpk(s[8 * s2], s[8 * s2 + 1]), cvtpk(s[8 * s2 + 2], s[8 * s2 + 3]), cvtpk(s[8 * s2 + 4], s[8 * s2 + 5]), cvtpk(s[8 * s2 + 6], s[8 * s2 + 7])};
                    const bf16x8 pf = __builtin_bit_cast(bf16x8, pw);
                    const int p0 = 32 * sb + 16 * s2 + 4 * hh + q4, p1 = p0 + 8; const int t0 = dir ? 63 - p0 : p0, t1 = dir ? 63 - p1 : p1;
                    const v4i16_t lo = vtr(L + VT + eb * 4096 + t0 * 64 + trcol), hi = vtr(L + VT + eb * 4096 + t1 * 64 + trcol);
                    const bf16x8 va = {lo[0], lo[1], lo[2], lo[3], hi[0], hi[1], hi[2], hi[3]};
                    o = MFMA32(va, pf, o);
                }
            }
        }
        rs = xor32_sum(rs);
        const float den = (at * nq) + rs; const float idn = 1.f / fmaxf(fabsf(den), __expf(-(bt + Mt)));
        LAS float* hp = (LAS float*)(L + HB) + ttok * 65 + 32 * eb;
        if (dir == 0) {
#pragma unroll
            for (int i = 0; i < 16; ++i) hp[crow(i, hh)] = o[i] * idn;
        } else {
#pragma unroll
            for (int i = 0; i < 16; ++i) hp[crow(i, hh)] += o[i] * idn;
        }
    }
    __syncthreads();
    { const int t = htid >> 2, e0 = (htid & 3) * 16; const float* out_norm = F.in[I_OUTNORM] + l * 256 + h * 64 + e0; float hv[16]; float ss = 0.f;
      const LAS float* hb = (LAS float*)(L + HB) + t * 65 + e0;
#pragma unroll
      for (int i = 0; i < 16; ++i) { hv[i] = hb[i]; ss += hv[i] * hv[i]; }
      ss += dpp_f<0xB1>(ss); ss += dpp_f<0x4E>(ss);
      const float rstd = rsqrtf(ss * (1.f / 64.f) + EPS);
      const unsigned ogw[8] = {og0.x, og0.y, og0.z, og0.w, og1.x, og1.y, og1.z, og1.w};
      unsigned ow[8];
#pragma unroll
      for (int i = 0; i < 8; ++i) { const float g0 = __uint_as_float(ogw[i] << 16), g1 = __uint_as_float(ogw[i] & 0xffff0000u);
          const float r0 = hv[2 * i] * rstd * out_norm[2 * i] * __builtin_amdgcn_rcpf(1.f + __expf(-g0)), r1 = hv[2 * i + 1] * rstd * out_norm[2 * i + 1] * __builtin_amdgcn_rcpf(1.f + __expf(-g1));
          ow[i] = cvtpk(r0, r1); }
      u32x4 w0 = {ow[0], ow[1], ow[2], ow[3]}, w1 = {ow[4], ow[5], ow[6], ow[7]};
      bf16_t* yp = F_Y + (size_t)(rbase + t) * D + h * 64 + e0; *(u32x4*)yp = w0; *(u32x4*)(yp + 8) = w1; }
    __syncthreads();
}

__device__ __forceinline__ void attn_dispatch(Frame& F, int l, int idx) {
    constexpr float LOG2E = 1.4426950408889634f;
    if (idx < 384) { const int bh6 = idx >> 4, qb = idx & 15; const int b = bh6 / 6, h = bh6 % 6; const size_t bh = (size_t)bh6;
        attn_unit256<96, false, false>(F, F_QB + (bh * TS + TC + 256 * qb) * 96, F_KB + bh * TS * 96, F_VB + bh * TS * 64, MLA_NP, 0, 0.f, F_Y + (size_t)(b * T + 256 * qb) * D + 256 + h * 64); return; }
    idx -= 384;
    if (idx < 384) { const int bh6 = idx >> 4, qb = idx & 15; const int b = bh6 / 6, hq = bh6 % 6; const int kvh = hq / 3; const size_t bk = (size_t)b * 2 + kvh;
        attn_unit256<64, true, true>(F, F_QC + ((size_t)bh6 * TS + TC + 256 * qb) * 64, F_KC + bk * TS * 64, F_VC + bk * TS * 64, 6, 256 * qb, F.in[I_SINK][l * 6 + hq] * LOG2E, F_Y + (size_t)(b * T + 256 * qb) * D + 640 + hq * 64); return; }
    idx -= 384;
    if (idx < 24) { const int b = idx / 6, h = idx % 6; const size_t bh = (size_t)idx;
        attn_unit256<96, false, false>(F, F_QB + (bh * TS) * 96, F_KB + bh * TS * 96, F_VB + bh * TS * 64, 2, 0, 0.f, F_Y + (size_t)(ML + b * TC) * D + 256 + h * 64); return; }
    idx -= 24;
    { const int b = idx / 6, hq = idx % 6; const int kvh = hq / 3; const size_t bk = (size_t)b * 2 + kvh;
        attn_unit256<64, false, true>(F, F_QC + ((size_t)idx * TS) * 64, F_KC + bk * TS * 64, F_VC + bk * TS * 64, 2, 0, F.in[I_SINK][l * 6 + hq] * LOG2E, F_Y + (size_t)(ML + b * TC) * D + 640 + hq * 64); }
}
constexpr int CW_Q = 8192;
__device__ __forceinline__ void mix_unit(Frame& F, int l, int x, int li) {
    int idx; bool m3 = false; const int b = x >> 1, kvh = x & 1;
    if (li < 48) idx = (x + 8 * (li >> 4)) * 16 + (li & 15);
    else if (li < 96) { const int r = li - 48; idx = 384 + (b * 6 + kvh * 3 + (r >> 4)) * 16 + (r & 15); }
    else if (li < 160) { m3 = true; idx = x * 128 + 2 * (li - 96); }
    else if (li < 164) { m3 = true; idx = 1024 + x * 8 + 2 * (li - 160); }
    else if (li < 167) idx = 768 + x + 8 * (li - 164);
    else idx = 792 + b * 6 + kvh * 3 + (li - 167);
    if (m3) mlstm_m3_mfma(F, l, idx); else attn_dispatch(F, l, idx);
}
__device__ __forceinline__ void ph_mixers(Frame& F, int l, int rep) {
    OPAQUE_TID(F);
    const bool need_ctx = l + 1 < DEPTH;
    const int nloc = 160 + (need_ctx ? 10 : 0);
    unsigned* ctr0 = (unsigned*)(F.ws + WS_CTL) + CW_Q + 64 * 8 * (l + 2 * rep);
    volatile LAS int* slot = (volatile LAS int*)(F.lds + MISC_OFF + 64);
    const int x0 = (int)(xb_xcc_id() & 7u);
    for (int xs = 0; xs < 8; ++xs) {
        const int x = (x0 + xs) & 7;
        for (;;) {
            if (F.tid == 0) slot[0] = (int)__hip_atomic_fetch_add(ctr0 + 64 * x, 1u, __ATOMIC_RELAXED, __HIP_MEMORY_SCOPE_AGENT);
            __syncthreads();
            const int li = slot[0];
            __syncthreads();
            if (li >= nloc) break;
            mix_unit(F, l, x, li);
        }
    }
}

__global__ void __launch_bounds__(512, 2) fwd_mk(Args args) {
    extern __shared__ __attribute__((aligned(16))) unsigned char lds[];
    Frame F;
    F.lds = (LAS unsigned char*)lds;
    volatile LAS unsigned* MISC = (volatile LAS unsigned*)(F.lds + MISC_OFF);
    F.tid = threadIdx.x; F.lane = F.tid & 63; F.wave = __builtin_amdgcn_readfirstlane(F.tid >> 6);
    F.G = gridDim.x; { const int bx = blockIdx.x; F.vcu = (F.G % 8 == 0) ? (bx % 8) * (F.G / 8) + bx / 8 : bx; }
    F.in = args.in; F.out = args.out; F.ws = args.ws; unsigned char* ws = args.ws;
    for (int u = F.tid; u < (LDS_BYTES - LDSCTL_OFF) / 4; u += 512) ((LAS unsigned*)(F.lds + LDSCTL_OFF))[u] = 0u;
    __syncthreads();
    gu32* ctl = (gu32*)(ws + WS_CTL);
    XcdBarrier bar; bar.bar = (unsigned*)(ctl + CW_BAR); bar.x = 0; bar.st = nullptr;
    if (MK_N_LAUNCHES == 1) bar = xcd_barrier_post((unsigned*)(ctl + CW_BAR), MISC + 8);

    const int lo = args.ph_lo, hi = args.ph_hi;
    int rep = 0;
    for (int ph = lo; ph < hi; ++ph) {
        {
        int cv_l0 = 0, cv_r0 = 0, cv_n0 = 0, cv_nt = 0, cv_gw = 0, cv_ngw = 1;
        if (ph == 0) { p0_prologue(F);
            if (F.G == 256 && F.vcu >= 64) { cv_n0 = CV_P0; cv_nt = CV_P0; cv_gw = (F.vcu - 64) * 8 + F.wave; cv_ngw = 192 * 8; } }
        else {
            const int l = (ph - 1) / 13, sp = (ph - 1) % 13;
            const float* modl = F_MOD + (size_t)l * 5 * 9 * D;
            const bool first = (l == 0 && sp <= 2);
            const float* xl = first ? F.in[I_X] : F.out;
            const int Mrows = (l + 1 == DEPTH && sp >= 9) ? ML : M;
            float* slabD = (float*)(F.ws + WS_QUP); float* slabO = (float*)(F.ws + WS_QUP + 34 * MiB);
            switch (sp) {
            case 0: case 3: case 10: {
                int npend = 0; const float* pg = F_MOD; float pc = 0.f; const float* sl = slabD;
                if (sp == 0 && l > 0) { npend = 11; pg = modp(F_MOD, l - 1, 4, 8); pc = 0.5f; }
                if (sp == 3) { npend = 11; pg = modp(F_MOD, l, 4, 2); pc = 0.5f; }
                if (sp == 10 && Mrows == M) { npend = 4; pg = modp(F_MOD, l, 4, 5); pc = 1.0f; sl = slabO; }
                ph_modulate(F, xl, l, sp == 0 ? 0 : (sp == 3 ? 1 : 2), Mrows, rep ? 0 : npend, sl, pg, pc);
                if (l == 0 && sp == 0) {
                    static_assert(DEPTH == 2, "conversion lists");
                    const bool hosted = (F.G == 256); cv_r0 = hosted ? CV_P0 : 0; cv_n0 = hosted ? CV_NA - CV_P0 : CV_NA + CV_NB; cv_nt = hosted ? CV_NA - CV_P0 : 2 * (CV_NA + CV_NB); cv_gw = F.vcu * 8 + F.wave; cv_ngw = F.G * 8; } } break;
            case 1: case 11: {
                pg8::Gemm g{F_XN, F.wl(l, sp == 1 ? W_1I : W_2I), Mrows, 2 * DFF, D}; pg8::StaticOrder S; S.init(Mrows, 2 * DFF, F.G, (int)blockIdx.x, D);
                EpiSwiglu E{F_HID};
                #ifdef UP_SP2_OFF
                pg8::gemm_phase<EpiSwiglu, pg8::StaticOrder, true, false>(F.lds + RING_OFF, g, S, E);
#elif defined(UP_ALIGN_OFF)
                pg8::gemm_phase<EpiSwiglu, pg8::StaticOrder, false, true>(F.lds + RING_OFF, g, S, E);
#else
                pg8::gemm_phase<EpiSwiglu, pg8::StaticOrder, true, true>(F.lds + RING_OFF, g, S, E);
#endif
                } break;
            case 2: case 12: case 9: {
                const bool isout = sp == 9; const int K = isout ? D : DFF;
                pg8::Gemm g{isout ? F_Y : F_HID, F.wl(l, isout ? W_OUT : (sp == 2 ? W_1O : W_2O)), Mrows, D, K}; pg8::SplitOrder S; S.init(D, K, F.G, (int)blockIdx.x, Mrows == M ? (isout ? 4 : 11) : 0);
                EpiResid E{xl, F.out, isout ? slabO : slabD, modl, isout ? 5 : (sp == 2 ? 2 : 8), isout ? 1.0f : 0.5f};
#ifdef PROBE_DUP
                if (rep == 0 && sp == PROBE_DUP) E.coef = 0.f;
#endif
                pg8::gemm_phase<EpiResid, pg8::SplitOrder, true, true>(F.lds + RING_OFF, g, S, E); } break;
            case 4: {
                const bool split = (F.G == 256); const int Gg = split ? 184 : F.G;
                if ((int)blockIdx.x >= Gg) { cv_l0 = l; cv_r0 = CV_NA; cv_n0 = CV_NB; cv_nt = CV_NB + (l + 1 < DEPTH ? CV_NA : 0); cv_gw = ((int)blockIdx.x - Gg) * 8 + F.wave; cv_ngw = (F.G - Gg) * 8; break; }
                pg8::Gemm g{F_XN, F.wl(l, W_IN), M, 2048, D}; pg8::StaticOrder S; S.init(M, 2048, Gg, (int)blockIdx.x, D);
                EpiInproj E{F_P16A, F_G32, F_P16B};
                pg8::gemm_phase<EpiInproj, pg8::StaticOrder, true, true>(F.lds + RING_OFF, g, S, E); } break;
            case 5: {
#pragma unroll 1
                for (int s_ = 0; s_ < 2; ++s_) { if (((s_ ^ F.vcu) & 1) == 0) ph_prepA(F, l); else ph_mlstm_m1b(F, l); __syncthreads(); }
                } break;
            case 6: {
                const int Gg = (F.G == 256) ? 204 : F.G;
                if ((int)blockIdx.x >= Gg) { ph_mlstm_m2<3>(F, (int)blockIdx.x - Gg, F.G - Gg); break; }
                pg8::Gemm g{F_CKN, F.wl(l, W_UP), M, 1536, 384}; pg8::UpOrder S; S.init(Gg, (int)blockIdx.x);
                EpiUp E{F_QUP, F_KVUP};
                pg8::gemm_phase<EpiUp, pg8::UpOrder, true, true>(F.lds + RING_OFF, g, S, E); } break;
            case 7: { if (F.G != 256) ph_mlstm_m2<1>(F, F.vcu, F.G); ph_prepB(F, l);
#ifdef PROBE_PREPB2
                __syncthreads(); ph_prepB(F, l);
#endif
                } break;
            case 8: { ph_mixers(F, l, rep); } break;
            default: break;
            }
        }
        if (cv_nt > 0) { __syncthreads(); p0_weights(F, cv_l0, cv_r0, cv_n0, cv_nt, cv_gw, cv_ngw); }
        }
#ifdef PROBE_DUP
        if (rep == 0 && ((ph > 0 && (ph - 1) % 13 == PROBE_DUP) || (ph == 0 && PROBE_DUP == 100))) { rep = 1; --ph; xcd_barrier(bar); continue; }
        rep = 0;
#endif
        if (ph + 1 < hi) xcd_barrier(bar);
    }
}

extern "C" void kernel_launch(void* const* d_in, const int* in_sizes, int n_in, void* d_out, int out_size, void* d_ws, size_t ws_size, hipStream_t stream) {
    static int grid = 0;
    if (grid == 0) {
        if (n_in != 24 || ws_size < WS_END) { fprintf(stderr, "kernel_launch: unexpected n_in %d or ws_size %zu (< %zu)\n", n_in, ws_size, (size_t)WS_END); grid = -1; return; }
        int dev = 0, cus = 0, per_cu = 0;
        if (hipGetDevice(&dev) != hipSuccess || hipDeviceGetAttribute(&cus, hipDeviceAttributeMultiprocessorCount, dev) != hipSuccess) { grid = -1; return; }
        if (hipFuncSetAttribute((const void*)fwd_mk, hipFuncAttributeMaxDynamicSharedMemorySize, LDS_BYTES) != hipSuccess) { fprintf(stderr, "kernel_launch: hipFuncSetAttribute failed\n"); grid = -1; return; }
        if (hipOccupancyMaxActiveBlocksPerMultiprocessor(&per_cu, (const void*)fwd_mk, 512, LDS_BYTES) != hipSuccess || per_cu < 1) fprintf(stderr, "kernel_launch: occupancy query says %d per CU\n", per_cu);
        (void)hipGetLastError();
        grid = cus;
    }
    if (grid < 0) return;
    (void)hipMemsetAsync((char*)d_ws + WS_CTL, 0, CTL_ZERO_BYTES, stream);
    Args a{};
    for (int i = 0; i < 24; ++i) a.in[i] = (const float*)d_in[i];
    a.out = (float*)d_out; a.ws = (unsigned char*)d_ws;
#if MK_N_LAUNCHES == 1
    a.ph_lo = 0; a.ph_hi = NPH;
    hipLaunchKernelGGL(fwd_mk, dim3(grid), dim3(512), LDS_BYTES, stream, a);
#else
    for (int p = 0; p < NPH; ++p) { a.ph_lo = p; a.ph_hi = p + 1; hipLaunchKernelGGL(fwd_mk, dim3(grid), dim3(512), LDS_BYTES, stream, a); }
#endif
}
```

```cpp
#include <hip/hip_runtime.h>
#include <cstdio>
#include <cstdint>
#define MK_N_LAUNCHES 1
namespace pg8 {
#define PG8_LAS __attribute__((address_space(3)))
typedef unsigned short bf16_t;
typedef short bf16x8 __attribute__((ext_vector_type(8)));
typedef float f32x4 __attribute__((ext_vector_type(4)));
typedef unsigned u32x4 __attribute__((ext_vector_type(4)));
constexpr int BM = 256, BK = 64, HALF = 128, HTB = HALF * BK * 2  , STAGE_BYTES = 8 * HTB, NXCD = 8, WGM = 8;

__host__ __device__ __forceinline__ int lds_byte(int r, int c) { const int st = (r >> 4) * 2 + (c >> 5), rr = r & 15, cc = c & 31, ob = rr * 64 + cc * 2; return st * 1024 + (ob ^ (((ob >> 9) & 1) << 5)); }
__host__ __device__ __forceinline__ void stage_rc(int b, int& R, int& C) { const int st = b / 1024, sb = b % 1024, swz = sb ^ (((sb >> 9) & 1) << 5); R = (st >> 1) * 16 + swz / 64; C = (st & 1) * 32 + (swz % 64) / 2; }
__host__ __device__ __forceinline__ int perm32(int rho) { const int n = rho >> 4, i = rho & 15; return 8 * (i >> 2) + 4 * n + (i & 3); }

struct Unit { int pm, pn, kt0, nt, half; };
struct Gemm { const bf16_t* A; const bf16_t* Bt; int M, N, K; };

struct StaticOrder {
    int nM, nN, nwg, G, c, ntK;
    __host__ __device__ void init(int M, int N, int G_, int c_, int K_) { nM = M / BM; nN = N / BM; nwg = nM * nN; G = G_; c = c_; ntK = K_ / BK; }
    __host__ __device__ bool next(int i, Unit& u) const {
        const long L = (long)i * G + c; if (L >= nwg) return false;
        int wgid = (int)L; { const int q = nwg / NXCD, r = nwg % NXCD, xcd = wgid % NXCD, off = wgid / NXCD; wgid = (xcd < r ? xcd * (q + 1) : r * (q + 1) + (xcd - r) * q) + off; }
        const int nig = WGM * nN, gid = wgid / nig, fm = gid * WGM, gsz = (nM - fm) < WGM ? (nM - fm) : WGM;
        u.pm = fm + ((wgid % nig) % gsz); u.pn = (wgid % nig) / gsz; u.kt0 = 0; u.nt = ntK; u.half = 0; return true;
    }
    __device__ __forceinline__ void a_ready(const Unit&) const {}
    __device__ __forceinline__ void done(const Unit&) const {}
};

struct SplitOrder {
    StaticOrder lat; int NS, ntS;
    __host__ __device__ void init(int N, int K, int G_, int c_, int NS_) { lat.init(16384, N, G_, c_, K); NS = NS_; ntS = NS_ ? (K / BK) / NS_ : 0; }
    __host__ __device__ bool next(int i, Unit& u) const {
        if (lat.G == lat.nwg && i < 2 && lat.c < 16 * NS) i = 1 - i;
        const long L = (long)i * lat.G + lat.c; if (L < lat.nwg) return lat.next(i, u);
        const int idx = (int)(L - lat.nwg); if (idx >= 16 * NS) return false;
        const int tile = idx / NS, sl = idx % NS; u.pm = 64 + (tile >> 2); u.pn = tile & 3; u.kt0 = sl * ntS; u.nt = ntS; u.half = 0; return true;
    }
    __device__ __forceinline__ void a_ready(const Unit&) const {}
    __device__ __forceinline__ void done(const Unit&) const {}
};

struct InprojOrder {
    StaticOrder full7; int G, c;
    __host__ __device__ void init(int G_, int c_, int K) { full7.init(17408, 7 * 256, G_, c_, K); G = G_; c = c_; }
    __host__ __device__ bool next(int i, Unit& u) const {
        if (G != 256) { if (i > 0) return false; u.pm = 0; u.pn = 0; u.kt0 = 0; u.nt = full7.ntK; u.half = 0; return c == 0; }
        if (i == 0 || (i == 1 && c < 220)) { const bool ok = full7.next(i, u); if (ok && u.pn >= 3) u.pn += 1; return ok; }
        int hidx;
        if (i == 1) hidx = c - 220;
        else if (i == 2 && c >= 220 && c < 252) hidx = 36 + (c - 220);
        else return false;
        u.pm = hidx; u.pn = 3; u.kt0 = 0; u.nt = full7.ntK; u.half = 1; return true;
    }
    __device__ __forceinline__ void a_ready(const Unit&) const {}
    __device__ __forceinline__ void done(const Unit&) const {}
};

struct UpOrder {
    int G, c;
    __host__ __device__ void init(int G_, int c_) { G = G_; c = c_; }
    __host__ __device__ bool next(int i, Unit& u) const {
        const long L = (long)i * G + c; if (L >= 408) return false;
        const int kv = L >= 204, j = kv ? (int)L - 204 : (int)L;
        u.pm = j / 3; u.pn = (kv ? 3 : 0) + j % 3; u.kt0 = kv ? 4 : 0; u.nt = kv ? 2 : 4; u.half = 0; return true;
    }
    __device__ __forceinline__ void a_ready(const Unit&) const {}
    __device__ __forceinline__ void done(const Unit&) const {}
};

__device__ __forceinline__ unsigned cvt_pk_bf16(float lo, float hi) { unsigned r; asm volatile("v_cvt_pk_bf16_f32 %0, %1, %2" : "=v"(r) : "v"(lo), "v"(hi)); return r; }
template <class Epi, class Sched, bool ALIGN_EPI = false, bool SP2 = false>
__device__ __forceinline__ void gemm_phase(PG8_LAS unsigned char* lds, const Gemm g, const Sched& S, const Epi& E) {
    int tid_ = threadIdx.x; asm volatile("" : "+v"(tid_));
    const int tid = tid_, wid = __builtin_amdgcn_readfirstlane(tid >> 6), lane = tid & 63, wr = wid >> 2, wc = wid & 3, fr = lane & 15, fq = lane >> 4;
    int K_ = g.K; asm volatile("" : "+s"(K_));
    const int K = K_;
    unsigned voffA[2], voffB[2];
#pragma unroll
    for (int i = 0; i < 2; ++i) { int R, C; stage_rc(tid * 16 + i * 8192, R, C); const int Rb = Epi::PERM ? ((R & ~31) + perm32(R & 31)) : R;
        voffA[i] = (unsigned)(R * K + C) * 2u; voffB[i] = (unsigned)(Rb * K + C) * 2u; }
    const size_t kstep = (size_t)(BK * 2);
    const size_t hstep = (size_t)HALF * K * 2;
    const size_t tstep = 2 * hstep;
    const unsigned ldsw = (unsigned)wid * 1024u;
    const int aoff = lds_byte(wr * 64 + fr, fq * 8), boff = lds_byte(wc * 32 + fr, fq * 8);
#define PG8_SA(b, h) (((b) * 2 + (h)) * HTB)
#define PG8_SB(b, h) ((4 + (b) * 2 + (h)) * HTB)
#define PG8_STAGE(bufoff, gbase, voff) do { _Pragma("unroll") for (int _i = 0; _i < 2; ++_i) \
        __builtin_amdgcn_global_load_lds((const unsigned*)((const char*)(gbase) + (voff)[_i]), (PG8_LAS unsigned*)(lds + (bufoff) + ldsw + _i * 8192), 16, 0, 0); } while (0)
#define PG8_LDA(dst, b, h) do { _Pragma("unroll") for (int m = 0; m < 4; ++m) _Pragma("unroll") for (int k = 0; k < 2; ++k) dst[m][k] = *(const PG8_LAS bf16x8*)(lds + PG8_SA(b, h) + aoff + m * 2048 + k * 1024); } while (0)
#define PG8_LDB(dst, b, h) do { _Pragma("unroll") for (int n = 0; n < 2; ++n) _Pragma("unroll") for (int k = 0; k < 2; ++k) dst[n][k] = *(const PG8_LAS bf16x8*)(lds + PG8_SB(b, h) + boff + n * 2048 + k * 1024); } while (0)
#define PG8_MMA(ai, bj, At, Bt) do { __builtin_amdgcn_s_setprio(1); _Pragma("unroll") for (int m = 0; m < 4; ++m) _Pragma("unroll") for (int n = 0; n < 2; ++n) _Pragma("unroll") for (int k = 0; k < 2; ++k) \
        acc[ai][bj][m][n] = __builtin_amdgcn_mfma_f32_16x16x32_bf16(Bt[n][k], At[m][k], acc[ai][bj][m][n], 0, 0, 0); __builtin_amdgcn_s_setprio(0); } while (0)
#define PG8_WAIT_V(n) asm volatile("s_waitcnt vmcnt(" #n ")" ::: "memory")
#define PG8_WAIT_L(n) asm volatile("s_waitcnt lgkmcnt(" #n ")" ::: "memory")
#define PG8_BAR __builtin_amdgcn_s_barrier()
#define PG8_SCHED __builtin_amdgcn_sched_barrier(0)
    Unit cur, nxt; int ui = 0;
    if (!S.next(0, cur)) return;
    f32x4 acc[2][2][4][2];
#pragma unroll
    for (int a = 0; a < 2; ++a)
#pragma unroll
        for (int b = 0; b < 2; ++b)
#pragma unroll
            for (int m = 0; m < 4; ++m)
#pragma unroll
                for (int n = 0; n < 2; ++n) acc[a][b][m][n] = (f32x4){0.f, 0.f, 0.f, 0.f};
    bf16x8 At[4][2], B0[2][2], B1[2][2];
    const char* cA = (const char*)g.A + (size_t)cur.pm * tstep + (size_t)cur.kt0 * kstep; const char* cB = (const char*)g.Bt + (size_t)cur.pn * tstep + (size_t)cur.kt0 * kstep;
    S.a_ready(cur);
    if constexpr (SP2) {
        PG8_STAGE(PG8_SB(0, 0), cB, voffB); PG8_STAGE(PG8_SB(0, 1), cB + hstep, voffB); PG8_STAGE(PG8_SA(0, 0), cA, voffA); PG8_STAGE(PG8_SA(0, 1), cA + hstep, voffA);
        if (wr == 1) PG8_BAR;
        PG8_WAIT_V(2); PG8_BAR;
        PG8_STAGE(PG8_SB(1, 0), cB + kstep, voffB); PG8_STAGE(PG8_SA(1, 0), cA + kstep, voffA); PG8_STAGE(PG8_SB(1, 1), cB + hstep + kstep, voffB);
        PG8_WAIT_V(6); PG8_BAR;
    } else {
        PG8_STAGE(PG8_SB(0, 0), cB, voffB); PG8_STAGE(PG8_SA(0, 0), cA, voffA); PG8_STAGE(PG8_SB(0, 1), cB + hstep, voffB); PG8_STAGE(PG8_SA(0, 1), cA + hstep, voffA);
        if (wr == 1) PG8_BAR;
        PG8_WAIT_V(4); PG8_BAR;
        PG8_STAGE(PG8_SB(1, 0), cB + kstep, voffB); PG8_STAGE(PG8_SA(1, 0), cA + kstep, voffA); PG8_STAGE(PG8_SB(1, 1), cB + hstep + kstep, voffB);
        PG8_WAIT_V(6); PG8_BAR;
    }
    for (;;) {
        const bool has_next = S.next(ui + 1, nxt);
        const char* nA = has_next ? (const char*)g.A + (size_t)nxt.pm * tstep + (size_t)nxt.kt0 * kstep : cA; const char* nB = has_next ? (const char*)g.Bt + (size_t)nxt.pn * tstep + (size_t)nxt.kt0 * kstep : cB;
        const int ntc = cur.nt; const bool full = !cur.half;
        for (int t = 0; t < ntc; t += 2) {
            const bool last = (t == ntc - 2);
            const char* a1 = cA + (size_t)(t + 1) * kstep;
            const char* a2 = last ? nA : cA + (size_t)(t + 2) * kstep; const char* b2 = last ? nB : cB + (size_t)(t + 2) * kstep;
            const char* a3 = a2 + kstep; const char* b3 = b2 + kstep;
            if (last && has_next) S.a_ready(nxt);
            if constexpr (SP2) {
            PG8_LDB(B0, 0, 0); PG8_LDB(B1, 0, 1); PG8_SCHED; PG8_LDA(At, 0, 0); PG8_STAGE(PG8_SA(1, 1), a1 + hstep, voffA);
            PG8_WAIT_V(8); PG8_WAIT_L(0); PG8_BAR; PG8_MMA(0, 0, At, B0); if (full) PG8_MMA(0, 1, At, B1); PG8_BAR; PG8_SCHED;
            PG8_LDA(At, 0, 1); PG8_STAGE(PG8_SB(0, 0), b2, voffB); PG8_STAGE(PG8_SB(0, 1), b2 + hstep, voffB); PG8_STAGE(PG8_SA(0, 0), a2, voffA);
            PG8_WAIT_V(8); PG8_WAIT_L(0); PG8_BAR; PG8_MMA(1, 0, At, B0); if (full) PG8_MMA(1, 1, At, B1); PG8_BAR; PG8_SCHED;
            PG8_LDB(B0, 1, 0); PG8_LDB(B1, 1, 1); PG8_SCHED; PG8_LDA(At, 1, 0); PG8_STAGE(PG8_SA(0, 1), a2 + hstep, voffA);
            PG8_WAIT_V(8); PG8_WAIT_L(0); PG8_BAR; PG8_MMA(0, 0, At, B0); if (full) PG8_MMA(0, 1, At, B1); PG8_BAR; PG8_SCHED;
            PG8_LDA(At, 1, 1); PG8_STAGE(PG8_SB(1, 0), b3, voffB); PG8_STAGE(PG8_SB(1, 1), b3 + hstep, voffB); PG8_STAGE(PG8_SA(1, 0), a3, voffA);
            PG8_WAIT_V(8); PG8_WAIT_L(0); PG8_BAR; PG8_MMA(1, 0, At, B0); if (full) PG8_MMA(1, 1, At, B1); PG8_BAR; PG8_SCHED;
            } else {
            PG8_LDB(B0, 0, 0); PG8_SCHED; PG8_LDA(At, 0, 0); PG8_STAGE(PG8_SA(1, 1), a1 + hstep, voffA);
            PG8_WAIT_L(8); PG8_BAR; PG8_WAIT_L(0); PG8_MMA(0, 0, At, B0); PG8_BAR; PG8_SCHED;
            PG8_LDB(B1, 0, 1); PG8_STAGE(PG8_SB(0, 0), b2, voffB);
            PG8_BAR; PG8_WAIT_L(0); PG8_MMA(0, 1, At, B1); PG8_BAR;
            PG8_LDA(At, 0, 1); PG8_STAGE(PG8_SA(0, 0), a2, voffA);
            PG8_BAR; PG8_WAIT_L(0); PG8_MMA(1, 0, At, B0); PG8_BAR; PG8_SCHED;
            PG8_STAGE(PG8_SB(0, 1), b2 + hstep, voffB);
            PG8_WAIT_V(6); PG8_BAR; PG8_MMA(1, 1, At, B1); PG8_BAR;
            PG8_LDB(B0, 1, 0); PG8_SCHED; PG8_LDA(At, 1, 0); PG8_STAGE(PG8_SA(0, 1), a2 + hstep, voffA);
            PG8_WAIT_L(8); PG8_BAR; PG8_WAIT_L(0); PG8_MMA(0, 0, At, B0); PG8_BAR; PG8_SCHED;
            PG8_LDB(B1, 1, 1); PG8_STAGE(PG8_SB(1, 0), b3, voffB);
            PG8_BAR; PG8_WAIT_L(0); PG8_MMA(0, 1, At, B1); PG8_BAR;
            PG8_LDA(At, 1, 1); PG8_STAGE(PG8_SA(1, 0), a3, voffA);
            PG8_BAR; PG8_WAIT_L(0); PG8_MMA(1, 0, At, B0); PG8_BAR; PG8_SCHED;
            PG8_STAGE(PG8_SB(1, 1), b3 + hstep, voffB);
            PG8_WAIT_V(6); PG8_BAR; PG8_MMA(1, 1, At, B1); PG8_BAR;
            }
        }
        if constexpr (ALIGN_EPI) { if (wr == 0) PG8_BAR; }
        if constexpr (!Epi::AFTER_DRAIN) { E(acc, cur, wr, wc, fr, fq); S.done(cur); }
        if (!has_next) break;
#pragma unroll
        for (int a = 0; a < 2; ++a)
#pragma unroll
            for (int b = 0; b < 2; ++b)
#pragma unroll
                for (int m = 0; m < 4; ++m)
#pragma unroll
                    for (int n = 0; n < 2; ++n) acc[a][b][m][n] = (f32x4){0.f, 0.f, 0.f, 0.f};
        cur = nxt; cA = nA; cB = nB; ++ui;
        if constexpr (ALIGN_EPI) { if (wr == 1) PG8_BAR; }
    }
    PG8_WAIT_V(0);
    if constexpr (!ALIGN_EPI) { if (wr == 0) PG8_BAR; }
    PG8_BAR;
    if constexpr (Epi::AFTER_DRAIN) { E.fused(acc, cur, wr, wc, fr, fq, lds, wid, lane); S.done(cur); }
#undef PG8_SA
#undef PG8_SB
#undef PG8_STAGE
#undef PG8_LDA
#undef PG8_LDB
#undef PG8_MMA
#undef PG8_WAIT_V
#undef PG8_WAIT_L
#undef PG8_BAR
#undef PG8_SCHED
}
}

#ifndef MK_N_LAUNCHES
#define MK_N_LAUNCHES 1
#endif
namespace cf {
constexpr int D = 1024, NB = 4, T = 4096, TC = 256, ML = NB * T, MC = NB * TC, M = ML + MC, TS = T + TC;
constexpr int DFF = 2816, DIN = 1840, DEPTH = 2;
constexpr float EPS = 1e-6f;
constexpr int NPH = 1 + 13 * DEPTH;
}
using namespace cf;
typedef unsigned short bf16_t;
typedef float f32x4 __attribute__((ext_vector_type(4)));
typedef unsigned u32x4 __attribute__((ext_vector_type(4)));
#define GAS __attribute__((address_space(1)))
#define LAS __attribute__((address_space(3)))
typedef GAS unsigned gu32;
#define RLX_AGENT __ATOMIC_RELAXED, __HIP_MEMORY_SCOPE_AGENT
#define LDS_WAIT() asm volatile("s_waitcnt lgkmcnt(0)" ::: "memory")
#define VM_WAIT() asm volatile("s_waitcnt vmcnt(0)" ::: "memory")

constexpr size_t MiB = 1u << 20;
constexpr size_t WS_CTL = 0, CTL_ZERO_BYTES = 64 * 1024;
constexpr size_t WS_MOD = 1 * MiB;
constexpr size_t WS_XBC = 5 * MiB;
constexpr size_t WS_W = 9 * MiB;
constexpr size_t W_1I = 0, W_1O = W_1I + (size_t)5632 * 1024, W_2I = W_1O + (size_t)1024 * 2816, W_2O = W_2I + (size_t)5632 * 1024, W_IN = W_2O + (size_t)1024 * 2816,
                 W_OUT = W_IN + (size_t)2048 * 1024, W_UP = W_OUT + (size_t)1024 * 1024, WL_STRIDE = W_UP + (size_t)1536 * 384;
static_assert(WS_W + 2 * WL_STRIDE * 2 <= 90 * MiB, "weights");
constexpr size_t WS_XN = 90 * MiB;
constexpr size_t WS_HID = 124 * MiB;
constexpr size_t WS_P16A = 124 * MiB;
constexpr size_t WS_G32 = WS_P16A + (size_t)M * 768 * 2;
constexpr size_t WS_P16B = 154 * MiB;
constexpr size_t WS_MLA = 154 * MiB;
constexpr size_t WS_LOC = 205 * MiB;
constexpr size_t WS_QUP = 223 * MiB;
constexpr size_t WS_END = 274 * MiB;
static_assert(WS_G32 + (size_t)M * 64 * 4 <= WS_P16B && WS_MLA + ((size_t)NB * 6 * TS * (96 + 96 + 64)) * 2 <= WS_LOC && WS_LOC + (size_t)32 * 68 * 2112 * 4 <= WS_QUP && WS_QUP + (size_t)M * 768 * 4 <= WS_END, "ws map");
static_assert(WS_HID + (size_t)M * DFF * 2 <= WS_QUP, "ws map 2");
constexpr int CW_BAR = 1024;

constexpr int RING_OFF = 0, RING_BYTES = 131072, LDSCTL_OFF = RING_BYTES, MISC_OFF = LDSCTL_OFF + 320, LDS_BYTES = 147456;

__device__ __forceinline__ float bf2f(bf16_t v) { return __uint_as_float(((unsigned)v) << 16); }
__device__ __forceinline__ bf16_t f2bf(float f) { unsigned u = __float_as_uint(f); u += 0x7fffu + ((u >> 16) & 1u); return (bf16_t)(u >> 16); }
__device__ __forceinline__ unsigned pk2(float lo, float hi) { typedef float f2_t_ __attribute__((ext_vector_type(2))); typedef __bf16 b2_t_ __attribute__((ext_vector_type(2))); f2_t_ v = {lo, hi}; b2_t_ b = __builtin_convertvector(v, b2_t_); return __builtin_bit_cast(unsigned, b); }
__device__ __forceinline__ float siluf(float x) { return x / (1.f + expf(-x)); }
__device__ __forceinline__ float silu_fast(float x) { return x * __builtin_amdgcn_rcpf(1.f + __expf(-x)); }
__device__ __forceinline__ float sigmoidf_(float x) { return 1.f / (1.f + expf(-x)); }
__device__ __forceinline__ float logsigmoidf_(float x) { return x >= 0.f ? -log1pf(expf(-x)) : x - log1pf(expf(x)); }
struct RowInfo { int b, t, isctx, s, sp; };
__device__ __forceinline__ RowInfo rowinfo(int m) {
    RowInfo r;
    if (m < ML) { r.b = m / T; r.t = m % T; r.isctx = 0; r.s = r.b; r.sp = TC + r.t; }
    else { int q = m - ML; r.b = q / TC; r.t = q % TC; r.isctx = 1; r.s = 4; r.sp = r.t; }
    return r;
}
template <int CTRL> __device__ __forceinline__ float dpp_f(float v) { return __int_as_float(__builtin_amdgcn_update_dpp(0, __float_as_int(v), CTRL, 0xF, 0xF, true)); }
__device__ __forceinline__ float sum16(float v) { v += dpp_f<0x128>(v); v += dpp_f<0x124>(v); v += dpp_f<0x122>(v); v += dpp_f<0x121>(v); return v; }
__device__ __forceinline__ float xor16_sum(float v) { auto r = __builtin_amdgcn_permlane16_swap(__float_as_uint(v), __float_as_uint(v), false, false); return __uint_as_float(r[0]) + __uint_as_float(r[1]); }
__device__ __forceinline__ float xor32_sum(float v) { auto r = __builtin_amdgcn_permlane32_swap(__float_as_uint(v), __float_as_uint(v), false, false); return __uint_as_float(r[0]) + __uint_as_float(r[1]); }
__device__ __forceinline__ float sum32(float v) { return xor16_sum(sum16(v)); }
__device__ __forceinline__ float wave_sum(float v) { return xor32_sum(xor16_sum(sum16(v))); }
template <int CTRL, int RMASK> __device__ __forceinline__ float dpp_id(float v, float ident) { return __int_as_float(__builtin_amdgcn_update_dpp(__float_as_int(ident), __float_as_int(v), CTRL, RMASK, 0xF, false)); }
__device__ __forceinline__ float scan_sum64(float v) {
    v += dpp_id<0x111, 0xF>(v, 0.f); v += dpp_id<0x112, 0xF>(v, 0.f); v += dpp_id<0x114, 0xF>(v, 0.f); v += dpp_id<0x118, 0xF>(v, 0.f);
    v += dpp_id<0x142, 0xA>(v, 0.f); v += dpp_id<0x143, 0xC>(v, 0.f); return v; }
__device__ __forceinline__ float scan_max64(float v) {
    const float NI = -INFINITY;
    v = fmaxf(v, dpp_id<0x111, 0xF>(v, NI)); v = fmaxf(v, dpp_id<0x112, 0xF>(v, NI)); v = fmaxf(v, dpp_id<0x114, 0xF>(v, NI)); v = fmaxf(v, dpp_id<0x118, 0xF>(v, NI));
    v = fmaxf(v, dpp_id<0x142, 0xA>(v, NI)); v = fmaxf(v, dpp_id<0x143, 0xC>(v, NI)); return v; }
__device__ __forceinline__ float lane_bcast(float v, int lane_const) { return __int_as_float(__builtin_amdgcn_readlane(__float_as_int(v), lane_const)); }
__device__ __forceinline__ float xchg4(float v, int l16) { const float up = dpp_f<0x104>(v)  , dn = dpp_f<0x114>(v)  ; return (l16 & 4) ? dn : up; }
__device__ __forceinline__ float xchg2(float v) { return dpp_f<0x4E>(v); }
__device__ __forceinline__ void sincos_b(float a, float& s, float& c) {
    const float inv2pi = 0.15915494309189535f;
    float k = rintf(a * inv2pi);
    float r = fmaf(-k, 6.28125f, a);
    r = fmaf(-k, 1.9353071795864769e-3f, r);
    float rev = r * inv2pi;
    s = __builtin_amdgcn_sinf(rev); c = __builtin_amdgcn_cosf(rev);
}
__device__ __forceinline__ const float* modp(const float* MOD, int l, int s, int n) { return MOD + ((size_t)(l * 5 + s) * 9 + n) * D; }
#define XB_TMO      128
#define XB_XCNT(j)  (256  + 64 * (j))
#define XB_XSUB(j)  (1280 + 64 * (j))
#define XB_XGEN(j)  (2304 + 64 * (j))
#define XB_TOP      3328
#define XB_TOPGEN   3392
#define XCD_BAR_WORDS 3456
#define XB_SPIN_CAP (1u << 18)

__device__ __forceinline__ unsigned xb_ld(unsigned* p)              { return __hip_atomic_load(p, __ATOMIC_RELAXED, __HIP_MEMORY_SCOPE_AGENT); }
__device__ __forceinline__ unsigned xb_add(unsigned* p, unsigned v) { return __hip_atomic_fetch_add(p, v, __ATOMIC_RELAXED, __HIP_MEMORY_SCOPE_AGENT); }
__device__ __forceinline__ unsigned xb_xcc_id() { return (unsigned)__builtin_amdgcn_s_getreg((3 << 11) | 20) & 0xFu; }
#define XB_SPIN(cond, bar) do { unsigned _sp = 0; while (cond) { __builtin_amdgcn_s_sleep(1); \
    if ((++_sp & 255u) == 0u) { if (xb_ld(&(bar)[XB_TMO])) break; if (_sp > XB_SPIN_CAP) { atomicAdd(&(bar)[XB_TMO], 1u); break; } } } } while (0)

struct XcdBarrier {
    unsigned* bar; unsigned x;
    volatile LAS unsigned* st;
};

__device__ __forceinline__ XcdBarrier xcd_barrier_post(unsigned* bar, volatile LAS unsigned* st) {
    XcdBarrier b; b.bar = bar; b.x = xb_xcc_id(); b.st = st;
    if (threadIdx.x == 0) (void)xb_add(&bar[XB_XCNT(b.x)], 1u);
    return b;
}
__device__ __forceinline__ void xcd_barrier_complete(unsigned* bar, unsigned x, unsigned& nloc, unsigned& nx) {
    const unsigned G = gridDim.x * gridDim.y * gridDim.z;
    unsigned sum, cnt, mine, sp = 0u;
    for (;;) {
        sum = 0u; cnt = 0u; mine = 0u;
#pragma unroll
        for (unsigned j = 0; j < 16; ++j) { const unsigned c = xb_ld(&bar[XB_XCNT(j)]); sum += c; cnt += (c > 0u) ? 1u : 0u; mine = (j == x) ? c : mine; }
        if (sum == G) break;
        __builtin_amdgcn_s_sleep(1);
        if ((++sp & 255u) == 0u) { if (xb_ld(&bar[XB_TMO])) break; if (sp > XB_SPIN_CAP) { atomicAdd(&bar[XB_TMO], 1u); break; } }
    }
    nloc = mine > 0u ? mine : 1u; nx = cnt > 0u ? cnt : 1u;
}

__device__ __forceinline__ void xcd_barrier(const XcdBarrier& b) {
    asm volatile("s_waitcnt vmcnt(0)" ::: "memory");
    __syncthreads();
    if (threadIdx.x == 0) {
        unsigned* bar = b.bar;
        __builtin_amdgcn_s_waitcnt(0);
        unsigned nloc = b.st[0], nx = b.st[1];
        if (nloc == 0u) { xcd_barrier_complete(bar, b.x, nloc, nx); b.st[0] = nloc; b.st[1] = nx; }
        const unsigned old = xb_add(&bar[XB_XSUB(b.x)], 1u);
        const unsigned gen = old / nloc;
        if (old + 1u == (gen + 1u) * nloc) {
            __builtin_amdgcn_fence(__ATOMIC_RELEASE, "agent");
            asm volatile("s_waitcnt vmcnt(0)" ::: "memory");
            const unsigned og = xb_add(&bar[XB_TOP], 1u);
            const unsigned tg = og / nx;
            if (og + 1u == (tg + 1u) * nx) xb_add(&bar[XB_TOPGEN], 1u);
            else XB_SPIN(xb_ld(&bar[XB_TOPGEN]) == tg, bar);
            __builtin_amdgcn_fence(__ATOMIC_ACQUIRE, "agent");
            xb_add(&bar[XB_XGEN(b.x)], 1u);
            asm volatile("s_waitcnt vmcnt(0)" ::: "memory");
        } else {
            XB_SPIN(xb_ld(&bar[XB_XGEN(b.x)]) == gen, bar);
            __builtin_amdgcn_fence(__ATOMIC_ACQUIRE, "agent");
            asm volatile("s_waitcnt vmcnt(0)" ::: "memory");
        }
    }
    __syncthreads();
}

struct Args { const float* in[24]; float* out; unsigned char* ws; int ph_lo, ph_hi; };
struct Frame {
    LAS unsigned char* lds; int tid, lane, wave, vcu, G;
    const float* const* in; float* out; unsigned char* ws;
    __device__ __forceinline__ bf16_t* wl(int l, size_t off) const { return (bf16_t*)(ws + WS_W) + (size_t)l * WL_STRIDE + off; }
};
#define OPAQUE_TID(F) do { int t_ = (F).tid; asm volatile("" : "+v"(t_)); (F).tid = t_; (F).lane = t_ & 63; } while (0)
#define F_MOD   ((float*)(F.ws + WS_MOD))
#define F_XBC   ((float*)(F.ws + WS_XBC))
#define F_XN    ((bf16_t*)(F.ws + WS_XN))
#define F_HID   ((bf16_t*)(F.ws + WS_HID))
#define F_P16A  ((bf16_t*)(F.ws + WS_P16A))
#define F_G32   ((float*)(F.ws + WS_G32))
#define F_P16B  ((bf16_t*)(F.ws + WS_P16B))
#define F_Y     ((bf16_t*)(F.ws + WS_QUP))
#define F_QUP   ((bf16_t*)(F.ws + WS_QUP))
#define F_KVUP  ((bf16_t*)(F.ws + WS_QUP) + (size_t)M * 768)
#define F_QC    ((bf16_t*)(F.ws + WS_XN))
#define F_KC    (F_QC + (size_t)NB * 6 * TS * 64)
#define F_VC    (F_KC + (size_t)NB * 2 * TS * 64)
#define F_CKN   (F_VC + (size_t)NB * 2 * TS * 64)
#define F_QB    ((bf16_t*)(F.ws + WS_MLA))
#define F_KB    (F_QB + (size_t)NB * 6 * TS * 96)
#define F_VB    (F_KB + (size_t)NB * 6 * TS * 96)
enum InIdx { I_X = 0, I_C, I_CTX, I_CCTX, I_ADAW, I_ADAB, I_NORMG, I_F1WI, I_F1WO, I_F2WI, I_F2WO, I_WIN, I_WOUT, I_GATEB, I_OUTNORM, I_CQN, I_CKVN, I_WUQ, I_WUKV, I_MQN, I_MKN, I_GQN, I_GKN, I_SINK };

template <class Map>
__device__ __forceinline__ void transpose_item(const float* W, int ldw, int Nsrc, int k0, int n0, bf16_t* WT, int ldt, int koff, Map map, LAS float* scr, int lane, float sc = 1.f) {
    int nsrc = n0 + (lane & 31); nsrc = nsrc < Nsrc ? nsrc : Nsrc - 1;
    float tv[32];
#pragma unroll
    for (int i = 0; i < 32; ++i) { const int kk = 2 * i + (lane >> 5); tv[i] = W[(size_t)(k0 + kk) * ldw + nsrc]; }
#pragma unroll
    for (int i = 0; i < 32; ++i) { const int kk = 2 * i + (lane >> 5); scr[kk * 33 + (lane & 31)] = tv[i]; }
    LDS_WAIT(); asm volatile("" ::: "memory");
    const int c = lane & 7;
#pragma unroll
    for (int j = 0; j < 4; ++j) { const int nn = (lane >> 3) + 8 * j; const LAS float* s = scr + (8 * c) * 33 + nn;
        u32x4 o; o.x = pk2(s[0 * 33] * sc, s[1 * 33] * sc); o.y = pk2(s[2 * 33] * sc, s[3 * 33] * sc); o.z = pk2(s[4 * 33] * sc, s[5 * 33] * sc); o.w = pk2(s[6 * 33] * sc, s[7 * 33] * sc);
        if (n0 + nn < Nsrc) *(u32x4*)(WT + (size_t)map(n0 + nn) * ldt + koff + k0 + 8 * c) = o; }
    LDS_WAIT(); asm volatile("" ::: "memory");
}
constexpr float SW_GSC = 1.4426950408889634f, SW_USC = 0.6931471805599453f;
static_assert(DFF % 32 == 0, "a conversion item never straddles the gate/up boundary");
struct MapId { __device__ __forceinline__ int operator()(int n) const { return n; } };
struct MapWi { __device__ __forceinline__ int operator()(int n) const { return n < DFF ? 256 * (n >> 7) + (n & 127) : 256 * ((n - DFF) >> 7) + 128 + ((n - DFF) & 127); } };
__host__ __device__ __forceinline__ int pcol(int n) {
    if (n < 784) return n;
    if (n < 1040) return 1024 + (n - 784);
    if (n < 1168) return 1280 + (n - 1040);
    if (n < 1200) return 784 + (n - 1168);
    if (n < 1584) return 1408 + (n - 1200);
    if (n < 1712) return 1792 + (n - 1584);
    return 1920 + (n - 1712);
}
struct MapWin { __device__ __forceinline__ int operator()(int n) const { return pcol(n); } };
struct MapUq { __device__ __forceinline__ int operator()(int n) const { return 128 * (n / 96) + (n % 96); } };
struct MapUkv { __device__ __forceinline__ int operator()(int n) const { return 768 + n; } };

__device__ __forceinline__ void p0_prologue(Frame& F) {
    OPAQUE_TID(F);
    {
        LAS float* sc = (LAS float*)(F.lds);
        LAS float* red = (LAS float*)(F.lds + 20480);
        for (int i = F.tid; i < 5 * 1024; i += 512) { int s = i >> 10, k = i & 1023; float v = s < 4 ? F.in[I_C][s * D + k] : F.in[I_CCTX][k]; sc[i] = siluf(v); }
        __syncthreads();
        for (int it = F.vcu; it < 576; it += F.G) {
            const int l = it / 288, cb = it % 288; const int kk = F.lane >> 3, c4 = F.lane & 7; const int kb = F.wave * 128;
            const float* w = F.in[I_ADAW] + (size_t)l * D * 9216 + (size_t)(kb + kk) * 9216 + cb * 32 + 4 * c4;
            f32x4 a[5] = {{0.f, 0.f, 0.f, 0.f}, {0.f, 0.f, 0.f, 0.f}, {0.f, 0.f, 0.f, 0.f}, {0.f, 0.f, 0.f, 0.f}, {0.f, 0.f, 0.f, 0.f}};
#pragma unroll 16
            for (int i = 0; i < 16; ++i) { const f32x4 wv = *(const f32x4*)(w + (size_t)(8 * i) * 9216); const int k = kb + kk + 8 * i;
#pragma unroll
                for (int s = 0; s < 5; ++s) a[s] += wv * sc[s * 1024 + k]; }
#pragma unroll
            for (int s = 0; s < 5; ++s) {
#pragma unroll
                for (int c = 0; c < 4; ++c) { float t = a[s][c]; t += dpp_f<0x128>(t); t = xor32_sum(xor16_sum(t)); a[s][c] = t; } }
            if (kk == 0) { LAS float* r = red + F.wave * 160 + 4 * c4;
#pragma unroll
                for (int s = 0; s < 5; ++s) *(LAS f32x4*)(r + 32 * s) = a[s]; }
            __syncthreads();
            if (F.tid < 160) { const int s = F.tid >> 5, col = F.tid & 31; float acc = F.in[I_ADAB][l * 9216 + cb * 32 + col];
#pragma unroll
                for (int wv = 0; wv < 8; ++wv) acc += red[wv * 160 + s * 32 + col];
                F_MOD[(size_t)(l * 5 + s) * 9216 + cb * 32 + col] = acc; }
            __syncthreads();
        }
    }
    { const int gt = F.vcu * 512 + F.tid, NGT = F.G * 512; for (int i = gt; i < MC * D / 4; i += NGT) ((f32x4*)F_XBC)[i] = ((const f32x4*)F.in[I_CTX])[i]; }
    {
        const int gt = F.vcu * 512 + F.tid, NGT = F.G * 512; const u32x4 z = {0u, 0u, 0u, 0u};
        for (int i = gt; i < 2 * (768 * 16 + 768 * 32); i += NGT) {
            const int l = i / (768 * 48); int r = i % (768 * 48);
            bf16_t* wu = F.wl(l, W_UP);
            if (r < 768 * 16) { const int row = r >> 4, ch = r & 15; *(u32x4*)(wu + (size_t)row * 384 + 256 + 8 * ch) = z; }
            else { r -= 768 * 16; const int row = 768 + (r >> 5), ch = r & 31; *(u32x4*)(wu + (size_t)row * 384 + 8 * ch) = z; }
        }
    }
}

constexpr int CV_WI = 16 * 176, CV_WO = 44 * 32, CV_IN = 16 * 58, CV_OUT = 16 * 32, CV_UQ = 4 * 18, CV_UKV = 2 * 24;
constexpr int CV_NA = CV_WI + CV_WO + CV_IN + CV_UQ + CV_UKV, CV_NB = CV_WI + CV_WO + CV_OUT, CV_P0 = CV_NA;
static_assert(CV_P0 <= CV_NA, "phase-0 share");
__device__ __forceinline__ void p0_weights(Frame& F, int l0, int r0, int n0, int ntot, int gw, int NGW) {
    OPAQUE_TID(F);
    LAS float* scr = (LAS float*)(F.lds + F.wave * 16384);
    for (int t = gw; t < ntot; t += NGW) {
        const int l = t < n0 ? l0 : l0 + 1; int r = t < n0 ? r0 + t : t - n0;
        if (r < CV_WI) { transpose_item(F.in[I_F1WI] + (size_t)l * D * 2 * DFF, 2 * DFF, 2 * DFF, 64 * (r / 176), 32 * (r % 176), F.wl(l, W_1I), 1024, 0, MapWi(), scr, F.lane, (r % 176) < 88 ? SW_GSC : SW_USC); continue; } r -= CV_WI;
        if (r < CV_WO) { transpose_item(F.in[I_F1WO] + (size_t)l * DFF * D, D, D, 64 * (r / 32), 32 * (r % 32), F.wl(l, W_1O), DFF, 0, MapId(), scr, F.lane); continue; } r -= CV_WO;
        if (r < CV_IN) { transpose_item(F.in[I_WIN] + (size_t)l * D * DIN, DIN, DIN, 64 * (r / 58), 32 * (r % 58), F.wl(l, W_IN), 1024, 0, MapWin(), scr, F.lane); continue; } r -= CV_IN;
        if (r < CV_UQ) { transpose_item(F.in[I_WUQ] + (size_t)l * 256 * 576, 576, 576, 64 * (r / 18), 32 * (r % 18), F.wl(l, W_UP), 384, 0, MapUq(), scr, F.lane); continue; } r -= CV_UQ;
        if (r < CV_UKV) { transpose_item(F.in[I_WUKV] + (size_t)l * 128 * 768, 768, 768, 64 * (r / 24), 32 * (r % 24), F.wl(l, W_UP), 384, 256, MapUkv(), scr, F.lane); continue; } r -= CV_UKV;
        if (r < CV_WI) { transpose_item(F.in[I_F2WI] + (size_t)l * D * 2 * DFF, 2 * DFF, 2 * DFF, 64 * (r / 176), 32 * (r % 176), F.wl(l, W_2I), 1024, 0, MapWi(), scr, F.lane, (r % 176) < 88 ? SW_GSC : SW_USC); continue; } r -= CV_WI;
        if (r < CV_WO) { transpose_item(F.in[I_F2WO] + (size_t)l * DFF * D, D, D, 64 * (r / 32), 32 * (r % 32), F.wl(l, W_2O), DFF, 0, MapId(), scr, F.lane); continue; } r -= CV_WO;
        transpose_item(F.in[I_WOUT] + (size_t)l * D * D, D, D, 64 * (r / 32), 32 * (r % 32), F.wl(l, W_OUT), 1024, 0, MapId(), scr, F.lane);
    }
}
__device__ __forceinline__ void ph_modulate(Frame& F, const float* xl, int l, int which, int Mrows, int npend, const float* slab, const float* pgate, float pcoef) {
    OPAQUE_TID(F);
    const int gw = F.vcu * 8 + F.wave, NGW = F.G * 8, lane = F.lane;
    const f32x4* g4 = (const f32x4*)(F.in[I_NORMG] + (l * 3 + which) * D);
    {
        f32x4 cur[4];
        if (gw < ML) {
#pragma unroll
            for (int j = 0; j < 4; ++j) cur[j] = ((const f32x4*)(xl + (size_t)gw * D))[lane + 64 * j];
        }
        for (int m = gw; m < ML; m += NGW) {
            const int mn = (m + NGW < ML) ? m + NGW : m; f32x4 nxt[4];
#pragma unroll
            for (int j = 0; j < 4; ++j) nxt[j] = ((const f32x4*)(xl + (size_t)mn * D))[lane + 64 * j];
            const int s = m / T;
            const f32x4* sh4 = (const f32x4*)modp(F_MOD, l, s, 3 * which); const f32x4* sc4 = (const f32x4*)modp(F_MOD, l, s, 3 * which + 1);
            f32x4 gs[4], sh[4];
#pragma unroll
            for (int j = 0; j < 4; ++j) { const f32x4 g = g4[lane + 64 * j], sc = sc4[lane + 64 * j]; sh[j] = sh4[lane + 64 * j]; gs[j] = g * (sc + 1.f); }
            float ss = 0.f;
#pragma unroll
            for (int j = 0; j < 4; ++j) ss += cur[j].x * cur[j].x + cur[j].y * cur[j].y + cur[j].z * cur[j].z + cur[j].w * cur[j].w;
            ss = wave_sum(ss);
            const float rstd = rsqrtf(ss * (1.f / D) + EPS);
            uint2* o = (uint2*)(F_XN + (size_t)m * D);
#pragma unroll
            for (int j = 0; j < 4; ++j) { const f32x4 y = cur[j] * rstd * gs[j] + sh[j]; uint2 r; r.x = pk2(y.x, y.y); r.y = pk2(y.z, y.w); o[lane + 64 * j] = r; }
#pragma unroll
            for (int j = 0; j < 4; ++j) cur[j] = nxt[j];
        }
    }
    if (Mrows > ML) {
        LAS float* xs = (LAS float*)(F.lds);
        for (int r0 = F.vcu * 4; r0 < MC; r0 += F.G * 4) {
            const int row = r0 + (F.wave >> 1), hf = F.wave & 1;
            f32x4* xr = (f32x4*)(F_XBC + (size_t)row * D) + hf * 128;
            f32x4 v[2];
#pragma unroll
            for (int j = 0; j < 2; ++j) v[j] = xr[lane + 64 * j];
            if (npend > 0) {
                f32x4 t[11][2];
#pragma unroll
                for (int s = 0; s < 11; ++s) { const int sc_ = s < npend ? s : npend - 1; const f32x4* sr = (const f32x4*)(slab + ((size_t)sc_ * MC + row) * D) + hf * 128;
#pragma unroll
                    for (int j = 0; j < 2; ++j) t[s][j] = sr[lane + 64 * j]; }
                f32x4 a[2] = {{0.f, 0.f, 0.f, 0.f}, {0.f, 0.f, 0.f, 0.f}};
#pragma unroll
                for (int s = 0; s < 11; ++s) { const float w = s < npend ? 1.f : 0.f;
#pragma unroll
                    for (int j = 0; j < 2; ++j) a[j] += t[s][j] * w; }
#pragma unroll
                for (int j = 0; j < 2; ++j) { v[j] += ((const f32x4*)pgate)[hf * 128 + lane + 64 * j] * pcoef * a[j]; xr[lane + 64 * j] = v[j]; }
            }
            float ss = 0.f;
#pragma unroll
            for (int j = 0; j < 2; ++j) ss += v[j].x * v[j].x + v[j].y * v[j].y + v[j].z * v[j].z + v[j].w * v[j].w;
            ss = wave_sum(ss);
            __syncthreads();
            if (lane == 0) xs[F.wave] = ss;
            __syncthreads();
            ss = xs[F.wave] + xs[F.wave ^ 1];
            const float rstd = rsqrtf(ss * (1.f / D) + EPS);
            const f32x4* sh4 = (const f32x4*)modp(F_MOD, l, 4, 3 * which) + hf * 128; const f32x4* sc4 = (const f32x4*)modp(F_MOD, l, 4, 3 * which + 1) + hf * 128;
            uint2* o = (uint2*)(F_XN + (size_t)(ML + row) * D) + hf * 128;
#pragma unroll
            for (int j = 0; j < 2; ++j) {
                f32x4 g = g4[hf * 128 + lane + 64 * j], sh = sh4[lane + 64 * j], sc = sc4[lane + 64 * j];
                uint2 r; r.x = pk2(v[j].x * rstd * g.x * (1.f + sc.x) + sh.x, v[j].y * rstd * g.y * (1.f + sc.y) + sh.y);
                r.y = pk2(v[j].z * rstd * g.z * (1.f + sc.z) + sh.z, v[j].w * rstd * g.w * (1.f + sc.w) + sh.w);
                o[lane + 64 * j] = r;
            }
        }
    }
}
__device__ __forceinline__ f32x4 ld_bf4(const bf16_t* p) { uint2 w = *(const uint2*)p; f32x4 r; r.x = __uint_as_float(w.x << 16); r.y = __uint_as_float(w.x & 0xffff0000u); r.z = __uint_as_float(w.y << 16); r.w = __uint_as_float(w.y & 0xffff0000u); return r; }
__device__ __forceinline__ f32x4 cvt_bf4(uint2 w) { f32x4 r; r.x = __uint_as_float(w.x << 16); r.y = __uint_as_float(w.x & 0xffff0000u); r.z = __uint_as_float(w.y << 16); r.w = __uint_as_float(w.y & 0xffff0000u); return r; }
__device__ __forceinline__ void st_bf4(bf16_t* p, float a, float b, float c, float d) { uint2 r; r.x = pk2(a, b); r.y = pk2(c, d); *(uint2*)p = r; }

__device__ __forceinline__ void rope64(float (&v)[4], int l16, int prow, int pcolp) {
    int d0 = 4 * l16; int pos = d0 < 32 ? prow : pcolp; int dd0 = d0 & 31; bool first = dd0 < 16;
#pragma unroll
    for (int i = 0; i < 4; ++i) {
        float other = xchg4(v[i], l16);
        int fi = (dd0 & 15) + i;
        float inv = exp2f(-(float)fi * (13.287712379549449f / 16.f));
        float s, c; sincos_b((float)pos * inv, s, c);
        v[i] = first ? (v[i] * c - other * s) : (other * s + v[i] * c);
    }
}
__device__ __forceinline__ void rope32(float (&v)[4], int l8, int prow, int pcolp) {
    int rd0 = 4 * l8; int pos = rd0 < 16 ? prow : pcolp; int r16 = rd0 & 15; bool first = r16 < 8;
#pragma unroll
    for (int i = 0; i < 4; ++i) {
        float other = xchg2(v[i]);
        int fi = (r16 & 7) + i;
        float inv = exp2f(-(float)fi * (13.287712379549449f / 8.f));
        float s, c; sincos_b((float)pos * inv, s, c);
        v[i] = first ? (v[i] * c - other * s) : (other * s + v[i] * c);
    }
}
__device__ __forceinline__ void ph_prepA(Frame& F, int l) {
    OPAQUE_TID(F);
    const int gw = F.vcu * 8 + F.wave, NGW = F.G * 8, lane = F.lane, l16 = lane & 15;
    const float* cq_norm = F.in[I_CQN] + l * 256; const float* ckv_norm = F.in[I_CKVN] + l * 128; const float* gq_norm = F.in[I_GQN] + l * 64; const float* gk_norm = F.in[I_GKN] + l * 64;
    uint2 nraw[4];
    { const bf16_t* pr = F_P16B + (size_t)(gw < M ? gw : 0) * 1024 + 4 * lane;
#pragma unroll
      for (int j = 0; j < 4; ++j) nraw[j] = *(const uint2*)(pr + 256 * j); }
    for (int m = gw; m < M; m += NGW) {
        RowInfo ri = rowinfo(m); const bool lat = !ri.isctx; const int prow = ri.t >> 6, pcl = ri.t & 63;
        const f32x4 v0 = cvt_bf4(nraw[0]), v1 = cvt_bf4(nraw[1]), v2 = cvt_bf4(nraw[2]), v3 = cvt_bf4(nraw[3]);
        { const int mn = m + NGW < M ? m + NGW : m; const bf16_t* pr = F_P16B + (size_t)mn * 1024 + 4 * lane;
#pragma unroll
          for (int j = 0; j < 4; ++j) nraw[j] = *(const uint2*)(pr + 256 * j); }
        { float ss = wave_sum(v0.x * v0.x + v0.y * v0.y + v0.z * v0.z + v0.w * v0.w); float rstd = rsqrtf(ss * (1.f / 256.f) + EPS);
          f32x4 g = ((const f32x4*)cq_norm)[lane]; st_bf4(F_CKN + (size_t)m * 384 + 4 * lane, v0.x * rstd * g.x, v0.y * rstd * g.y, v0.z * rstd * g.z, v0.w * rstd * g.w); }
        { float p = lane < 32 ? (v1.x * v1.x + v1.y * v1.y + v1.z * v1.z + v1.w * v1.w) : 0.f; float ss = wave_sum(p); float rstd = rsqrtf(ss * (1.f / 128.f) + EPS);
          if (lane < 32) { f32x4 g = ((const f32x4*)ckv_norm)[lane]; st_bf4(F_CKN + (size_t)m * 384 + 256 + 4 * lane, v1.x * rstd * g.x, v1.y * rstd * g.y, v1.z * rstd * g.z, v1.w * rstd * g.w); } }
#pragma unroll
        for (int part = 0; part < 2; ++part) {
            f32x4 x = part ? v2 : v1; const bool ok = part ? true : lane >= 32; const int hq = part ? 2 + (lane >> 4) : ((lane >> 4) & 1);
            float ss = x.x * x.x + x.y * x.y + x.z * x.z + x.w * x.w;
            ss = sum16(ss);
            float rstd = rsqrtf(ss * (1.f / 64.f) + EPS); f32x4 g = ((const f32x4*)gq_norm)[l16];
            float v[4] = {x.x * rstd * g.x, x.y * rstd * g.y, x.z * rstd * g.z, x.w * rstd * g.w};
            float vr[4] = {v[0], v[1], v[2], v[3]}; rope64(vr, l16, prow, pcl);
            if (lat) { v[0] = vr[0]; v[1] = vr[1]; v[2] = vr[2]; v[3] = vr[3]; }
            constexpr float QSC = 0.125f * 1.4426950408889634f;
            if (ok) st_bf4(F_QC + (((size_t)ri.b * 6 + hq) * TS + ri.sp) * 64 + 4 * l16, v[0] * QSC, v[1] * QSC, v[2] * QSC, v[3] * QSC);
        }
        { const int kvh = (lane & 31) >> 4; const bool isk = lane < 32; f32x4 x = v3;
          float ss = x.x * x.x + x.y * x.y + x.z * x.z + x.w * x.w;
          ss = sum16(ss);
          float rstd = rsqrtf(ss * (1.f / 64.f) + EPS); f32x4 g = ((const f32x4*)gk_norm)[l16];
          float v[4] = {x.x * rstd * g.x, x.y * rstd * g.y, x.z * rstd * g.z, x.w * rstd * g.w};
          float vr[4] = {v[0], v[1], v[2], v[3]}; rope64(vr, l16, prow, pcl);
          if (lat) { v[0] = vr[0]; v[1] = vr[1]; v[2] = vr[2]; v[3] = vr[3]; }
          const size_t off = (((size_t)ri.b * 2 + kvh) * TS + ri.sp) * 64 + 4 * l16;
          if (isk) st_bf4(F_KC + off, v[0], v[1], v[2], v[3]); else st_bf4(F_VC + off, x.x, x.y, x.z, x.w); }
    }
}
__device__ __forceinline__ void ph_prepB(Frame& F, int l) {
    OPAQUE_TID(F);
    const int gw = ((F.vcu + F.G / 2) % F.G) * 8 + F.wave, NGW = F.G * 8, lane = F.lane, l32 = lane & 31, d0 = 4 * l32;
    const float* q_norm = F.in[I_MQN] + l * 96; const float* k_norm = F.in[I_MKN] + l * 96;
    f32x4 nkr; uint2 nq[3], nkv[3];
    { const int m0 = gw < M ? gw : 0; nkr = *(const f32x4*)(F_G32 + (size_t)m0 * 64 + 16 + 4 * (lane & 7));
#pragma unroll
      for (int j = 0; j < 3; ++j) { nq[j] = *(const uint2*)(F_QUP + (size_t)m0 * 768 + 256 * j + 4 * lane); nkv[j] = *(const uint2*)(F_KVUP + (size_t)m0 * 768 + 256 * j + 4 * lane); } }
    for (int m = gw; m < M; m += NGW) {
        RowInfo ri = rowinfo(m); const bool lat = !ri.isctx; const int prow = ri.t >> 6, pcl = ri.t & 63;
        f32x4 kr = nkr; if (lane >= 8) kr = (f32x4){0.f, 0.f, 0.f, 0.f};
        uint2 qraw[3], kvraw[3];
#pragma unroll
        for (int j = 0; j < 3; ++j) { qraw[j] = nq[j]; kvraw[j] = nkv[j]; }
        { const int mn = m + NGW < M ? m + NGW : m; nkr = *(const f32x4*)(F_G32 + (size_t)mn * 64 + 16 + 4 * (lane & 7));
#pragma unroll
          for (int j = 0; j < 3; ++j) { nq[j] = *(const uint2*)(F_QUP + (size_t)mn * 768 + 256 * j + 4 * lane); nkv[j] = *(const uint2*)(F_KVUP + (size_t)mn * 768 + 256 * j + 4 * lane); } }
        float krr[4];
        { f32x4 gk = ((const f32x4*)k_norm)[16 + (lane & 7)]; float kv_[4] = {kr.x * gk.x, kr.y * gk.y, kr.z * gk.z, kr.w * gk.w}; float kvr_[4] = {kv_[0], kv_[1], kv_[2], kv_[3]};
          rope32(kvr_, lane & 7, prow, pcl);
#pragma unroll
          for (int i = 0; i < 4; ++i) krr[i] = lat ? kvr_[i] : kv_[i]; }
        float sskr = kr.x * kr.x + kr.y * kr.y + kr.z * kr.z + kr.w * kr.w; sskr = __int_as_float(__builtin_amdgcn_readfirstlane(__float_as_int(sum16(sskr))));
#pragma unroll
        for (int j = 0; j < 3; ++j) {
            const int h = 2 * j + (lane >> 5);
            { f32x4 xq = cvt_bf4(qraw[j]);
              float x[4] = {xq.x, xq.y, xq.z, xq.w}; if (d0 >= 96) { x[0] = x[1] = x[2] = x[3] = 0.f; }
              float ss = x[0] * x[0] + x[1] * x[1] + x[2] * x[2] + x[3] * x[3];
              ss = sum32(ss);
              float rstd = rsqrtf(ss * (1.f / 96.f) + EPS);
              f32x4 g = {0.f, 0.f, 0.f, 0.f}; if (d0 < 96) g = ((const f32x4*)q_norm)[l32];
              float v[4] = {x[0] * rstd * g.x, x[1] * rstd * g.y, x[2] * rstd * g.z, x[3] * rstd * g.w};
              float vr[4] = {v[0], v[1], v[2], v[3]};
              rope32(vr, (l32 - 16) & 7, prow, pcl);
              if (lat && l32 >= 16 && l32 < 24) { v[0] = vr[0]; v[1] = vr[1]; v[2] = vr[2]; v[3] = vr[3]; }
              constexpr float QSB = 0.10206207261596575f * 1.4426950408889634f;
              if (d0 < 96) st_bf4(F_QB + (((size_t)ri.b * 6 + h) * TS + ri.sp) * 96 + d0, v[0] * QSB, v[1] * QSB, v[2] * QSB, v[3] * QSB); }
            { f32x4 xk = cvt_bf4(kvraw[j]);
              float x[4] = {xk.x, xk.y, xk.z, xk.w};
              float ss = d0 < 64 ? (x[0] * x[0] + x[1] * x[1] + x[2] * x[2] + x[3] * x[3]) : 0.f;
              ss = sum32(ss);
              float rstd = rsqrtf((ss + sskr) * (1.f / 96.f) + EPS);
              const size_t kbase = (((size_t)ri.b * 6 + h) * TS + ri.sp) * 96;
              if (d0 < 64) { f32x4 g = ((const f32x4*)k_norm)[l32]; st_bf4(F_KB + kbase + d0, x[0] * rstd * g.x, x[1] * rstd * g.y, x[2] * rstd * g.z, x[3] * rstd * g.w); }
              else { *(uint2*)(F_VB + (((size_t)ri.b * 6 + h) * TS + ri.sp) * 64 + (d0 - 64)) = kvraw[j]; }
#pragma unroll
              for (int hh = 0; hh < 2; ++hh) {
                  const float rs = __int_as_float(hh ? __builtin_amdgcn_readlane(__float_as_int(rstd), 32) : __builtin_amdgcn_readlane(__float_as_int(rstd), 0));
                  if (lane < 8) st_bf4(F_KB + (((size_t)ri.b * 6 + 2 * j + hh) * TS + ri.sp) * 96 + 64 + 4 * lane, krr[0] * rs, krr[1] * rs, krr[2] * rs, krr[3] * rs);
              } }
        }
    }
}
using pg8::Unit;
__device__ __forceinline__ float swg(float g, float u) { return (g * u) * __builtin_amdgcn_rcpf(1.f + __builtin_amdgcn_exp2f(-g)); }
struct EpiSwiglu { static constexpr bool PERM = true, AFTER_DRAIN = false; bf16_t* hid;
    __device__ __forceinline__ void operator()(const pg8::f32x4 (&acc)[2][2][4][2], const Unit& u, int wr, int wc, int fr_, int fq_) const {
        int fr = fr_, fq = fq_; asm volatile("" : "+v"(fr), "+v"(fq));
#ifdef PROBE_EPI2
        for (int rep_ = 0; rep_ < 2; ++rep_) { asm volatile("" ::: "memory");
#endif
        const int row0 = u.pm * 256 + wr * 64 + fr, hc = u.pn * 128 + wc * 32 + 8 * fq;
#pragma unroll
        for (int ai = 0; ai < 2; ++ai)
#pragma unroll
            for (int m = 0; m < 4; ++m) { const pg8::f32x4 g0 = acc[ai][0][m][0], g1 = acc[ai][0][m][1], u0 = acc[ai][1][m][0], u1 = acc[ai][1][m][1];
                u32x4 w; w.x = pg8::cvt_pk_bf16(swg(g0[0], u0[0]), swg(g0[1], u0[1])); w.y = pg8::cvt_pk_bf16(swg(g0[2], u0[2]), swg(g0[3], u0[3]));
                w.z = pg8::cvt_pk_bf16(swg(g1[0], u1[0]), swg(g1[1], u1[1])); w.w = pg8::cvt_pk_bf16(swg(g1[2], u1[2]), swg(g1[3], u1[3]));
                *(u32x4*)(hid + (size_t)(row0 + ai * 128 + m * 16) * DFF + hc) = w; }
#ifdef PROBE_EPI2
        }
#endif
    }
};
struct EpiResid { static constexpr bool PERM = false, AFTER_DRAIN = false; const float* baseL; float* outL; float* slab; const float* modl  ; int gate; float coef;
    __device__ __forceinline__ void operator()(const pg8::f32x4 (&acc)[2][2][4][2], const Unit& u, int wr, int wc, int fr_, int fq_) const {
        int fr = fr_, fq = fq_; asm volatile("" : "+v"(fr), "+v"(fq));
        const int col0 = u.pn * 256 + wc * 32 + 4 * fq;
        if (u.pm >= ML / 256) {
            float* sp = slab + ((size_t)(u.kt0 / u.nt) * MC + (u.pm * 256 - ML) + wr * 64 + fr) * D + col0;
#pragma unroll
            for (int ai = 0; ai < 2; ++ai)
#pragma unroll
                for (int m = 0; m < 4; ++m)
#pragma unroll
                    for (int bj = 0; bj < 2; ++bj)
#pragma unroll
                        for (int n = 0; n < 2; ++n) *(pg8::f32x4*)(sp + (size_t)(ai * 128 + m * 16) * D + bj * 128 + n * 16) = acc[ai][bj][m][n];
            return;
        }
        const int s = u.pm / (T / 256); const int rb = u.pm * 256 + wr * 64 + fr;
        const float* gp = modl + ((size_t)s * 9 + gate) * D;
        pg8::f32x4 gv[2][2];
#pragma unroll
        for (int bj = 0; bj < 2; ++bj)
#pragma unroll
            for (int n = 0; n < 2; ++n) gv[bj][n] = *(const pg8::f32x4*)(gp + col0 + bj * 128 + n * 16) * coef;
#ifdef PROBE_EPIR2
#pragma unroll 1
        for (int rep_ = 0; rep_ < 2; ++rep_) { asm volatile("" ::: "memory"); const float cz = rep_ ? 1.f : 0.f; const float* baseL = rep_ ? this->outL : this->baseL;
#pragma unroll
        for (int ai = 0; ai < 2; ++ai)
#pragma unroll
            for (int m = 0; m < 4; ++m) { const size_t off = (size_t)(rb + ai * 128 + m * 16) * D + col0;
#pragma unroll
                for (int bj = 0; bj < 2; ++bj)
#pragma unroll
                    for (int n = 0; n < 2; ++n) { const pg8::f32x4 bs = *(const pg8::f32x4*)(baseL + off + bj * 128 + n * 16); *(pg8::f32x4*)(outL + off + bj * 128 + n * 16) = bs + gv[bj][n] * cz * acc[ai][bj][m][n]; }
                if (m & 1) asm volatile("" ::: "memory"); }
        }
        return;
#endif
#pragma unroll
        for (int ai = 0; ai < 2; ++ai)
#pragma unroll
            for (int m = 0; m < 4; ++m) { const size_t off = (size_t)(rb + ai * 128 + m * 16) * D + col0;
#pragma unroll
                for (int bj = 0; bj < 2; ++bj)
#pragma unroll
                    for (int n = 0; n < 2; ++n) {
#if defined(RESID_NT)
                        const pg8::f32x4 bs = __builtin_nontemporal_load((const pg8::f32x4*)(baseL + off + bj * 128 + n * 16)); __builtin_nontemporal_store(bs + gv[bj][n] * acc[ai][bj][m][n], (pg8::f32x4*)(outL + off + bj * 128 + n * 16));
#elif defined(RESID_NTL)
                        const pg8::f32x4 bs = __builtin_nontemporal_load((const pg8::f32x4*)(baseL + off + bj * 128 + n * 16)); *(pg8::f32x4*)(outL + off + bj * 128 + n * 16) = bs + gv[bj][n] * acc[ai][bj][m][n];
#else
                        const pg8::f32x4 bs = *(const pg8::f32x4*)(baseL + off + bj * 128 + n * 16); *(pg8::f32x4*)(outL + off + bj * 128 + n * 16) = bs + gv[bj][n] * acc[ai][bj][m][n];
#endif
                    }
                if (m & 1) asm volatile("" ::: "memory"); }
    }
};
__device__ __forceinline__ u32x4 pack8(const pg8::f32x4& a, const pg8::f32x4& b) { u32x4 w; w.x = pg8::cvt_pk_bf16(a[0], a[1]); w.y = pg8::cvt_pk_bf16(a[2], a[3]); w.z = pg8::cvt_pk_bf16(b[0], b[1]); w.w = pg8::cvt_pk_bf16(b[2], b[3]); return w; }
struct EpiInproj { static constexpr bool PERM = true, AFTER_DRAIN = false; bf16_t* pa; float* g32; bf16_t* pb;
    __device__ __forceinline__ void operator()(const pg8::f32x4 (&acc)[2][2][4][2], const Unit& u, int wr, int wc, int fr_, int fq_) const {
        int fr = fr_, fq = fq_; asm volatile("" : "+v"(fr), "+v"(fq));
        const int row0 = u.pm * 256 + wr * 64 + fr, c0 = wc * 32 + 8 * fq;
        if (u.pn == 3) {
            if (wc < 2) {
#pragma unroll
                for (int ai = 0; ai < 2; ++ai)
#pragma unroll
                    for (int m = 0; m < 4; ++m) { float* p = g32 + (size_t)(row0 + ai * 128 + m * 16) * 64 + c0; *(pg8::f32x4*)p = acc[ai][0][m][0]; *(pg8::f32x4*)(p + 4) = acc[ai][0][m][1]; }
            }
            return;
        }
        bf16_t* dst = u.pn < 3 ? pa + (size_t)row0 * 768 + u.pn * 256 + c0 : pb + (size_t)row0 * 1024 + (u.pn - 4) * 256 + c0; const size_t ld = u.pn < 3 ? 768 : 1024;
#pragma unroll
        for (int ai = 0; ai < 2; ++ai)
#pragma unroll
            for (int m = 0; m < 4; ++m)
#pragma unroll
                for (int bj = 0; bj < 2; ++bj) *(u32x4*)(dst + (size_t)(ai * 128 + m * 16) * ld + bj * 128) = pack8(acc[ai][bj][m][0], acc[ai][bj][m][1]);
    }
};
struct EpiUp { static constexpr bool PERM = true, AFTER_DRAIN = false; bf16_t* qup; bf16_t* kvup;
    __device__ __forceinline__ void operator()(const pg8::f32x4 (&acc)[2][2][4][2], const Unit& u, int wr, int wc, int fr_, int fq_) const {
        int fr = fr_, fq = fq_; asm volatile("" : "+v"(fr), "+v"(fq));
        const int row0 = u.pm * 256 + wr * 64 + fr, c0 = wc * 32 + 8 * fq;
        bf16_t* dst = (u.pn < 3 ? qup + u.pn * 256 : kvup + (u.pn - 3) * 256) + (size_t)row0 * 768 + c0;
#pragma unroll
        for (int ai = 0; ai < 2; ++ai)
#pragma unroll
            for (int m = 0; m < 4; ++m)
#pragma unroll
                for (int bj = 0; bj < 2; ++bj) *(u32x4*)(dst + (size_t)(ai * 128 + m * 16) * 768 + bj * 128) = pack8(acc[ai][bj][m][0], acc[ai][bj][m][1]);
    }
};

constexpr int LOCW = 2112, NCS = 68;
#define F_LOC ((float*)(F.ws + WS_LOC))
__device__ __forceinline__ int mls_cs(int isctx, int j, int dir) { return isctx ? (dir ? 3 - j : j) : 4 + (dir ? 63 - j : j); }
template <int NE>
__device__ __forceinline__ void ph_mlstm_m2(Frame& F, int widx, int nw) {
    OPAQUE_TID(F);
    constexpr int TPS = (2080 + NE - 1) / NE;
    const int g = widx * 512 + F.tid; if (g >= 32 * TPS) return;
    const int seq = g / TPS, r = g % TPS;
    float* base = F_LOC + (size_t)seq * NCS * LOCW + r;
    bool ok[NE]; float val[NE]; float m = 0.f;
#pragma unroll
    for (int j = 0; j < NE; ++j) { ok[j] = r + j * TPS < 2080; val[j] = 0.f; }
#pragma unroll 1
    for (int c0 = 0; c0 < NCS; c0 += 17) {
        float bl[17], ml[17], x[NE][17];
#pragma unroll
        for (int i = 0; i < 17; ++i) { const float* p = base + (size_t)(c0 + i) * LOCW; bl[i] = p[2080 - r]; ml[i] = p[2081 - r];
#pragma unroll
            for (int j = 0; j < NE; ++j) x[j][i] = p[ok[j] ? j * TPS : 0]; }
#pragma unroll
        for (int i = 0; i < 17; ++i) { float* p = base + (size_t)(c0 + i) * LOCW;
#pragma unroll
            for (int j = 0; j < NE; ++j) if (ok[j]) p[j * TPS] = val[j];
            if (r == 0) p[2082] = m;
            const float mn = fmaxf(bl[i] + m, ml[i]); const float a = __expf(bl[i] + m - mn), b = __expf(ml[i] - mn);
#pragma unroll
            for (int j = 0; j < NE; ++j) val[j] = a * val[j] + b * x[j][i];
            m = mn; }
    }
}

typedef short bf16x8 __attribute__((ext_vector_type(8)));
typedef short v4i16_t __attribute__((ext_vector_type(4)));
typedef float f32x16 __attribute__((ext_vector_type(16)));
#define MFMA32(a, b, c) __builtin_amdgcn_mfma_f32_32x32x16_bf16((a), (b), (c), 0, 0, 0)
__device__ __forceinline__ int crow(int r, int h) { return (r & 3) + 8 * (r >> 2) + 4 * h; }
__device__ __forceinline__ unsigned cvtpk(float lo, float hi) { typedef float f2_t __attribute__((ext_vector_type(2))); typedef __bf16 b2_t __attribute__((ext_vector_type(2))); f2_t v = {lo, hi}; b2_t b = __builtin_convertvector(v, b2_t); return __builtin_bit_cast(unsigned, b); }
__device__ __forceinline__ v4i16_t vtr(const LAS unsigned char* p) { return __builtin_amdgcn_ds_read_tr16_b64_v4i16((LAS v4i16_t*)p); }
__device__ __forceinline__ float max3f(float a, float b, float c) { float r; asm("v_max3_f32 %0, %1, %2, %3" : "=v"(r) : "v"(a), "v"(b), "v"(c)); return r; }
#ifdef PROBE_MLA2X
constexpr int MLA_NP = 2 * (TS / 128), MLA_WRAP = TS / 128;
#else
constexpr int MLA_NP = TS / 128, MLA_WRAP = 1 << 20;
#endif
constexpr float ATT_THR = 6.0f;

template <int DQK, bool BAND, bool SINK>
__device__ __forceinline__ void attn_unit256(Frame& F, const bf16_t* Qrows, const bf16_t* Kseq, const bf16_t* Vseq, int npairs, int qpos0, float sink2, bf16_t* Yout) {
    constexpr int NCH = DQK / 8, KSTR = DQK * 2 + 16, KST = 128 * KSTR, STAGE = KST + 16384, NKI = (128 * NCH) / 512, NKS = DQK / 16;
    static_assert((128 * NCH) % 512 == 0 && 2 * STAGE <= RING_BYTES, "attention staging / LDS");
    int tid_ = F.tid; asm volatile("" : "+v"(tid_));
    const int tid = tid_, lane = tid_ & 63, wave = F.wave, r32 = lane & 31, h = lane >> 5;
    LAS unsigned char* L = F.lds;
    bf16x8 qf[NKS];
#pragma unroll
    for (int ks = 0; ks < NKS; ++ks) qf[ks] = *(const bf16x8*)(Qrows + (size_t)(32 * wave + r32) * DQK + 16 * ks + 8 * h);
    const f32x16 z16 = {0.f, 0.f, 0.f, 0.f, 0.f, 0.f, 0.f, 0.f, 0.f, 0.f, 0.f, 0.f, 0.f, 0.f, 0.f, 0.f};
    f32x16 o0 = z16, o1 = z16;
    float l_run = (SINK && h == 0) ? __builtin_amdgcn_exp2f(sink2) : 0.f;
    u32x4 kreg[NKI], vreg[2];
#define ATT_SEQ0(p) ((BAND && (p) >= 2) ? (TC + qpos0 - 128 + 128 * ((p) - 2)) : 128 * ((p) % MLA_WRAP))
#define ATT_LOAD(p) do { const int seq0_ = ATT_SEQ0(p); \
        _Pragma("unroll") for (int i_ = 0; i_ < NKI; ++i_) { const int cid = tid + 512 * i_; const int key = cid / NCH, ch = cid % NCH; int sr = seq0_ + key; sr = sr < 0 ? 0 : (sr > TS - 1 ? TS - 1 : sr); \
            kreg[i_] = *(const u32x4*)(Kseq + (size_t)sr * DQK + ch * 8); } \
        _Pragma("unroll") for (int i_ = 0; i_ < 2; ++i_) { const int cid = tid + 512 * i_; const int key = cid >> 3, ch = cid & 7; int sr = seq0_ + key; sr = sr < 0 ? 0 : (sr > TS - 1 ? TS - 1 : sr); \
            vreg[i_] = *(const u32x4*)(Vseq + (size_t)sr * 64 + ch * 8); } } while (0)
#define ATT_STORE(st) do { LAS unsigned char* sb_ = L + (st) * STAGE; \
        _Pragma("unroll") for (int i_ = 0; i_ < NKI; ++i_) { const int cid = tid + 512 * i_; const int key = cid / NCH, ch = cid % NCH; *(LAS u32x4*)(sb_ + key * KSTR + ch * 16) = kreg[i_]; } \
        _Pragma("unroll") for (int i_ = 0; i_ < 2; ++i_) { const int cid = tid + 512 * i_; const int key = cid >> 3, ch = cid & 7; \
            *(LAS u32x4*)(sb_ + KST + (key >> 6) * 8192 + (ch >> 2) * 4096 + (key & 63) * 64 + (ch & 3) * 16) = vreg[i_]; } } while (0)
    ATT_LOAD(0); ATT_STORE(0); if (npairs > 1) ATT_LOAD(1);
    __syncthreads();
    const int trcol = ((lane >> 4) & 1) * 32 + (lane & 3) * 8, q4 = (lane & 15) >> 2;
    const int qpos = qpos0 + 32 * wave + r32;
    if (wave >= 4) __builtin_amdgcn_s_setprio(1);
#pragma unroll 1
    for (int p = 0; p < npairs; ++p) {
        const int st = p & 1;
        bool need = true;
        if (BAND && p >= 2) { const int k0 = qpos0 - 128 + 128 * (p - 2); const int r0 = qpos0 + 32 * wave; need = (k0 <= r0 + 31 + 128) && (k0 + 127 >= r0 - 128) && (k0 + 127 >= 0) && (k0 < T); }
        if (need) {
#ifdef ATT_ROT
            const int boff = (wave >> 2) * 2;
#else
            const int boff = 0;
#endif
            const LAS unsigned char* Kt = L + st * STAGE + r32 * KSTR + 16 * h;
            const LAS unsigned char* Vb = L + st * STAGE + KST + (4 * h + q4) * 64 + trcol;
            f32x16 sa, sb;
            bf16x8 kf[NKS];
#pragma unroll
            for (int ks = 0; ks < NKS; ++ks) kf[ks] = *(const LAS bf16x8*)(Kt + (32 * boff) * KSTR + 32 * ks);
            __builtin_amdgcn_sched_barrier(0);
            sa = MFMA32(kf[0], qf[0], z16);
#pragma unroll
            for (int ks = 1; ks < NKS; ++ks) sa = MFMA32(kf[ks], qf[ks], sa);
            float rs = 0.f;
#pragma unroll
            for (int blk = 0; blk < 4; ++blk) {
                const int bb = (blk + boff) & 3, bn = (blk + 1 + boff) & 3;
                const LAS unsigned char* vp = Vb + (bb >> 1) * 8192 + (32 * (bb & 1)) * 64;
                v4i16_t vl[2][2], vh[2][2];
#pragma unroll
                for (int s = 0; s < 2; ++s) { vl[0][s] = vtr(vp + (16 * s) * 64); vh[0][s] = vtr(vp + (16 * s + 8) * 64); vl[1][s] = vtr(vp + 4096 + (16 * s) * 64); vh[1][s] = vtr(vp + 4096 + (16 * s + 8) * 64); }
                if (blk < 3) {
#pragma unroll
                    for (int ks = 0; ks < NKS; ++ks) kf[ks] = *(const LAS bf16x8*)(Kt + (32 * bn) * KSTR + 32 * ks);
                }
#ifdef PROBE_LDS2
                { bf16x8 dk[NKS];
#pragma unroll
                  for (int ks = 0; ks < NKS; ++ks) { dk[ks] = *(const LAS bf16x8*)(Kt + (32 * bb) * KSTR + 32 * ks); asm volatile("" :: "v"(dk[ks])); } }
#endif
                __builtin_amdgcn_sched_barrier(0);
                if (BAND && p >= 2) {
                    const int kb0 = qpos0 - 128 + 128 * (p - 2) + 32 * bb;
#pragma unroll
                    for (int i = 0; i < 16; ++i) { const int kp = kb0 + crow(i, h); const int d0 = qpos - kp; if (!(kp >= 0 && kp < T && d0 <= 128 && d0 >= -128)) sa[i] = -INFINITY; }
                }
#pragma unroll
                for (int ks = 0; ks < NKS; ++ks) {
                    if (blk < 3) sb = MFMA32(kf[ks], qf[ks], ks == 0 ? z16 : sb);
#ifndef ATT_NOPIN
                    __builtin_amdgcn_sched_barrier(0);
#endif
#pragma unroll
                    for (int i = (16 * ks) / NKS; i < (16 * (ks + 1)) / NKS; ++i) { sa[i] = __builtin_amdgcn_exp2f(sa[i]); rs += sa[i]; }
#ifndef ATT_NOPIN
                    __builtin_amdgcn_sched_barrier(0);
#else
                    __builtin_amdgcn_sched_group_barrier(0x8, 1, 0); __builtin_amdgcn_sched_group_barrier(0x2, 6, 0);
#endif
                }
                bf16x8 pf[2];
#pragma unroll
                for (int s = 0; s < 2; ++s) { u32x4 a = {cvtpk(sa[8 * s], sa[8 * s + 1]), cvtpk(sa[8 * s + 2], sa[8 * s + 3]), cvtpk(sa[8 * s + 4], sa[8 * s + 5]), cvtpk(sa[8 * s + 6], sa[8 * s + 7])}; pf[s] = __builtin_bit_cast(bf16x8, a); }
                __builtin_amdgcn_sched_barrier(0);
#pragma unroll
                for (int s = 0; s < 2; ++s) {
                    const v4i16_t lo0 = vl[0][s], hi0 = vh[0][s], lo1 = vl[1][s], hi1 = vh[1][s];
                    const bf16x8 va0 = {lo0[0], lo0[1], lo0[2], lo0[3], hi0[0], hi0[1], hi0[2], hi0[3]}; const bf16x8 va1 = {lo1[0], lo1[1], lo1[2], lo1[3], hi1[0], hi1[1], hi1[2], hi1[3]};
                    o0 = MFMA32(va0, pf[s], o0); o1 = MFMA32(va1, pf[s], o1);
                }
                if (blk < 3) sa = sb;
            }
            l_run += rs;
        }
        if (p + 1 < npairs) ATT_STORE(st ^ 1);
        if (p + 2 < npairs) ATT_LOAD(p + 2);
        __syncthreads();
    }
#undef ATT_SEQ0
#undef ATT_LOAD
#undef ATT_STORE
    if (wave >= 4) __builtin_amdgcn_s_setprio(0);
    {
        const float inv = 1.f / xor32_sum(l_run);
        LAS unsigned char* osc = L + wave * (32 * 144) + r32 * 144;
#pragma unroll
        for (int i = 0; i < 16; i += 2) { *(LAS unsigned*)(osc + crow(i, h) * 2) = cvtpk(o0[i] * inv, o0[i + 1] * inv); *(LAS unsigned*)(osc + (32 + crow(i, h)) * 2) = cvtpk(o1[i] * inv, o1[i + 1] * inv); }
        LDS_WAIT();
        const LAS unsigned char* osr = L + wave * (32 * 144);
#pragma unroll
        for (int i = 0; i < 4; ++i) { const int row = i * 8 + (lane >> 3), ch = lane & 7; const u32x4 v = *(const LAS u32x4*)(osr + row * 144 + ch * 16);
            *(u32x4*)(Yout + (size_t)(32 * wave + row) * D + ch * 8) = v; }
    }
    __syncthreads();
}

__device__ __forceinline__ void mlstm_m1_mfma(Frame& F, int l, int item) {
    constexpr int KT = 0, VT = 4096, SW = 12288, SST = 12800;
    int tid_ = F.tid; asm volatile("" : "+v"(tid_)); const int tid = tid_, lane = tid & 63, wave = F.wave, hh = lane >> 5;
    LAS unsigned char* L = F.lds;
    int isctx, b, h, j;
    if (item < 1024) { isctx = 0; b = item >> 8; h = (item >> 6) & 3; j = item & 63; } else { const int r = item - 1024; isctx = 1; b = r >> 4; h = (r >> 2) & 3; j = r & 3; }
    const int rbase = (isctx ? ML + b * TC : b * T) + 64 * j;
    const float* gate_b = F.in[I_GATEB] + l * 16;
    if (tid < 256) { const int tok = tid >> 2, ch = tid & 3; *(LAS u32x4*)(L + KT + tok * 64 + ch * 16) = *(const u32x4*)(F_P16A + (size_t)(rbase + tok) * 768 + 128 + h * 32 + ch * 8); }
    { const int tok = tid >> 3, ch = tid & 7; *(LAS u32x4*)(L + VT + (ch >> 2) * 4096 + tok * 64 + (ch & 3) * 16) = *(const u32x4*)(F_P16A + (size_t)(rbase + tok) * 768 + 256 + h * 64 + ch * 8); }
    if (wave < 2) {
        const int dir = wave, p = lane, tok = dir ? 63 - p : p; const int gi = dir ? 2 : 0;
        const float* pr = F_G32 + (size_t)(rbase + tok) * 64; const float ig = pr[gi * 4 + h] + gate_b[gi * 4 + h]; const float lf = logsigmoidf_(pr[(gi + 1) * 4 + h] + gate_b[(gi + 1) * 4 + h]);
        const float v = scan_sum64(lf); const float blast = lane_bcast(v, 63); const float g = blast - v + ig; const float gm = lane_bcast(scan_max64(g), 63);
        ((LAS float*)(L + SW))[dir * 64 + tok] = __expf(g - gm);
        if (p == 0) { ((LAS float*)(L + SST))[2 * dir] = blast; ((LAS float*)(L + SST))[2 * dir + 1] = gm; }
    }
    __syncthreads();
    if (wave < 4) {
        const int dir = wave >> 1, eb = wave & 1;
        const int trcol = ((lane >> 4) & 1) * 32 + (lane & 3) * 8, q4 = (lane & 15) >> 2;
        const LAS float* wp = (const LAS float*)(L + SW) + dir * 64;
        const f32x16 z16 = {0.f, 0.f, 0.f, 0.f, 0.f, 0.f, 0.f, 0.f, 0.f, 0.f, 0.f, 0.f, 0.f, 0.f, 0.f, 0.f};
        f32x16 acc = z16, accn = z16;
        const bf16x8 ones = {0x3f80, 0x3f80, 0x3f80, 0x3f80, 0x3f80, 0x3f80, 0x3f80, 0x3f80};
#pragma unroll
        for (int ks = 0; ks < 4; ++ks) {
            const int s0 = 16 * ks + 8 * hh;
            const v4i16_t klo = vtr(L + KT + (s0 + q4) * 64 + trcol), khi = vtr(L + KT + (s0 + 4 + q4) * 64 + trcol);
            const v4i16_t vlo = vtr(L + VT + eb * 4096 + (s0 + q4) * 64 + trcol), vhi = vtr(L + VT + eb * 4096 + (s0 + 4 + q4) * 64 + trcol);
            const f32x4 w0 = *(const LAS f32x4*)(wp + s0), w1 = *(const LAS f32x4*)(wp + s0 + 4);
            u32x4 aw; aw.x = cvtpk(bf2f((bf16_t)klo[0]) * w0[0], bf2f((bf16_t)klo[1]) * w0[1]); aw.y = cvtpk(bf2f((bf16_t)klo[2]) * w0[2], bf2f((bf16_t)klo[3]) * w0[3]);
            aw.z = cvtpk(bf2f((bf16_t)khi[0]) * w1[0], bf2f((bf16_t)khi[1]) * w1[1]); aw.w = cvtpk(bf2f((bf16_t)khi[2]) * w1[2], bf2f((bf16_t)khi[3]) * w1[3]);
            const bf16x8 af = __builtin_bit_cast(bf16x8, aw); const bf16x8 vf = {vlo[0], vlo[1], vlo[2], vlo[3], vhi[0], vhi[1], vhi[2], vhi[3]};
            acc = MFMA32(af, vf, acc);
            if (eb == 0) accn = MFMA32(af, ones, accn);
        }
        float* Lp = F_LOC + ((size_t)((b * 4 + h) * 2 + dir) * NCS + mls_cs(isctx, j, dir)) * LOCW;
        const int e = 32 * eb + (lane & 31);
#pragma unroll
        for (int i = 0; i < 16; ++i) Lp[crow(i, hh) * 64 + e] = acc[i];
        if (eb == 0) {
            if ((lane & 31) == 0) {
#pragma unroll
                for (int i = 0; i < 16; ++i) Lp[2048 + crow(i, hh)] = accn[i];
            }
            if (lane == 0) { Lp[2080] = ((LAS float*)(L + SST))[2 * dir]; Lp[2081] = ((LAS float*)(L + SST))[2 * dir + 1]; }
        }
    }
    __syncthreads();
}
__device__ __forceinline__ void ph_mlstm_m1b(Frame& F, int l) { for (int it = F.vcu; it < 1024 + 64; it += F.G) mlstm_m1_mfma(F, l, it); }

__device__ __forceinline__ void mlstm_m3_mfma(Frame& F, int l, int item0) {
    constexpr int KT = 0, VT = 5120, CT = 13312, SN = 23552, SU = 23808, SM = 24320, SB = 24832, SMST = 25344, HB = 25600, HALFB = 45056;
    constexpr float QS = 0.17677669529663687f;
    int tid_ = F.tid; asm volatile("" : "+v"(tid_)); const int tid = tid_, lane = tid & 63, wave = F.wave, r32 = lane & 31, hh = lane >> 5;
    const int half = wave >> 2, hw = wave & 3, htid = tid & 255, tb = hw >> 1, eb = hw & 1;
    LAS unsigned char* L = F.lds + half * HALFB;
    const int item = item0 + half;
    int isctx, b, h, j;
    if (item < 1024) { isctx = 0; b = item >> 8; h = (item >> 6) & 3; j = item & 63; } else { const int r = item - 1024; isctx = 1; b = r >> 4; h = (r >> 2) & 3; j = r & 3; }
    const int rbase = (isctx ? ML + b * TC : b * T) + 64 * j;
    const float* gate_b = F.in[I_GATEB] + l * 16;
    const float* stf = F_LOC + ((size_t)((b * 4 + h) * 2) * NCS + mls_cs(isctx, j, 0)) * LOCW; const float* stb = F_LOC + ((size_t)((b * 4 + h) * 2 + 1) * NCS + mls_cs(isctx, j, 1)) * LOCW;
    bf16x8 qf[2][2];
#pragma unroll
    for (int dir = 0; dir < 2; ++dir) { const int tposq = 32 * (dir ? 1 - tb : tb) + r32; const int ttokq = dir ? 63 - tposq : tposq;
#pragma unroll
        for (int ks = 0; ks < 2; ++ks) qf[dir][ks] = *(const bf16x8*)(F_P16A + (size_t)(rbase + ttokq) * 768 + h * 32 + 16 * ks + 8 * hh); }
    { const int tok = htid >> 2, ch = htid & 3; *(LAS u32x4*)(L + KT + tok * 80 + ch * 16) = *(const u32x4*)(F_P16A + (size_t)(rbase + tok) * 768 + 128 + h * 32 + ch * 8); }
#pragma unroll
    for (int i = 0; i < 2; ++i) { const int cid = htid + 256 * i, tok = cid >> 3, ch = cid & 7; *(LAS u32x4*)(L + VT + (ch >> 2) * 4096 + tok * 64 + (ch & 3) * 16) = *(const u32x4*)(F_P16A + (size_t)(rbase + tok) * 768 + 256 + h * 64 + ch * 8); }
#pragma unroll
    for (int dir = 0; dir < 2; ++dir) { const float* st = dir ? stb : stf;
#pragma unroll
        for (int i = 0; i < 2; ++i) { const int idx = htid + 256 * i, d = idx >> 4, e0 = (idx & 15) * 4; const f32x4 c = *(const f32x4*)(st + d * 64 + e0);
            LAS unsigned char* cp = L + CT + dir * 5120 + e0 * 80 + d * 2;
            *(LAS bf16_t*)(cp) = f2bf(c.x); *(LAS bf16_t*)(cp + 80) = f2bf(c.y); *(LAS bf16_t*)(cp + 160) = f2bf(c.z); *(LAS bf16_t*)(cp + 240) = f2bf(c.w); } }
    if (htid < 64) { const int dir = htid >> 5, d = htid & 31; ((LAS float*)(L + SN))[dir * 32 + d] = (dir ? stb : stf)[2048 + d]; }
    if (hw < 2) { const int dir = hw, p = lane, tok = dir ? 63 - p : p; const int gi = dir ? 2 : 0;
        const float* pr = F_G32 + (size_t)(rbase + tok) * 64; const float ig = pr[gi * 4 + h] + gate_b[gi * 4 + h]; const float lf = logsigmoidf_(pr[(gi + 1) * 4 + h] + gate_b[(gi + 1) * 4 + h]);
        const float v = scan_sum64(lf);
        const float u0 = ig - v; const float cm = scan_max64(u0);
        const float m = (dir ? stb : stf)[2082];
        ((LAS float*)(L + SU))[dir * 64 + p] = u0; ((LAS float*)(L + SM))[dir * 64 + p] = fmaxf(m, cm); ((LAS float*)(L + SB))[dir * 64 + p] = v;
        if (p == 0) ((LAS float*)(L + SMST))[dir] = m; }
    const u32x4 og0 = *(const u32x4*)(F_P16A + (size_t)(rbase + (htid >> 2)) * 768 + 512 + h * 64 + (htid & 3) * 16), og1 = *(const u32x4*)(F_P16A + (size_t)(rbase + (htid >> 2)) * 768 + 512 + h * 64 + (htid & 3) * 16 + 8);
    __syncthreads();
    const int trcol = ((lane >> 4) & 1) * 32 + (lane & 3) * 8, q4 = (lane & 15) >> 2;
#pragma unroll
    for (int dir = 0; dir < 2; ++dir) {
        const int tbd = dir ? 1 - tb : tb; const int tpos = 32 * tbd + r32; const int ttok = dir ? 63 - tpos : tpos;
        const float Mt = ((LAS float*)(L + SM))[dir * 64 + tpos], bt = ((LAS float*)(L + SB))[dir * 64 + tpos], mst = ((LAS float*)(L + SMST))[dir];
        float nq = 0.f;
#pragma unroll
        for (int ks = 0; ks < 2; ++ks) { const LAS float* np = (LAS float*)(L + SN) + dir * 32 + 16 * ks + 8 * hh;
#pragma unroll
            for (int jj = 0; jj < 8; ++jj) nq += bf2f((bf16_t)qf[dir][ks][jj]) * np[jj]; }
        nq = xor32_sum(nq);
        const float at = __expf(mst - Mt) * QS;
        f32x16 o;
#pragma unroll
        for (int i = 0; i < 16; ++i) o[i] = 0.f;
#pragma unroll
        for (int ks = 0; ks < 2; ++ks) { const bf16x8 cf = *(const LAS bf16x8*)(L + CT + dir * 5120 + (32 * eb + r32) * 80 + (16 * ks + 8 * hh) * 2); o = MFMA32(cf, qf[dir][ks], o); }
#pragma unroll
        for (int i = 0; i < 16; ++i) o[i] *= at;
        float rs = 0.f;
#pragma unroll
        for (int sb = 0; sb < 2; ++sb) {
            if (sb <= tbd) {
                const int srow = 32 * sb + r32; const int stok = dir ? 63 - srow : srow;
                f32x16 s;
#pragma unroll
                for (int i = 0; i < 16; ++i) s[i] = 0.f;
#pragma unroll
                for (int ks = 0; ks < 2; ++ks) { const bf16x8 kf = *(const LAS bf16x8*)(L + KT + stok * 80 + (16 * ks + 8 * hh) * 2); s = MFMA32(kf, qf[dir][ks], s); }
#pragma unroll
                for (int g = 0; g < 4; ++g) { const f32x4 uv = *(const LAS f32x4*)((LAS float*)(L + SU) + dir * 64 + 32 * sb + 8 * g + 4 * hh);
#pragma unroll
                    for (int c = 0; c < 4; ++c) { const int spos = 32 * sb + 8 * g + 4 * hh + c; const float w = spos <= tpos ? __expf(uv[c] - Mt) * QS : 0.f; const float sw = s[4 * g + c] * w; s[4 * g + c] = sw; rs += sw; } }
#pragma unroll
                for (int s2 = 0; s2 < 2; ++s2) {
                    u32x4 pw = {cvtpk(s[8 * s2], s[8 * s2 + 1]), cvtpk(s[8 * s2 + 2], s[8 * s2 + 3]), cvtpk(s[8 * s2 + 4], s[8 * s2 + 5]), cvtpk(s[8 * s2 + 6], s[8 * s2 + 7])};
                    const bf16x8 pf = __builtin_bit_cast(bf16x8, pw);
                    const int p0 = 32 * sb + 16 * s2 + 4 * hh + q4, p1 = p0 + 8; const int t0 = dir ? 63 - p0 : p0, t1 = dir ? 63 - p1 : p1;
                    const v4i16_t lo = vtr(L + VT + eb * 4096 + t0 * 64 + trcol), hi = vtr(L + VT + eb * 4096 + t1 * 64 + trcol);
                    const bf16x8 va = {lo[0], lo[1], lo[2], lo[3], hi[0], hi[1], hi[2], hi[3]};
                    o = MFMA32(va, pf, o);
                }
            }
        }
        rs = xor32_sum(rs);
        const float den = (at * nq) + rs; const float idn = 1.f / fmaxf(fabsf(den), __expf(-(bt + Mt)));
        LAS float* hp = (LAS float*)(L + HB) + ttok * 65 + 32 * eb;
        if (dir == 0) {
#pragma unroll
            for (int i = 0; i < 16; ++i) hp[crow(i, hh)] = o[i] * idn;
        } else {
#pragma unroll
            for (int i = 0; i < 16; ++i) hp[crow(i, hh)] += o[i] * idn;
        }
    }
    __syncthreads();
    { const int t = htid >> 2, e0 = (htid & 3) * 16; const float* out_norm = F.in[I_OUTNORM] + l * 256 + h * 64 + e0; float hv[16]; float ss = 0.f;
      const LAS float* hb = (LAS float*)(L + HB) + t * 65 + e0;
#pragma unroll
      for (int i = 0; i < 16; ++i) { hv[i] = hb[i]; ss += hv[i] * hv[i]; }
      ss += dpp_f<0xB1>(ss); ss += dpp_f<0x4E>(ss);
      const float rstd = rsqrtf(ss * (1.f / 64.f) + EPS);
      const unsigned ogw[8] = {og0.x, og0.y, og0.z, og0.w, og1.x, og1.y, og1.z, og1.w};
      unsigned ow[8];
#pragma unroll
      for (int i = 0; i < 8; ++i) { const float g0 = __uint_as_float(ogw[i] << 16), g1 = __uint_as_float(ogw[i] & 0xffff0000u);
          const float r0 = hv[2 * i] * rstd * out_norm[2 * i] * __builtin_amdgcn_rcpf(1.f + __expf(-g0)), r1 = hv[2 * i + 1] * rstd * out_norm[2 * i + 1] * __builtin_amdgcn_rcpf(1.f + __expf(-g1));
          ow[i] = cvtpk(r0, r1); }
      u32x4 w0 = {ow[0], ow[1], ow[2], ow[3]}, w1 = {ow[4], ow[5], ow[6], ow[7]};
      bf16_t* yp = F_Y + (size_t)(rbase + t) * D + h * 64 + e0; *(u32x4*)yp = w0; *(u32x4*)(yp + 8) = w1; }
    __syncthreads();
}

__device__ __forceinline__ void attn_dispatch(Frame& F, int l, int idx) {
    constexpr float LOG2E = 1.4426950408889634f;
    if (idx < 384) { const int bh6 = idx >> 4, qb = idx & 15; const int b = bh6 / 6, h = bh6 % 6; const size_t bh = (size_t)bh6;
        attn_unit256<96, false, false>(F, F_QB + (bh * TS + TC + 256 * qb) * 96, F_KB + bh * TS * 96, F_VB + bh * TS * 64, MLA_NP, 0, 0.f, F_Y + (size_t)(b * T + 256 * qb) * D + 256 + h * 64); return; }
    idx -= 384;
    if (idx < 384) { const int bh6 = idx >> 4, qb = idx & 15; const int b = bh6 / 6, hq = bh6 % 6; const int kvh = hq / 3; const size_t bk = (size_t)b * 2 + kvh;
        attn_unit256<64, true, true>(F, F_QC + ((size_t)bh6 * TS + TC + 256 * qb) * 64, F_KC + bk * TS * 64, F_VC + bk * TS * 64, 6, 256 * qb, F.in[I_SINK][l * 6 + hq] * LOG2E, F_Y + (size_t)(b * T + 256 * qb) * D + 640 + hq * 64); return; }
    idx -= 384;
    if (idx < 24) { const int b = idx / 6, h = idx % 6; const size_t bh = (size_t)idx;
        attn_unit256<96, false, false>(F, F_QB + (bh * TS) * 96, F_KB + bh * TS * 96, F_VB + bh * TS * 64, 2, 0, 0.f, F_Y + (size_t)(ML + b * TC) * D + 256 + h * 64); return; }
    idx -= 24;
    { const int b = idx / 6, hq = idx % 6; const int kvh = hq / 3; const size_t bk = (size_t)b * 2 + kvh;
        attn_unit256<64, false, true>(F, F_QC + ((size_t)idx * TS) * 64, F_KC + bk * TS * 64, F_VC + bk * TS * 64, 2, 0, F.in[I_SINK][l * 6 + hq] * LOG2E, F_Y + (size_t)(ML + b * TC) * D + 640 + hq * 64); }
}
constexpr int CW_Q = 8192;
__device__ __forceinline__ void mix_unit(Frame& F, int l, int x, int li) {
    int idx; bool m3 = false; const int b = x >> 1, kvh = x & 1;
    if (li < 48) idx = (x + 8 * (li >> 4)) * 16 + (li & 15);
    else if (li < 96) { const int r = li - 48; idx = 384 + (b * 6 + kvh * 3 + (r >> 4)) * 16 + (r & 15); }
    else if (li < 160) { m3 = true; idx = x * 128 + 2 * (li - 96); }
    else if (li < 164) { m3 = true; idx = 1024 + x * 8 + 2 * (li - 160); }
    else if (li < 167) idx = 768 + x + 8 * (li - 164);
    else idx = 792 + b * 6 + kvh * 3 + (li - 167);
    if (m3) mlstm_m3_mfma(F, l, idx); else attn_dispatch(F, l, idx);
}
__device__ __forceinline__ void ph_mixers(Frame& F, int l, int rep) {
    OPAQUE_TID(F);
    const bool need_ctx = l + 1 < DEPTH;
    const int nloc = 160 + (need_ctx ? 10 : 0);
    unsigned* ctr0 = (unsigned*)(F.ws + WS_CTL) + CW_Q + 64 * 8 * (l + 2 * rep);
    volatile LAS int* slot = (volatile LAS int*)(F.lds + MISC_OFF + 64);
    const int x0 = (int)(xb_xcc_id() & 7u);
    for (int xs = 0; xs < 8; ++xs) {
        const int x = (x0 + xs) & 7;
        for (;;) {
            if (F.tid == 0) slot[0] = (int)__hip_atomic_fetch_add(ctr0 + 64 * x, 1u, __ATOMIC_RELAXED, __HIP_MEMORY_SCOPE_AGENT);
            __syncthreads();
            const int li = slot[0];
            __syncthreads();
            if (li >= nloc) break;
            mix_unit(F, l, x, li);
        }
    }
}

__global__ void __launch_bounds__(512, 2) fwd_mk(Args args) {
    extern __shared__ __attribute__((aligned(16))) unsigned char lds[];
    Frame F;
    F.lds = (LAS unsigned char*)lds;
    volatile LAS unsigned* MISC = (volatile LAS unsigned*)(F.lds + MISC_OFF);
    F.tid = threadIdx.x; F.lane = F.tid & 63; F.wave = __builtin_amdgcn_readfirstlane(F.tid >> 6);
    F.G = gridDim.x; { const int bx = blockIdx.x; F.vcu = (F.G % 8 == 0) ? (bx % 8) * (F.G / 8) + bx / 8 : bx; }
    F.in = args.in; F.out = args.out; F.ws = args.ws; unsigned char* ws = args.ws;
    for (int u = F.tid; u < (LDS_BYTES - LDSCTL_OFF) / 4; u += 512) ((LAS unsigned*)(F.lds + LDSCTL_OFF))[u] = 0u;
    __syncthreads();
    gu32* ctl = (gu32*)(ws + WS_CTL);
    XcdBarrier bar; bar.bar = (unsigned*)(ctl + CW_BAR); bar.x = 0; bar.st = nullptr;
    if (MK_N_LAUNCHES == 1) bar = xcd_barrier_post((unsigned*)(ctl + CW_BAR), MISC + 8);

    const int lo = args.ph_lo, hi = args.ph_hi;
    int rep = 0;
    for (int ph = lo; ph < hi; ++ph) {
        {
        int cv_l0 = 0, cv_r0 = 0, cv_n0 = 0, cv_nt = 0, cv_gw = 0, cv_ngw = 1;
        if (ph == 0) { p0_prologue(F);
            if (F.G == 256 && F.vcu >= 64) { cv_n0 = CV_P0; cv_nt = CV_P0; cv_gw = (F.vcu - 64) * 8 + F.wave; cv_ngw = 192 * 8; } }
        else {
            const int l = (ph - 1) / 13, sp = (ph - 1) % 13;
            const float* modl = F_MOD + (size_t)l * 5 * 9 * D;
            const bool first = (l == 0 && sp <= 2);
            const float* xl = first ? F.in[I_X] : F.out;
            const int Mrows = (l + 1 == DEPTH && sp >= 9) ? ML : M;
            float* slabD = (float*)(F.ws + WS_QUP); float* slabO = (float*)(F.ws + WS_QUP + 34 * MiB);
            switch (sp) {
            case 0: case 3: case 10: {
                int npend = 0; const float* pg = F_MOD; float pc = 0.f; const float* sl = slabD;
                if (sp == 0 && l > 0) { npend = 11; pg = modp(F_MOD, l - 1, 4, 8); pc = 0.5f; }
                if (sp == 3) { npend = 11; pg = modp(F_MOD, l, 4, 2); pc = 0.5f; }
                if (sp == 10 && Mrows == M) { npend = 4; pg = modp(F_MOD, l, 4, 5); pc = 1.0f; sl = slabO; }
                ph_modulate(F, xl, l, sp == 0 ? 0 : (sp == 3 ? 1 : 2), Mrows, rep ? 0 : npend, sl, pg, pc);
                if (l == 0 && sp == 0) {
                    static_assert(DEPTH == 2, "conversion lists");
                    const bool hosted = (F.G == 256); cv_r0 = hosted ? CV_P0 : 0; cv_n0 = hosted ? CV_NA - CV_P0 : CV_NA + CV_NB; cv_nt = hosted ? CV_NA - CV_P0 : 2 * (CV_NA + CV_NB); cv_gw = F.vcu * 8 + F.wave; cv_ngw = F.G * 8; } } break;
            case 1: case 11: {
                pg8::Gemm g{F_XN, F.wl(l, sp == 1 ? W_1I : W_2I), Mrows, 2 * DFF, D}; pg8::StaticOrder S; S.init(Mrows, 2 * DFF, F.G, (int)blockIdx.x, D);
                EpiSwiglu E{F_HID};
                #ifdef UP_SP2_OFF
                pg8::gemm_phase<EpiSwiglu, pg8::StaticOrder, true, false>(F.lds + RING_OFF, g, S, E);
#elif defined(UP_ALIGN_OFF)
                pg8::gemm_phase<EpiSwiglu, pg8::StaticOrder, false, true>(F.lds + RING_OFF, g, S, E);
#else
                pg8::gemm_phase<EpiSwiglu, pg8::StaticOrder, true, true>(F.lds + RING_OFF, g, S, E);
#endif
                } break;
            case 2: case 12: case 9: {
                const bool isout = sp == 9; const int K = isout ? D : DFF;
                pg8::Gemm g{isout ? F_Y : F_HID, F.wl(l, isout ? W_OUT : (sp == 2 ? W_1O : W_2O)), Mrows, D, K}; pg8::SplitOrder S; S.init(D, K, F.G, (int)blockIdx.x, Mrows == M ? (isout ? 4 : 11) : 0);
                EpiResid E{xl, F.out, isout ? slabO : slabD, modl, isout ? 5 : (sp == 2 ? 2 : 8), isout ? 1.0f : 0.5f};
#ifdef PROBE_DUP
                if (rep == 0 && sp == PROBE_DUP) E.coef = 0.f;
#endif
                pg8::gemm_phase<EpiResid, pg8::SplitOrder, true, true>(F.lds + RING_OFF, g, S, E); } break;
            case 4: {
                const bool split = (F.G == 256); const int Gg = split ? 184 : F.G;
                if ((int)blockIdx.x >= Gg) { cv_l0 = l; cv_r0 = CV_NA; cv_n0 = CV_NB; cv_nt = CV_NB + (l + 1 < DEPTH ? CV_NA : 0); cv_gw = ((int)blockIdx.x - Gg) * 8 + F.wave; cv_ngw = (F.G - Gg) * 8; break; }
                pg8::Gemm g{F_XN, F.wl(l, W_IN), M, 2048, D}; pg8::StaticOrder S; S.init(M, 2048, Gg, (int)blockIdx.x, D);
                EpiInproj E{F_P16A, F_G32, F_P16B};
                pg8::gemm_phase<EpiInproj, pg8::StaticOrder, true, true>(F.lds + RING_OFF, g, S, E); } break;
            case 5: {
#pragma unroll 1
                for (int s_ = 0; s_ < 2; ++s_) { if (((s_ ^ F.vcu) & 1) == 0) ph_prepA(F, l); else ph_mlstm_m1b(F, l); __syncthreads(); }
                } break;
            case 6: {
                const int Gg = (F.G == 256) ? 204 : F.G;
                if ((int)blockIdx.x >= Gg) { ph_mlstm_m2<3>(F, (int)blockIdx.x - Gg, F.G - Gg); break; }
                pg8::Gemm g{F_CKN, F.wl(l, W_UP), M, 1536, 384}; pg8::UpOrder S; S.init(Gg, (int)blockIdx.x);
                EpiUp E{F_QUP, F_KVUP};
                pg8::gemm_phase<EpiUp, pg8::UpOrder, true, true>(F.lds + RING_OFF, g, S, E); } break;
            case 7: { if (F.G != 256) ph_mlstm_m2<1>(F, F.vcu, F.G); ph_prepB(F, l);
#ifdef PROBE_PREPB2
                __syncthreads(); ph_prepB(F, l);
#endif
                } break;
            case 8: { ph_mixers(F, l, rep); } break;
            default: break;
            }
        }
        if (cv_nt > 0) { __syncthreads(); p0_weights(F, cv_l0, cv_r0, cv_n0, cv_nt, cv_gw, cv_ngw); }
        }
#ifdef PROBE_DUP
        if (rep == 0 && ((ph > 0 && (ph - 1) % 13 == PROBE_DUP) || (ph == 0 && PROBE_DUP == 100))) { rep = 1; --ph; xcd_barrier(bar); continue; }
        rep = 0;
#endif
        if (ph + 1 < hi) xcd_barrier(bar);
    }
}

extern "C" void kernel_launch(void* const* d_in, const int* in_sizes, int n_in, void* d_out, int out_size, void* d_ws, size_t ws_size, hipStream_t stream) {
    static int grid = 0;
    if (grid == 0) {
        if (n_in != 24 || ws_size < WS_END) { fprintf(stderr, "kernel_launch: unexpected n_in %d or ws_size %zu (< %zu)\n", n_in, ws_size, (size_t)WS_END); grid = -1; return; }
        int dev = 0, cus = 0, per_cu = 0;
        if (hipGetDevice(&dev) != hipSuccess || hipDeviceGetAttribute(&cus, hipDeviceAttributeMultiprocessorCount, dev) != hipSuccess) { grid = -1; return; }
        if (hipFuncSetAttribute((const void*)fwd_mk, hipFuncAttributeMaxDynamicSharedMemorySize, LDS_BYTES) != hipSuccess) { fprintf(stderr, "kernel_launch: hipFuncSetAttribute failed\n"); grid = -1; return; }
        if (hipOccupancyMaxActiveBlocksPerMultiprocessor(&per_cu, (const void*)fwd_mk, 512, LDS_BYTES) != hipSuccess || per_cu < 1) fprintf(stderr, "kernel_launch: occupancy query says %d per CU\n", per_cu);
        (void)hipGetLastError();
        grid = cus;
    }
    if (grid < 0) return;
    (void)hipMemsetAsync((char*)d_ws + WS_CTL, 0, CTL_ZERO_BYTES, stream);
    Args a{};
    for (int i = 0; i < 24; ++i) a.in[i] = (const float*)d_in[i];
    a.out = (float*)d_out; a.ws = (unsigned char*)d_ws;
#if MK_N_LAUNCHES == 1
    a.ph_lo = 0; a.ph_hi = NPH;
    hipLaunchKernelGGL(fwd_mk, dim3(grid), dim3(512), LDS_BYTES, stream, a);
#else
    for (int p = 0; p < NPH; ++p) { a.ph_lo = p; a.ph_hi = p + 1; hipLaunchKernelGGL(fwd_mk, dim3(grid), dim3(512), LDS_BYTES, stream, a); }
#endif
}
```

```cpp
#include <hip/hip_runtime.h>
#include <cstdio>
#include <cstdint>
#define MK_N_LAUNCHES 1
namespace pg8 {
#define PG8_LAS __attribute__((address_space(3)))
typedef unsigned short bf16_t;
typedef short bf16x8 __attribute__((ext_vector_type(8)));
typedef float f32x4 __attribute__((ext_vector_type(4)));
typedef unsigned u32x4 __attribute__((ext_vector_type(4)));
constexpr int BM = 256, BK = 64, HALF = 128, HTB = HALF * BK * 2  , STAGE_BYTES = 8 * HTB, NXCD = 8, WGM = 8;

__host__ __device__ __forceinline__ int lds_byte(int r, int c) { const int st = (r >> 4) * 2 + (c >> 5), rr = r & 15, cc = c & 31, ob = rr * 64 + cc * 2; return st * 1024 + (ob ^ (((ob >> 9) & 1) << 5)); }
__host__ __device__ __forceinline__ void stage_rc(int b, int& R, int& C) { const int st = b / 1024, sb = b % 1024, swz = sb ^ (((sb >> 9) & 1) << 5); R = (st >> 1) * 16 + swz / 64; C = (st & 1) * 32 + (swz % 64) / 2; }
__host__ __device__ __forceinline__ int perm32(int rho) { const int n = rho >> 4, i = rho & 15; return 8 * (i >> 2) + 4 * n + (i & 3); }

struct Unit { int pm, pn, kt0, nt, half; };
struct Gemm { const bf16_t* A; const bf16_t* Bt; int M, N, K; };

struct StaticOrder {
    int nM, nN, nwg, G, c, ntK;
    __host__ __device__ void init(int M, int N, int G_, int c_, int K_) { nM = M / BM; nN = N / BM; nwg = nM * nN; G = G_; c = c_; ntK = K_ / BK; }
    __host__ __device__ bool next(int i, Unit& u) const {
        const long L = (long)i * G + c; if (L >= nwg) return false;
        int wgid = (int)L; { const int q = nwg / NXCD, r = nwg % NXCD, xcd = wgid % NXCD, off = wgid / NXCD; wgid = (xcd < r ? xcd * (q + 1) : r * (q + 1) + (xcd - r) * q) + off; }
        const int nig = WGM * nN, gid = wgid / nig, fm = gid * WGM, gsz = (nM - fm) < WGM ? (nM - fm) : WGM;
        u.pm = fm + ((wgid % nig) % gsz); u.pn = (wgid % nig) / gsz; u.kt0 = 0; u.nt = ntK; u.half = 0; return true;
    }
    __device__ __forceinline__ void a_ready(const Unit&) const {}
    __device__ __forceinline__ void done(const Unit&) const {}
};

struct SplitOrder {
    StaticOrder lat; int NS, ntS;
    __host__ __device__ void init(int N, int K, int G_, int c_, int NS_) { lat.init(16384, N, G_, c_, K); NS = NS_; ntS = NS_ ? (K / BK) / NS_ : 0; }
    __host__ __device__ bool next(int i, Unit& u) const {
        if (lat.G == lat.nwg && i < 2 && lat.c < 16 * NS) i = 1 - i;
        const long L = (long)i * lat.G + lat.c; if (L < lat.nwg) return lat.next(i, u);
        const int idx = (int)(L - lat.nwg); if (idx >= 16 * NS) return false;
        const int tile = idx / NS, sl = idx % NS; u.pm = 64 + (tile >> 2); u.pn = tile & 3; u.kt0 = sl * ntS; u.nt = ntS; u.half = 0; return true;
    }
    __device__ __forceinline__ void a_ready(const Unit&) const {}
    __device__ __forceinline__ void done(const Unit&) const {}
};

struct InprojOrder {
    StaticOrder full7; int G, c;
    __host__ __device__ void init(int G_, int c_, int K) { full7.init(17408, 7 * 256, G_, c_, K); G = G_; c = c_; }
    __host__ __device__ bool next(int i, Unit& u) const {
        if (G != 256) { if (i > 0) return false; u.pm = 0; u.pn = 0; u.kt0 = 0; u.nt = full7.ntK; u.half = 0; return c == 0; }
        if (i == 0 || (i == 1 && c < 220)) { const bool ok = full7.next(i, u); if (ok && u.pn >= 3) u.pn += 1; return ok; }
        int hidx;
        if (i == 1) hidx = c - 220;
        else if (i == 2 && c >= 220 && c < 252) hidx = 36 + (c - 220);
        else return false;
        u.pm = hidx; u.pn = 3; u.kt0 = 0; u.nt = full7.ntK; u.half = 1; return true;
    }
    __device__ __forceinline__ void a_ready(const Unit&) const {}
    __device__ __forceinline__ void done(const Unit&) const {}
};

struct UpOrder {
    int G, c;
    __host__ __device__ void init(int G_, int c_) { G = G_; c = c_; }
    __host__ __device__ bool next(int i, Unit& u) const {
        const long L = (long)i * G + c; if (L >= 408) return false;
        const int kv = L >= 204, j = kv ? (int)L - 204 : (int)L;
        u.pm = j / 3; u.pn = (kv ? 3 : 0) + j % 3; u.kt0 = kv ? 4 : 0; u.nt = kv ? 2 : 4; u.half = 0; return true;
    }
    __device__ __forceinline__ void a_ready(const Unit&) const {}
    __device__ __forceinline__ void done(const Unit&) const {}
};

__device__ __forceinline__ unsigned cvt_pk_bf16(float lo, float hi) { unsigned r; asm volatile("v_cvt_pk_bf16_f32 %0, %1, %2" : "=v"(r) : "v"(lo), "v"(hi)); return r; }
template <class Epi, class Sched, bool ALIGN_EPI = false, bool SP2 = false>
__device__ __forceinline__ void gemm_phase(PG8_LAS unsigned char* lds, const Gemm g, const Sched& S, const Epi& E) {
    int tid_ = threadIdx.x; asm volatile("" : "+v"(tid_));
    const int tid = tid_, wid = __builtin_amdgcn_readfirstlane(tid >> 6), lane = tid & 63, wr = wid >> 2, wc = wid & 3, fr = lane & 15, fq = lane >> 4;
    int K_ = g.K; asm volatile("" : "+s"(K_));
    const int K = K_;
    unsigned voffA[2], voffB[2];
#pragma unroll
    for (int i = 0; i < 2; ++i) { int R, C; stage_rc(tid * 16 + i * 8192, R, C); const int Rb = Epi::PERM ? ((R & ~31) + perm32(R & 31)) : R;
        voffA[i] = (unsigned)(R * K + C) * 2u; voffB[i] = (unsigned)(Rb * K + C) * 2u; }
    const size_t kstep = (size_t)(BK * 2);
    const size_t hstep = (size_t)HALF * K * 2;
    const size_t tstep = 2 * hstep;
    const unsigned ldsw = (unsigned)wid * 1024u;
    const int aoff = lds_byte(wr * 64 + fr, fq * 8), boff = lds_byte(wc * 32 + fr, fq * 8);
#define PG8_SA(b, h) (((b) * 2 + (h)) * HTB)
#define PG8_SB(b, h) ((4 + (b) * 2 + (h)) * HTB)
#define PG8_STAGE(bufoff, gbase, voff) do { _Pragma("unroll") for (int _i = 0; _i < 2; ++_i) \
        __builtin_amdgcn_global_load_lds((const unsigned*)((const char*)(gbase) + (voff)[_i]), (PG8_LAS unsigned*)(lds + (bufoff) + ldsw + _i * 8192), 16, 0, 0); } while (0)
#define PG8_LDA(dst, b, h) do { _Pragma("unroll") for (int m = 0; m < 4; ++m) _Pragma("unroll") for (int k = 0; k < 2; ++k) dst[m][k] = *(const PG8_LAS bf16x8*)(lds + PG8_SA(b, h) + aoff + m * 2048 + k * 1024); } while (0)
#define PG8_LDB(dst, b, h) do { _Pragma("unroll") for (int n = 0; n < 2; ++n) _Pragma("unroll") for (int k = 0; k < 2; ++k) dst[n][k] = *(const PG8_LAS bf16x8*)(lds + PG8_SB(b, h) + boff + n * 2048 + k * 1024); } while (0)
#define PG8_MMA(ai, bj, At, Bt) do { __builtin_amdgcn_s_setprio(1); _Pragma("unroll") for (int m = 0; m < 4; ++m) _Pragma("unroll") for (int n = 0; n < 2; ++n) _Pragma("unroll") for (int k = 0; k < 2; ++k) \
        acc[ai][bj][m][n] = __builtin_amdgcn_mfma_f32_16x16x32_bf16(Bt[n][k], At[m][k], acc[ai][bj][m][n], 0, 0, 0); __builtin_amdgcn_s_setprio(0); } while (0)
#define PG8_WAIT_V(n) asm volatile("s_waitcnt vmcnt(" #n ")" ::: "memory")
#define PG8_WAIT_L(n) asm volatile("s_waitcnt lgkmcnt(" #n ")" ::: "memory")
#define PG8_BAR __builtin_amdgcn_s_barrier()
#define PG8_SCHED __builtin_amdgcn_sched_barrier(0)
    Unit cur, nxt; int ui = 0;
    if (!S.next(0, cur)) return;
    f32x4 acc[2][2][4][2];
#pragma unroll
    for (int a = 0; a < 2; ++a)
#pragma unroll
        for (int b = 0; b < 2; ++b)
#pragma unroll
            for (int m = 0; m < 4; ++m)
#pragma unroll
                for (int n = 0; n < 2; ++n) acc[a][b][m][n] = (f32x4){0.f, 0.f, 0.f, 0.f};
    bf16x8 At[4][2], B0[2][2], B1[2][2];
    const char* cA = (const char*)g.A + (size_t)cur.pm * tstep + (size_t)cur.kt0 * kstep; const char* cB = (const char*)g.Bt + (size_t)cur.pn * tstep + (size_t)cur.kt0 * kstep;
    S.a_ready(cur);
    if constexpr (SP2) {
        PG8_STAGE(PG8_SB(0, 0), cB, voffB); PG8_STAGE(PG8_SB(0, 1), cB + hstep, voffB); PG8_STAGE(PG8_SA(0, 0), cA, voffA); PG8_STAGE(PG8_SA(0, 1), cA + hstep, voffA);
        if (wr == 1) PG8_BAR;
        PG8_WAIT_V(2); PG8_BAR;
        PG8_STAGE(PG8_SB(1, 0), cB + kstep, voffB); PG8_STAGE(PG8_SA(1, 0), cA + kstep, voffA); PG8_STAGE(PG8_SB(1, 1), cB + hstep + kstep, voffB);
        PG8_WAIT_V(6); PG8_BAR;
    } else {
        PG8_STAGE(PG8_SB(0, 0), cB, voffB); PG8_STAGE(PG8_SA(0, 0), cA, voffA); PG8_STAGE(PG8_SB(0, 1), cB + hstep, voffB); PG8_STAGE(PG8_SA(0, 1), cA + hstep, voffA);
        if (wr == 1) PG8_BAR;
        PG8_WAIT_V(4); PG8_BAR;
        PG8_STAGE(PG8_SB(1, 0), cB + kstep, voffB); PG8_STAGE(PG8_SA(1, 0), cA + kstep, voffA); PG8_STAGE(PG8_SB(1, 1), cB + hstep + kstep, voffB);
        PG8_WAIT_V(6); PG8_BAR;
    }
    for (;;) {
        const bool has_next = S.next(ui + 1, nxt);
        const char* nA = has_next ? (const char*)g.A + (size_t)nxt.pm * tstep + (size_t)nxt.kt0 * kstep : cA; const char* nB = has_next ? (const char*)g.Bt + (size_t)nxt.pn * tstep + (size_t)nxt.kt0 * kstep : cB;
        const int ntc = cur.nt; const bool full = !cur.half;
        for (int t = 0; t < ntc; t += 2) {
            const bool last = (t == ntc - 2);
            const char* a1 = cA + (size_t)(t + 1) * kstep;
            const char* a2 = last ? nA : cA + (size_t)(t + 2) * kstep; const char* b2 = last ? nB : cB + (size_t)(t + 2) * kstep;
            const char* a3 = a2 + kstep; const char* b3 = b2 + kstep;
            if (last && has_next) S.a_ready(nxt);
            if constexpr (SP2) {
            PG8_LDB(B0, 0, 0); PG8_LDB(B1, 0, 1); PG8_SCHED; PG8_LDA(At, 0, 0); PG8_STAGE(PG8_SA(1, 1), a1 + hstep, voffA);
            PG8_WAIT_V(8); PG8_WAIT_L(0); PG8_BAR; PG8_MMA(0, 0, At, B0); if (full) PG8_MMA(0, 1, At, B1); PG8_BAR; PG8_SCHED;
            PG8_LDA(At, 0, 1); PG8_STAGE(PG8_SB(0, 0), b2, voffB); PG8_STAGE(PG8_SB(0, 1), b2 + hstep, voffB); PG8_STAGE(PG8_SA(0, 0), a2, voffA);
            PG8_WAIT_V(8); PG8_WAIT_L(0); PG8_BAR; PG8_MMA(1, 0, At, B0); if (full) PG8_MMA(1, 1, At, B1); PG8_BAR; PG8_SCHED;
            PG8_LDB(B0, 1, 0); PG8_LDB(B1, 1, 1); PG8_SCHED; PG8_LDA(At, 1, 0); PG8_STAGE(PG8_SA(0, 1), a2 + hstep, voffA);
            PG8_WAIT_V(8); PG8_WAIT_L(0); PG8_BAR; PG8_MMA(0, 0, At, B0); if (full) PG8_MMA(0, 1, At, B1); PG8_BAR; PG8_SCHED;
            PG8_LDA(At, 1, 1); PG8_STAGE(PG8_SB(1, 0), b3, voffB); PG8_STAGE(PG8_SB(1, 1), b3 + hstep, voffB); PG8_STAGE(PG8_SA(1, 0), a3, voffA);
            PG8_WAIT_V(8); PG8_WAIT_L(0); PG8_BAR; PG8_MMA(1, 0, At, B0); if (full) PG8_MMA(1, 1, At, B1); PG8_BAR; PG8_SCHED;
            } else {
            PG8_LDB(B0, 0, 0); PG8_SCHED; PG8_LDA(At, 0, 0); PG8_STAGE(PG8_SA(1, 1), a1 + hstep, voffA);
            PG8_WAIT_L(8); PG8_BAR; PG8_WAIT_L(0); PG8_MMA(0, 0, At, B0); PG8_BAR; PG8_SCHED;
            PG8_LDB(B1, 0, 1); PG8_STAGE(PG8_SB(0, 0), b2, voffB);
            PG8_BAR; PG8_WAIT_L(0); PG8_MMA(0, 1, At, B1); PG8_BAR;
            PG8_LDA(At, 0, 1); PG8_STAGE(PG8_SA(0, 0), a2, voffA);
            PG8_BAR; PG8_WAIT_L(0); PG8_MMA(1, 0, At, B0); PG8_BAR; PG8_SCHED;
            PG8_STAGE(PG8_SB(0, 1), b2 + hstep, voffB);
            PG8_WAIT_V(6); PG8_BAR; PG8_MMA(1, 1, At, B1); PG8_BAR;
            PG8_LDB(B0, 1, 0); PG8_SCHED; PG8_LDA(At, 1, 0); PG8_STAGE(PG8_SA(0, 1), a2 + hstep, voffA);
            PG8_WAIT_L(8); PG8_BAR; PG8_WAIT_L(0); PG8_MMA(0, 0, At, B0); PG8_BAR; PG8_SCHED;
            PG8_LDB(B1, 1, 1); PG8_STAGE(PG8_SB(1, 0), b3, voffB);
            PG8_BAR; PG8_WAIT_L(0); PG8_MMA(0, 1, At, B1); PG8_BAR;
            PG8_LDA(At, 1, 1); PG8_STAGE(PG8_SA(1, 0), a3, voffA);
            PG8_BAR; PG8_WAIT_L(0); PG8_MMA(1, 0, At, B0); PG8_BAR; PG8_SCHED;
            PG8_STAGE(PG8_SB(1, 1), b3 + hstep, voffB);
            PG8_WAIT_V(6); PG8_BAR; PG8_MMA(1, 1, At, B1); PG8_BAR;
            }
        }
        if constexpr (ALIGN_EPI) { if (wr == 0) PG8_BAR; }
        if constexpr (!Epi::AFTER_DRAIN) { E(acc, cur, wr, wc, fr, fq); S.done(cur); }
        if (!has_next) break;
#pragma unroll
        for (int a = 0; a < 2; ++a)
#pragma unroll
            for (int b = 0; b < 2; ++b)
#pragma unroll
                for (int m = 0; m < 4; ++m)
#pragma unroll
                    for (int n = 0; n < 2; ++n) acc[a][b][m][n] = (f32x4){0.f, 0.f, 0.f, 0.f};
        cur = nxt; cA = nA; cB = nB; ++ui;
        if constexpr (ALIGN_EPI) { if (wr == 1) PG8_BAR; }
    }
    PG8_WAIT_V(0);
    if constexpr (!ALIGN_EPI) { if (wr == 0) PG8_BAR; }
    PG8_BAR;
    if constexpr (Epi::AFTER_DRAIN) { E.fused(acc, cur, wr, wc, fr, fq, lds, wid, lane); S.done(cur); }
#undef PG8_SA
#undef PG8_SB
#undef PG8_STAGE
#undef PG8_LDA
#undef PG8_LDB
#undef PG8_MMA
#undef PG8_WAIT_V
#undef PG8_WAIT_L
#undef PG8_BAR
#undef PG8_SCHED
}
}

#ifndef MK_N_LAUNCHES
#define MK_N_LAUNCHES 1
#endif
namespace cf {
constexpr int D = 1024, NB = 4, T = 4096, TC = 256, ML = NB * T, MC = NB * TC, M = ML + MC, TS = T + TC;
constexpr int DFF = 2816, DIN = 1840, DEPTH = 2;
constexpr float EPS = 1e-6f;
constexpr int NPH = 1 + 13 * DEPTH;
}
using namespace cf;
typedef unsigned short bf16_t;
typedef float f32x4 __attribute__((ext_vector_type(4)));
typedef unsigned u32x4 __attribute__((ext_vector_type(4)));
#define GAS __attribute__((address_space(1)))
#define LAS __attribute__((address_space(3)))
typedef GAS unsigned gu32;
#define RLX_AGENT __ATOMIC_RELAXED, __HIP_MEMORY_SCOPE_AGENT
#define LDS_WAIT() asm volatile("s_waitcnt lgkmcnt(0)" ::: "memory")
#define VM_WAIT() asm volatile("s_waitcnt vmcnt(0)" ::: "memory")

constexpr size_t MiB = 1u << 20;
constexpr size_t WS_CTL = 0, CTL_ZERO_BYTES = 64 * 1024;
constexpr size_t WS_MOD = 1 * MiB;
constexpr size_t WS_XBC = 5 * MiB;
constexpr size_t WS_W = 9 * MiB;
constexpr size_t W_1I = 0, W_1O = W_1I + (size_t)5632 * 1024, W_2I = W_1O + (size_t)1024 * 2816, W_2O = W_2I + (size_t)5632 * 1024, W_IN = W_2O + (size_t)1024 * 2816,
                 W_OUT = W_IN + (size_t)2048 * 1024, W_UP = W_OUT + (size_t)1024 * 1024, WL_STRIDE = W_UP + (size_t)1536 * 384;
static_assert(WS_W + 2 * WL_STRIDE * 2 <= 90 * MiB, "weights");
constexpr size_t WS_XN = 90 * MiB;
constexpr size_t WS_HID = 124 * MiB;
constexpr size_t WS_P16A = 124 * MiB;
constexpr size_t WS_G32 = WS_P16A + (size_t)M * 768 * 2;
constexpr size_t WS_P16B = 154 * MiB;
constexpr size_t WS_MLA = 154 * MiB;
constexpr size_t WS_LOC = 205 * MiB;
constexpr size_t WS_QUP = 223 * MiB;
constexpr size_t WS_END = 274 * MiB;
static_assert(WS_G32 + (size_t)M * 64 * 4 <= WS_P16B && WS_MLA + ((size_t)NB * 6 * TS * (96 + 96 + 64)) * 2 <= WS_LOC && WS_LOC + (size_t)32 * 68 * 2112 * 4 <= WS_QUP && WS_QUP + (size_t)M * 768 * 4 <= WS_END, "ws map");
static_assert(WS_HID + (size_t)M * DFF * 2 <= WS_QUP, "ws map 2");
constexpr int CW_BAR = 1024;

constexpr int RING_OFF = 0, RING_BYTES = 131072, LDSCTL_OFF = RING_BYTES, MISC_OFF = LDSCTL_OFF + 320, LDS_BYTES = 147456;

__device__ __forceinline__ float bf2f(bf16_t v) { return __uint_as_float(((unsigned)v) << 16); }
__device__ __forceinline__ bf16_t f2bf(float f) { unsigned u = __float_as_uint(f); u += 0x7fffu + ((u >> 16) & 1u); return (bf16_t)(u >> 16); }
__device__ __forceinline__ unsigned pk2(float lo, float hi) { typedef float f2_t_ __attribute__((ext_vector_type(2))); typedef __bf16 b2_t_ __attribute__((ext_vector_type(2))); f2_t_ v = {lo, hi}; b2_t_ b = __builtin_convertvector(v, b2_t_); return __builtin_bit_cast(unsigned, b); }
__device__ __forceinline__ float siluf(float x) { return x / (1.f + expf(-x)); }
__device__ __forceinline__ float silu_fast(float x) { return x * __builtin_amdgcn_rcpf(1.f + __expf(-x)); }
__device__ __forceinline__ float sigmoidf_(float x) { return 1.f / (1.f + expf(-x)); }
__device__ __forceinline__ float logsigmoidf_(float x) { return x >= 0.f ? -log1pf(expf(-x)) : x - log1pf(expf(x)); }
struct RowInfo { int b, t, isctx, s, sp; };
__device__ __forceinline__ RowInfo rowinfo(int m) {
    RowInfo r;
    if (m < ML) { r.b = m / T; r.t = m % T; r.isctx = 0; r.s = r.b; r.sp = TC + r.t; }
    else { int q = m - ML; r.b = q / TC; r.t = q % TC; r.isctx = 1; r.s = 4; r.sp = r.t; }
    return r;
}
template <int CTRL> __device__ __forceinline__ float dpp_f(float v) { return __int_as_float(__builtin_amdgcn_update_dpp(0, __float_as_int(v), CTRL, 0xF, 0xF, true)); }
__device__ __forceinline__ float sum16(float v) { v += dpp_f<0x128>(v); v += dpp_f<0x124>(v); v += dpp_f<0x122>(v); v += dpp_f<0x121>(v); return v; }
__device__ __forceinline__ float xor16_sum(float v) { auto r = __builtin_amdgcn_permlane16_swap(__float_as_uint(v), __float_as_uint(v), false, false); return __uint_as_float(r[0]) + __uint_as_float(r[1]); }
__device__ __forceinline__ float xor32_sum(float v) { auto r = __builtin_amdgcn_permlane32_swap(__float_as_uint(v), __float_as_uint(v), false, false); return __uint_as_float(r[0]) + __uint_as_float(r[1]); }
__device__ __forceinline__ float sum32(float v) { return xor16_sum(sum16(v)); }
__device__ __forceinline__ float wave_sum(float v) { return xor32_sum(xor16_sum(sum16(v))); }
template <int CTRL, int RMASK> __device__ __forceinline__ float dpp_id(float v, float ident) { return __int_as_float(__builtin_amdgcn_update_dpp(__float_as_int(ident), __float_as_int(v), CTRL, RMASK, 0xF, false)); }
__device__ __forceinline__ float scan_sum64(float v) {
    v += dpp_id<0x111, 0xF>(v, 0.f); v += dpp_id<0x112, 0xF>(v, 0.f); v += dpp_id<0x114, 0xF>(v, 0.f); v += dpp_id<0x118, 0xF>(v, 0.f);
    v += dpp_id<0x142, 0xA>(v, 0.f); v += dpp_id<0x143, 0xC>(v, 0.f); return v; }
__device__ __forceinline__ float scan_max64(float v) {
    const float NI = -INFINITY;
    v = fmaxf(v, dpp_id<0x111, 0xF>(v, NI)); v = fmaxf(v, dpp_id<0x112, 0xF>(v, NI)); v = fmaxf(v, dpp_id<0x114, 0xF>(v, NI)); v = fmaxf(v, dpp_id<0x118, 0xF>(v, NI));
    v = fmaxf(v, dpp_id<0x142, 0xA>(v, NI)); v = fmaxf(v, dpp_id<0x143, 0xC>(v, NI)); return v; }
__device__ __forceinline__ float lane_bcast(float v, int lane_const) { return __int_as_float(__builtin_amdgcn_readlane(__float_as_int(v), lane_const)); }
__device__ __forceinline__ float xchg4(float v, int l16) { const float up = dpp_f<0x104>(v)  , dn = dpp_f<0x114>(v)  ; return (l16 & 4) ? dn : up; }
__device__ __forceinline__ float xchg2(float v) { return dpp_f<0x4E>(v); }
__device__ __forceinline__ void sincos_b(float a, float& s, float& c) {
    const float inv2pi = 0.15915494309189535f;
    float k = rintf(a * inv2pi);
    float r = fmaf(-k, 6.28125f, a);
    r = fmaf(-k, 1.9353071795864769e-3f, r);
    float rev = r * inv2pi;
    s = __builtin_amdgcn_sinf(rev); c = __builtin_amdgcn_cosf(rev);
}
__device__ __forceinline__ const float* modp(const float* MOD, int l, int s, int n) { return MOD + ((size_t)(l * 5 + s) * 9 + n) * D; }
#define XB_TMO      128
#define XB_XCNT(j)  (256  + 64 * (j))
#define XB_XSUB(j)  (1280 + 64 * (j))
#define XB_XGEN(j)  (2304 + 64 * (j))
#define XB_TOP      3328
#define XB_TOPGEN   3392
#define XCD_BAR_WORDS 3456
#define XB_SPIN_CAP (1u << 18)

__device__ __forceinline__ unsigned xb_ld(unsigned* p)              { return __hip_atomic_load(p, __ATOMIC_RELAXED, __HIP_MEMORY_SCOPE_AGENT); }
__device__ __forceinline__ unsigned xb_add(unsigned* p, unsigned v) { return __hip_atomic_fetch_add(p, v, __ATOMIC_RELAXED, __HIP_MEMORY_SCOPE_AGENT); }
__device__ __forceinline__ unsigned xb_xcc_id() { return (unsigned)__builtin_amdgcn_s_getreg((3 << 11) | 20) & 0xFu; }
#define XB_SPIN(cond, bar) do { unsigned _sp = 0; while (cond) { __builtin_amdgcn_s_sleep(1); \
    if ((++_sp & 255u) == 0u) { if (xb_ld(&(bar)[XB_TMO])) break; if (_sp > XB_SPIN_CAP) { atomicAdd(&(bar)[XB_TMO], 1u); break; } } } } while (0)

struct XcdBarrier {
    unsigned* bar; unsigned x;
    volatile LAS unsigned* st;
};

__device__ __forceinline__ XcdBarrier xcd_barrier_post(unsigned* bar, volatile LAS unsigned* st) {
    XcdBarrier b; b.bar = bar; b.x = xb_xcc_id(); b.st = st;
    if (threadIdx.x == 0) (void)xb_add(&bar[XB_XCNT(b.x)], 1u);
    return b;
}
__device__ __forceinline__ void xcd_barrier_complete(unsigned* bar, unsigned x, unsigned& nloc, unsigned& nx) {
    const unsigned G = gridDim.x * gridDim.y * gridDim.z;
    unsigned sum, cnt, mine, sp = 0u;
    for (;;) {
        sum = 0u; cnt = 0u; mine = 0u;
#pragma unroll
        for (unsigned j = 0; j < 16; ++j) { const unsigned c = xb_ld(&bar[XB_XCNT(j)]); sum += c; cnt += (c > 0u) ? 1u : 0u; mine = (j == x) ? c : mine; }
        if (sum == G) break;
        __builtin_amdgcn_s_sleep(1);
        if ((++sp & 255u) == 0u) { if (xb_ld(&bar[XB_TMO])) break; if (sp > XB_SPIN_CAP) { atomicAdd(&bar[XB_TMO], 1u); break; } }
    }
    nloc = mine > 0u ? mine : 1u; nx = cnt > 0u ? cnt : 1u;
}

__device__ __forceinline__ void xcd_barrier(const XcdBarrier& b) {
    asm volatile("s_waitcnt vmcnt(0)" ::: "memory");
    __syncthreads();
    if (threadIdx.x == 0) {
        unsigned* bar = b.bar;
        __builtin_amdgcn_s_waitcnt(0);
        unsigned nloc = b.st[0], nx = b.st[1];
        if (nloc == 0u) { xcd_barrier_complete(bar, b.x, nloc, nx); b.st[0] = nloc; b.st[1] = nx; }
        const unsigned old = xb_add(&bar[XB_XSUB(b.x)], 1u);
        const unsigned gen = old / nloc;
        if (old + 1u == (gen + 1u) * nloc) {
            __builtin_amdgcn_fence(__ATOMIC_RELEASE, "agent");
            asm volatile("s_waitcnt vmcnt(0)" ::: "memory");
            const unsigned og = xb_add(&bar[XB_TOP], 1u);
            const unsigned tg = og / nx;
            if (og + 1u == (tg + 1u) * nx) xb_add(&bar[XB_TOPGEN], 1u);
            else XB_SPIN(xb_ld(&bar[XB_TOPGEN]) == tg, bar);
            __builtin_amdgcn_fence(__ATOMIC_ACQUIRE, "agent");
            xb_add(&bar[XB_XGEN(b.x)], 1u);
            asm volatile("s_waitcnt vmcnt(0)" ::: "memory");
        } else {
            XB_SPIN(xb_ld(&bar[XB_XGEN(b.x)]) == gen, bar);
            __builtin_amdgcn_fence(__ATOMIC_ACQUIRE, "agent");
            asm volatile("s_waitcnt vmcnt(0)" ::: "memory");
        }
    }
    __syncthreads();
}

struct Args { const float* in[24]; float* out; unsigned char* ws; int ph_lo, ph_hi; };
struct Frame {
    LAS unsigned char* lds; int tid, lane, wave, vcu, G;
    const float* const* in; float* out; unsigned char* ws;
    __device__ __forceinline__ bf16_t* wl(int l, size_t off) const { return (bf16_t*)(ws + WS_W) + (size_t)l * WL_STRIDE + off; }
};
#define OPAQUE_TID(F) do { int t_ = (F).tid; asm volatile("" : "+v"(t_)); (F).tid = t_; (F).lane = t_ & 63; } while (0)
#define F_MOD   ((float*)(F.ws + WS_MOD))
#define F_XBC   ((float*)(F.ws + WS_XBC))
#define F_XN    ((bf16_t*)(F.ws + WS_XN))
#define F_HID   ((bf16_t*)(F.ws + WS_HID))
#define F_P16A  ((bf16_t*)(F.ws + WS_P16A))
#define F_G32   ((float*)(F.ws + WS_G32))
#define F_P16B  ((bf16_t*)(F.ws + WS_P16B))
#define F_Y     ((bf16_t*)(F.ws + WS_QUP))
#define F_QUP   ((bf16_t*)(F.ws + WS_QUP))
#define F_KVUP  ((bf16_t*)(F.ws + WS_QUP) + (size_t)M * 768)
#define F_QC    ((bf16_t*)(F.ws + WS_XN))
#define F_KC    (F_QC + (size_t)NB * 6 * TS * 64)
#define F_VC    (F_KC + (size_t)NB * 2 * TS * 64)
#define F_CKN   (F_VC + (size_t)NB * 2 * TS * 64)
#define F_QB    ((bf16_t*)(F.ws + WS_MLA))
#define F_KB    (F_QB + (size_t)NB * 6 * TS * 96)
#define F_VB    (F_KB + (size_t)NB * 6 * TS * 96)
enum InIdx { I_X = 0, I_C, I_CTX, I_CCTX, I_ADAW, I_ADAB, I_NORMG, I_F1WI, I_F1WO, I_F2WI, I_F2WO, I_WIN, I_WOUT, I_GATEB, I_OUTNORM, I_CQN, I_CKVN, I_WUQ, I_WUKV, I_MQN, I_MKN, I_GQN, I_GKN, I_SINK };

template <class Map>
__device__ __forceinline__ void transpose_item(const float* W, int ldw, int Nsrc, int k0, int n0, bf16_t* WT, int ldt, int koff, Map map, LAS float* scr, int lane, float sc = 1.f) {
    int nsrc = n0 + (lane & 31); nsrc = nsrc < Nsrc ? nsrc : Nsrc - 1;
    float tv[32];
#pragma unroll
    for (int i = 0; i < 32; ++i) { const int kk = 2 * i + (lane >> 5); tv[i] = W[(size_t)(k0 + kk) * ldw + nsrc]; }
#pragma unroll
    for (int i = 0; i < 32; ++i) { const int kk = 2 * i + (lane >> 5); scr[kk * 33 + (lane & 31)] = tv[i]; }
    LDS_WAIT(); asm volatile("" ::: "memory");
    const int c = lane & 7;
#pragma unroll
    for (int j = 0; j < 4; ++j) { const int nn = (lane >> 3) + 8 * j; const LAS float* s = scr + (8 * c) * 33 + nn;
        u32x4 o; o.x = pk2(s[0 * 33] * sc, s[1 * 33] * sc); o.y = pk2(s[2 * 33] * sc, s[3 * 33] * sc); o.z = pk2(s[4 * 33] * sc, s[5 * 33] * sc); o.w = pk2(s[6 * 33] * sc, s[7 * 33] * sc);
        if (n0 + nn < Nsrc) *(u32x4*)(WT + (size_t)map(n0 + nn) * ldt + koff + k0 + 8 * c) = o; }
    LDS_WAIT(); asm volatile("" ::: "memory");
}
constexpr float SW_GSC = 1.4426950408889634f, SW_USC = 0.6931471805599453f;
static_assert(DFF % 32 == 0, "a conversion item never straddles the gate/up boundary");
struct MapId { __device__ __forceinline__ int operator()(int n) const { return n; } };
struct MapWi { __device__ __forceinline__ int operator()(int n) const { return n < DFF ? 256 * (n >> 7) + (n & 127) : 256 * ((n - DFF) >> 7) + 128 + ((n - DFF) & 127); } };
__host__ __device__ __forceinline__ int pcol(int n) {
    if (n < 784) return n;
    if (n < 1040) return 1024 + (n - 784);
    if (n < 1168) return 1280 + (n - 1040);
    if (n < 1200) return 784 + (n - 1168);
    if (n < 1584) return 1408 + (n - 1200);
    if (n < 1712) return 1792 + (n - 1584);
    return 1920 + (n - 1712);
}
struct MapWin { __device__ __forceinline__ int operator()(int n) const { return pcol(n); } };
struct MapUq { __device__ __forceinline__ int operator()(int n) const { return 128 * (n / 96) + (n % 96); } };
struct MapUkv { __device__ __forceinline__ int operator()(int n) const { return 768 + n; } };

__device__ __forceinline__ void p0_prologue(Frame& F) {
    OPAQUE_TID(F);
    {
        LAS float* sc = (LAS float*)(F.lds);
        LAS float* red = (LAS float*)(F.lds + 20480);
        for (int i = F.tid; i < 5 * 1024; i += 512) { int s = i >> 10, k = i & 1023; float v = s < 4 ? F.in[I_C][s * D + k] : F.in[I_CCTX][k]; sc[i] = siluf(v); }
        __syncthreads();
        for (int it = F.vcu; it < 576; it += F.G) {
            const int l = it / 288, cb = it % 288; const int kk = F.lane >> 3, c4 = F.lane & 7; const int kb = F.wave * 128;
            const float* w = F.in[I_ADAW] + (size_t)l * D * 9216 + (size_t)(kb + kk) * 9216 + cb * 32 + 4 * c4;
            f32x4 a[5] = {{0.f, 0.f, 0.f, 0.f}, {0.f, 0.f, 0.f, 0.f}, {0.f, 0.f, 0.f, 0.f}, {0.f, 0.f, 0.f, 0.f}, {0.f, 0.f, 0.f, 0.f}};
#pragma unroll 16
            for (int i = 0; i < 16; ++i) { const f32x4 wv = *(const f32x4*)(w + (size_t)(8 * i) * 9216); const int k = kb + kk + 8 * i;
#pragma unroll
                for (int s = 0; s < 5; ++s) a[s] += wv * sc[s * 1024 + k]; }
#pragma unroll
            for (int s = 0; s < 5; ++s) {
#pragma unroll
                for (int c = 0; c < 4; ++c) { float t = a[s][c]; t += dpp_f<0x128>(t); t = xor32_sum(xor16_sum(t)); a[s][c] = t; } }
            if (kk == 0) { LAS float* r = red + F.wave * 160 + 4 * c4;
#pragma unroll
                for (int s = 0; s < 5; ++s) *(LAS f32x4*)(r + 32 * s) = a[s]; }
            __syncthreads();
            if (F.tid < 160) { const int s = F.tid >> 5, col = F.tid & 31; float acc = F.in[I_ADAB][l * 9216 + cb * 32 + col];
#pragma unroll
                for (int wv = 0; wv < 8; ++wv) acc += red[wv * 160 + s * 32 + col];
                F_MOD[(size_t)(l * 5 + s) * 9216 + cb * 32 + col] = acc; }
            __syncthreads();
        }
    }
    { const int gt = F.vcu * 512 + F.tid, NGT = F.G * 512; for (int i = gt; i < MC * D / 4; i += NGT) ((f32x4*)F_XBC)[i] = ((const f32x4*)F.in[I_CTX])[i]; }
    {
        const int gt = F.vcu * 512 + F.tid, NGT = F.G * 512; const u32x4 z = {0u, 0u, 0u, 0u};
        for (int i = gt; i < 2 * (768 * 16 + 768 * 32); i += NGT) {
            const int l = i / (768 * 48); int r = i % (768 * 48);
            bf16_t* wu = F.wl(l, W_UP);
            if (r < 768 * 16) { const int row = r >> 4, ch = r & 15; *(u32x4*)(wu + (size_t)row * 384 + 256 + 8 * ch) = z; }
            else { r -= 768 * 16; const int row = 768 + (r >> 5), ch = r & 31; *(u32x4*)(wu + (size_t)row * 384 + 8 * ch) = z; }
        }
    }
}

constexpr int CV_WI = 16 * 176, CV_WO = 44 * 32, CV_IN = 16 * 58, CV_OUT = 16 * 32, CV_UQ = 4 * 18, CV_UKV = 2 * 24;
constexpr int CV_NA = CV_WI + CV_WO + CV_IN + CV_UQ + CV_UKV, CV_NB = CV_WI + CV_WO + CV_OUT, CV_P0 = CV_NA;
static_assert(CV_P0 <= CV_NA, "phase-0 share");
__device__ __forceinline__ void p0_weights(Frame& F, int l0, int r0, int n0, int ntot, int gw, int NGW) {
    OPAQUE_TID(F);
    LAS float* scr = (LAS float*)(F.lds + F.wave * 16384);
    for (int t = gw; t < ntot; t += NGW) {
        const int l = t < n0 ? l0 : l0 + 1; int r = t < n0 ? r0 + t : t - n0;
        if (r < CV_WI) { transpose_item(F.in[I_F1WI] + (size_t)l * D * 2 * DFF, 2 * DFF, 2 * DFF, 64 * (r / 176), 32 * (r % 176), F.wl(l, W_1I), 1024, 0, MapWi(), scr, F.lane, (r % 176) < 88 ? SW_GSC : SW_USC); continue; } r -= CV_WI;
        if (r < CV_WO) { transpose_item(F.in[I_F1WO] + (size_t)l * DFF * D, D, D, 64 * (r / 32), 32 * (r % 32), F.wl(l, W_1O), DFF, 0, MapId(), scr, F.lane); continue; } r -= CV_WO;
        if (r < CV_IN) { transpose_item(F.in[I_WIN] + (size_t)l * D * DIN, DIN, DIN, 64 * (r / 58), 32 * (r % 58), F.wl(l, W_IN), 1024, 0, MapWin(), scr, F.lane); continue; } r -= CV_IN;
        if (r < CV_UQ) { transpose_item(F.in[I_WUQ] + (size_t)l * 256 * 576, 576, 576, 64 * (r / 18), 32 * (r % 18), F.wl(l, W_UP), 384, 0, MapUq(), scr, F.lane); continue; } r -= CV_UQ;
        if (r < CV_UKV) { transpose_item(F.in[I_WUKV] + (size_t)l * 128 * 768, 768, 768, 64 * (r / 24), 32 * (r % 24), F.wl(l, W_UP), 384, 256, MapUkv(), scr, F.lane); continue; } r -= CV_UKV;
        if (r < CV_WI) { transpose_item(F.in[I_F2WI] + (size_t)l * D * 2 * DFF, 2 * DFF, 2 * DFF, 64 * (r / 176), 32 * (r % 176), F.wl(l, W_2I), 1024, 0, MapWi(), scr, F.lane, (r % 176) < 88 ? SW_GSC : SW_USC); continue; } r -= CV_WI;
        if (r < CV_WO) { transpose_item(F.in[I_F2WO] + (size_t)l * DFF * D, D, D, 64 * (r / 32), 32 * (r % 32), F.wl(l, W_2O), DFF, 0, MapId(), scr, F.lane); continue; } r -= CV_WO;
        transpose_item(F.in[I_WOUT] + (size_t)l * D * D, D, D, 64 * (r / 32), 32 * (r % 32), F.wl(l, W_OUT), 1024, 0, MapId(), scr, F.lane);
    }
}
__device__ __forceinline__ void ph_modulate(Frame& F, const float* xl, int l, int which, int Mrows, int npend, const float* slab, const float* pgate, float pcoef) {
    OPAQUE_TID(F);
    const int gw = F.vcu * 8 + F.wave, NGW = F.G * 8, lane = F.lane;
    const f32x4* g4 = (const f32x4*)(F.in[I_NORMG] + (l * 3 + which) * D);
    {
        f32x4 cur[4];
        if (gw < ML) {
#pragma unroll
            for (int j = 0; j < 4; ++j) cur[j] = ((const f32x4*)(xl + (size_t)gw * D))[lane + 64 * j];
        }
        for (int m = gw; m < ML; m += NGW) {
            const int mn = (m + NGW < ML) ? m + NGW : m; f32x4 nxt[4];
#pragma unroll
            for (int j = 0; j < 4; ++j) nxt[j] = ((const f32x4*)(xl + (size_t)mn * D))[lane + 64 * j];
            const int s = m / T;
            const f32x4* sh4 = (const f32x4*)modp(F_MOD, l, s, 3 * which); const f32x4* sc4 = (const f32x4*)modp(F_MOD, l, s, 3 * which + 1);
            f32x4 gs[4], sh[4];
#pragma unroll
            for (int j = 0; j < 4; ++j) { const f32x4 g = g4[lane + 64 * j], sc = sc4[lane + 64 * j]; sh[j] = sh4[lane + 64 * j]; gs[j] = g * (sc + 1.f); }
            float ss = 0.f;
#pragma unroll
            for (int j = 0; j < 4; ++j) ss += cur[j].x * cur[j].x + cur[j].y * cur[j].y + cur[j].z * cur[j].z + cur[j].w * cur[j].w;
            ss = wave_sum(ss);
            const float rstd = rsqrtf(ss * (1.f / D) + EPS);
            uint2* o = (uint2*)(F_XN + (size_t)m * D);
#pragma unroll
            for (int j = 0; j < 4; ++j) { const f32x4 y = cur[j] * rstd * gs[j] + sh[j]; uint2 r; r.x = pk2(y.x, y.y); r.y = pk2(y.z, y.w); o[lane + 64 * j] = r; }
#pragma unroll
            for (int j = 0; j < 4; ++j) cur[j] = nxt[j];
        }
    }
    if (Mrows > ML) {
        LAS float* xs = (LAS float*)(F.lds);
        for (int r0 = F.vcu * 4; r0 < MC; r0 += F.G * 4) {
            const int row = r0 + (F.wave >> 1), hf = F.wave & 1;
            f32x4* xr = (f32x4*)(F_XBC + (size_t)row * D) + hf * 128;
            f32x4 v[2];
#pragma unroll
            for (int j = 0; j < 2; ++j) v[j] = xr[lane + 64 * j];
            if (npend > 0) {
                f32x4 t[11][2];
#pragma unroll
                for (int s = 0; s < 11; ++s) { const int sc_ = s < npend ? s : npend - 1; const f32x4* sr = (const f32x4*)(slab + ((size_t)sc_ * MC + row) * D) + hf * 128;
#pragma unroll
                    for (int j = 0; j < 2; ++j) t[s][j] = sr[lane + 64 * j]; }
                f32x4 a[2] = {{0.f, 0.f, 0.f, 0.f}, {0.f, 0.f, 0.f, 0.f}};
#pragma unroll
                for (int s = 0; s < 11; ++s) { const float w = s < npend ? 1.f : 0.f;
#pragma unroll
                    for (int j = 0; j < 2; ++j) a[j] += t[s][j] * w; }
#pragma unroll
                for (int j = 0; j < 2; ++j) { v[j] += ((const f32x4*)pgate)[hf * 128 + lane + 64 * j] * pcoef * a[j]; xr[lane + 64 * j] = v[j]; }
            }
            float ss = 0.f;
#pragma unroll
            for (int j = 0; j < 2; ++j) ss += v[j].x * v[j].x + v[j].y * v[j].y + v[j].z * v[j].z + v[j].w * v[j].w;
            ss = wave_sum(ss);
            __syncthreads();
            if (lane == 0) xs[F.wave] = ss;
            __syncthreads();
            ss = xs[F.wave] + xs[F.wave ^ 1];
            const float rstd = rsqrtf(ss * (1.f / D) + EPS);
            const f32x4* sh4 = (const f32x4*)modp(F_MOD, l, 4, 3 * which) + hf * 128; const f32x4* sc4 = (const f32x4*)modp(F_MOD, l, 4, 3 * which + 1) + hf * 128;
            uint2* o = (uint2*)(F_XN + (size_t)(ML + row) * D) + hf * 128;
#pragma unroll
            for (int j = 0; j < 2; ++j) {
                f32x4 g = g4[hf * 128 + lane + 64 * j], sh = sh4[lane + 64 * j], sc = sc4[lane + 64 * j];
                uint2 r; r.x = pk2(v[j].x * rstd * g.x * (1.f + sc.x) + sh.x, v[j].y * rstd * g.y * (1.f + sc.y) + sh.y);
                r.y = pk2(v[j].z * rstd * g.z * (1.f + sc.z) + sh.z, v[j].w * rstd * g.w * (1.f + sc.w) + sh.w);
                o[lane + 64 * j] = r;
            }
        }
    }
}
__device__ __forceinline__ f32x4 ld_bf4(const bf16_t* p) { uint2 w = *(const uint2*)p; f32x4 r; r.x = __uint_as_float(w.x << 16); r.y = __uint_as_float(w.x & 0xffff0000u); r.z = __uint_as_float(w.y << 16); r.w = __uint_as_float(w.y & 0xffff0000u); return r; }
__device__ __forceinline__ f32x4 cvt_bf4(uint2 w) { f32x4 r; r.x = __uint_as_float(w.x << 16); r.y = __uint_as_float(w.x & 0xffff0000u); r.z = __uint_as_float(w.y << 16); r.w = __uint_as_float(w.y & 0xffff0000u); return r; }
__device__ __forceinline__ void st_bf4(bf16_t* p, float a, float b, float c, float d) { uint2 r; r.x = pk2(a, b); r.y = pk2(c, d); *(uint2*)p = r; }

__device__ __forceinline__ void rope64(float (&v)[4], int l16, int prow, int pcolp) {
    int d0 = 4 * l16; int pos = d0 < 32 ? prow : pcolp; int dd0 = d0 & 31; bool first = dd0 < 16;
#pragma unroll
    for (int i = 0; i < 4; ++i) {
        float other = xchg4(v[i], l16);
        int fi = (dd0 & 15) + i;
        float inv = exp2f(-(float)fi * (13.287712379549449f / 16.f));
        float s, c; sincos_b((float)pos * inv, s, c);
        v[i] = first ? (v[i] * c - other * s) : (other * s + v[i] * c);
    }
}
__device__ __forceinline__ void rope32(float (&v)[4], int l8, int prow, int pcolp) {
    int rd0 = 4 * l8; int pos = rd0 < 16 ? prow : pcolp; int r16 = rd0 & 15; bool first = r16 < 8;
#pragma unroll
    for (int i = 0; i < 4; ++i) {
        float other = xchg2(v[i]);
        int fi = (r16 & 7) + i;
        float inv = exp2f(-(float)fi * (13.287712379549449f / 8.f));
        float s, c; sincos_b((float)pos * inv, s, c);
        v[i] = first ? (v[i] * c - other * s) : (other * s + v[i] * c);
    }
}
__device__ __forceinline__ void ph_prepA(Frame& F, int l) {
    OPAQUE_TID(F);
    const int gw = F.vcu * 8 + F.wave, NGW = F.G * 8, lane = F.lane, l16 = lane & 15;
    const float* cq_norm = F.in[I_CQN] + l * 256; const float* ckv_norm = F.in[I_CKVN] + l * 128; const float* gq_norm = F.in[I_GQN] + l * 64; const float* gk_norm = F.in[I_GKN] + l * 64;
    uint2 nraw[4];
    { const bf16_t* pr = F_P16B + (size_t)(gw < M ? gw : 0) * 1024 + 4 * lane;
#pragma unroll
      for (int j = 0; j < 4; ++j) nraw[j] = *(const uint2*)(pr + 256 * j); }
    for (int m = gw; m < M; m += NGW) {
        RowInfo ri = rowinfo(m); const bool lat = !ri.isctx; const int prow = ri.t >> 6, pcl = ri.t & 63;
        const f32x4 v0 = cvt_bf4(nraw[0]), v1 = cvt_bf4(nraw[1]), v2 = cvt_bf4(nraw[2]), v3 = cvt_bf4(nraw[3]);
        { const int mn = m + NGW < M ? m + NGW : m; const bf16_t* pr = F_P16B + (size_t)mn * 1024 + 4 * lane;
#pragma unroll
          for (int j = 0; j < 4; ++j) nraw[j] = *(const uint2*)(pr + 256 * j); }
        { float ss = wave_sum(v0.x * v0.x + v0.y * v0.y + v0.z * v0.z + v0.w * v0.w); float rstd = rsqrtf(ss * (1.f / 256.f) + EPS);
          f32x4 g = ((const f32x4*)cq_norm)[lane]; st_bf4(F_CKN + (size_t)m * 384 + 4 * lane, v0.x * rstd * g.x, v0.y * rstd * g.y, v0.z * rstd * g.z, v0.w * rstd * g.w); }
        { float p = lane < 32 ? (v1.x * v1.x + v1.y * v1.y + v1.z * v1.z + v1.w * v1.w) : 0.f; float ss = wave_sum(p); float rstd = rsqrtf(ss * (1.f / 128.f) + EPS);
          if (lane < 32) { f32x4 g = ((const f32x4*)ckv_norm)[lane]; st_bf4(F_CKN + (size_t)m * 384 + 256 + 4 * lane, v1.x * rstd * g.x, v1.y * rstd * g.y, v1.z * rstd * g.z, v1.w * rstd * g.w); } }
#pragma unroll
        for (int part = 0; part < 2; ++part) {
            f32x4 x = part ? v2 : v1; const bool ok = part ? true : lane >= 32; const int hq = part ? 2 + (lane >> 4) : ((lane >> 4) & 1);
            float ss = x.x * x.x + x.y * x.y + x.z * x.z + x.w * x.w;
            ss = sum16(ss);
            float rstd = rsqrtf(ss * (1.f / 64.f) + EPS); f32x4 g = ((const f32x4*)gq_norm)[l16];
            float v[4] = {x.x * rstd * g.x, x.y * rstd * g.y, x.z * rstd * g.z, x.w * rstd * g.w};
            float vr[4] = {v[0], v[1], v[2], v[3]}; rope64(vr, l16, prow, pcl);
            if (lat) { v[0] = vr[0]; v[1] = vr[1]; v[2] = vr[2]; v[3] = vr[3]; }
            constexpr float QSC = 0.125f * 1.4426950408889634f;
            if (ok) st_bf4(F_QC + (((size_t)ri.b * 6 + hq) * TS + ri.sp) * 64 + 4 * l16, v[0] * QSC, v[1] * QSC, v[2] * QSC, v[3] * QSC);
        }
        { const int kvh = (lane & 31) >> 4; const bool isk = lane < 32; f32x4 x = v3;
          float ss = x.x * x.x + x.y * x.y + x.z * x.z + x.w * x.w;
          ss = sum16(ss);
          float rstd = rsqrtf(ss * (1.f / 64.f) + EPS); f32x4 g = ((const f32x4*)gk_norm)[l16];
          float v[4] = {x.x * rstd * g.x, x.y * rstd * g.y, x.z * rstd * g.z, x.w * rstd * g.w};
          float vr[4] = {v[0], v[1], v[2], v[3]}; rope64(vr, l16, prow, pcl);
          if (lat) { v[0] = vr[0]; v[1] = vr[1]; v[2] = vr[2]; v[3] = vr[3]; }
          const size_t off = (((size_t)ri.b * 2 + kvh) * TS + ri.sp) * 64 + 4 * l16;
          if (isk) st_bf4(F_KC + off, v[0], v[1], v[2], v[3]); else st_bf4(F_VC + off, x.x, x.y, x.z, x.w); }
    }
}
__device__ __forceinline__ void ph_prepB(Frame& F, int l) {
    OPAQUE_TID(F);
    const int gw = ((F.vcu + F.G / 2) % F.G) * 8 + F.wave, NGW = F.G * 8, lane = F.lane, l32 = lane & 31, d0 = 4 * l32;
    const float* q_norm = F.in[I_MQN] + l * 96; const float* k_norm = F.in[I_MKN] + l * 96;
    f32x4 nkr; uint2 nq[3], nkv[3];
    { const int m0 = gw < M ? gw : 0; nkr = *(const f32x4*)(F_G32 + (size_t)m0 * 64 + 16 + 4 * (lane & 7));
#pragma unroll
      for (int j = 0; j < 3; ++j) { nq[j] = *(const uint2*)(F_QUP + (size_t)m0 * 768 + 256 * j + 4 * lane); nkv[j] = *(const uint2*)(F_KVUP + (size_t)m0 * 768 + 256 * j + 4 * lane); } }
    for (int m = gw; m < M; m += NGW) {
        RowInfo ri = rowinfo(m); const bool lat = !ri.isctx; const int prow = ri.t >> 6, pcl = ri.t & 63;
        f32x4 kr = nkr; if (lane >= 8) kr = (f32x4){0.f, 0.f, 0.f, 0.f};
        uint2 qraw[3], kvraw[3];
#pragma unroll
        for (int j = 0; j < 3; ++j) { qraw[j] = nq[j]; kvraw[j] = nkv[j]; }
        { const int mn = m + NGW < M ? m + NGW : m; nkr = *(const f32x4*)(F_G32 + (size_t)mn * 64 + 16 + 4 * (lane & 7));
#pragma unroll
          for (int j = 0; j < 3; ++j) { nq[j] = *(const uint2*)(F_QUP + (size_t)mn * 768 + 256 * j + 4 * lane); nkv[j] = *(const uint2*)(F_KVUP + (size_t)mn * 768 + 256 * j + 4 * lane); } }
        float krr[4];
        { f32x4 gk = ((const f32x4*)k_norm)[16 + (lane & 7)]; float kv_[4] = {kr.x * gk.x, kr.y * gk.y, kr.z * gk.z, kr.w * gk.w}; float kvr_[4] = {kv_[0], kv_[1], kv_[2], kv_[3]};
          rope32(kvr_, lane & 7, prow, pcl);
#pragma unroll
          for (int i = 0; i < 4; ++i) krr[i] = lat ? kvr_[i] : kv_[i]; }
        float sskr = kr.x * kr.x + kr.y * kr.y + kr.z * kr.z + kr.w * kr.w; sskr = __int_as_float(__builtin_amdgcn_readfirstlane(__float_as_int(sum16(sskr))));
#pragma unroll
        for (int j = 0; j < 3; ++j) {
            const int h = 2 * j + (lane >> 5);
            { f32x4 xq = cvt_bf4(qraw[j]);
              float x[4] = {xq.x, xq.y, xq.z, xq.w}; if (d0 >= 96) { x[0] = x[1] = x[2] = x[3] = 0.f; }
              float ss = x[0] * x[0] + x[1] * x[1] + x[2] * x[2] + x[3] * x[3];
              ss = sum32(ss);
              float rstd = rsqrtf(ss * (1.f / 96.f) + EPS);
              f32x4 g = {0.f, 0.f, 0.f, 0.f}; if (d0 < 96) g = ((const f32x4*)q_norm)[l32];
              float v[4] = {x[0] * rstd * g.x, x[1] * rstd * g.y, x[2] * rstd * g.z, x[3] * rstd * g.w};
              float vr[4] = {v[0], v[1], v[2], v[3]};
              rope32(vr, (l32 - 16) & 7, prow, pcl);
              if (lat && l32 >= 16 && l32 < 24) { v[0] = vr[0]; v[1] = vr[1]; v[2] = vr[2]; v[3] = vr[3]; }
              constexpr float QSB = 0.10206207261596575f * 1.4426950408889634f;
              if (d0 < 96) st_bf4(F_QB + (((size_t)ri.b * 6 + h) * TS + ri.sp) * 96 + d0, v[0] * QSB, v[1] * QSB, v[2] * QSB, v[3] * QSB); }
            { f32x4 xk = cvt_bf4(kvraw[j]);
              float x[4] = {xk.x, xk.y, xk.z, xk.w};
              float ss = d0 < 64 ? (x[0] * x[0] + x[1] * x[1] + x[2] * x[2] + x[3] * x[3]) : 0.f;
              ss = sum32(ss);
              float rstd = rsqrtf((ss + sskr) * (1.f / 96.f) + EPS);
              const size_t kbase = (((size_t)ri.b * 6 + h) * TS + ri.sp) * 96;
              if (d0 < 64) { f32x4 g = ((const f32x4*)k_norm)[l32]; st_bf4(F_KB + kbase + d0, x[0] * rstd * g.x, x[1] * rstd * g.y, x[2] * rstd * g.z, x[3] * rstd * g.w); }
              else { *(uint2*)(F_VB + (((size_t)ri.b * 6 + h) * TS + ri.sp) * 64 + (d0 - 64)) = kvraw[j]; }
#pragma unroll
              for (int hh = 0; hh < 2; ++hh) {
                  const float rs = __int_as_float(hh ? __builtin_amdgcn_readlane(__float_as_int(rstd), 32) : __builtin_amdgcn_readlane(__float_as_int(rstd), 0));
                  if (lane < 8) st_bf4(F_KB + (((size_t)ri.b * 6 + 2 * j + hh) * TS + ri.sp) * 96 + 64 + 4 * lane, krr[0] * rs, krr[1] * rs, krr[2] * rs, krr[3] * rs);
              } }
        }
    }
}
using pg8::Unit;
__device__ __forceinline__ float swg(float g, float u) { return (g * u) * __builtin_amdgcn_rcpf(1.f + __builtin_amdgcn_exp2f(-g)); }
struct EpiSwiglu { static constexpr bool PERM = true, AFTER_DRAIN = false; bf16_t* hid;
    __device__ __forceinline__ void operator()(const pg8::f32x4 (&acc)[2][2][4][2], const Unit& u, int wr, int wc, int fr_, int fq_) const {
        int fr = fr_, fq = fq_; asm volatile("" : "+v"(fr), "+v"(fq));
#ifdef PROBE_EPI2
        for (int rep_ = 0; rep_ < 2; ++rep_) { asm volatile("" ::: "memory");
#endif
        const int row0 = u.pm * 256 + wr * 64 + fr, hc = u.pn * 128 + wc * 32 + 8 * fq;
#pragma unroll
        for (int ai = 0; ai < 2; ++ai)
#pragma unroll
            for (int m = 0; m < 4; ++m) { const pg8::f32x4 g0 = acc[ai][0][m][0], g1 = acc[ai][0][m][1], u0 = acc[ai][1][m][0], u1 = acc[ai][1][m][1];
                u32x4 w; w.x = pg8::cvt_pk_bf16(swg(g0[0], u0[0]), swg(g0[1], u0[1])); w.y = pg8::cvt_pk_bf16(swg(g0[2], u0[2]), swg(g0[3], u0[3]));
                w.z = pg8::cvt_pk_bf16(swg(g1[0], u1[0]), swg(g1[1], u1[1])); w.w = pg8::cvt_pk_bf16(swg(g1[2], u1[2]), swg(g1[3], u1[3]));
                *(u32x4*)(hid + (size_t)(row0 + ai * 128 + m * 16) * DFF + hc) = w; }
#ifdef PROBE_EPI2
        }
#endif
    }
};
struct EpiResid { static constexpr bool PERM = false, AFTER_DRAIN = false; const float* baseL; float* outL; float* slab; const float* modl  ; int gate; float coef;
    __device__ __forceinline__ void operator()(const pg8::f32x4 (&acc)[2][2][4][2], const Unit& u, int wr, int wc, int fr_, int fq_) const {
        int fr = fr_, fq = fq_; asm volatile("" : "+v"(fr), "+v"(fq));
        const int col0 = u.pn * 256 + wc * 32 + 4 * fq;
        if (u.pm >= ML / 256) {
            float* sp = slab + ((size_t)(u.kt0 / u.nt) * MC + (u.pm * 256 - ML) + wr * 64 + fr) * D + col0;
#pragma unroll
            for (int ai = 0; ai < 2; ++ai)
#pragma unroll
                for (int m = 0; m < 4; ++m)
#pragma unroll
                    for (int bj = 0; bj < 2; ++bj)
#pragma unroll
                        for (int n = 0; n < 2; ++n) *(pg8::f32x4*)(sp + (size_t)(ai * 128 + m * 16) * D + bj * 128 + n * 16) = acc[ai][bj][m][n];
            return;
        }
        const int s = u.pm / (T / 256); const int rb = u.pm * 256 + wr * 64 + fr;
        const float* gp = modl + ((size_t)s * 9 + gate) * D;
        pg8::f32x4 gv[2][2];
#pragma unroll
        for (int bj = 0; bj < 2; ++bj)
#pragma unroll
            for (int n = 0; n < 2; ++n) gv[bj][n] = *(const pg8::f32x4*)(gp + col0 + bj * 128 + n * 16) * coef;
#ifdef PROBE_EPIR2
#pragma unroll 1
        for (int rep_ = 0; rep_ < 2; ++rep_) { asm volatile("" ::: "memory"); const float cz = rep_ ? 1.f : 0.f; const float* baseL = rep_ ? this->outL : this->baseL;
#pragma unroll
        for (int ai = 0; ai < 2; ++ai)
#pragma unroll
            for (int m = 0; m < 4; ++m) { const size_t off = (size_t)(rb + ai * 128 + m * 16) * D + col0;
#pragma unroll
                for (int bj = 0; bj < 2; ++bj)
#pragma unroll
                    for (int n = 0; n < 2; ++n) { const pg8::f32x4 bs = *(const pg8::f32x4*)(baseL + off + bj * 128 + n * 16); *(pg8::f32x4*)(outL + off + bj * 128 + n * 16) = bs + gv[bj][n] * cz * acc[ai][bj][m][n]; }
                if (m & 1) asm volatile("" ::: "memory"); }
        }
        return;
#endif
#pragma unroll
        for (int ai = 0; ai < 2; ++ai)
#pragma unroll
            for (int m = 0; m < 4; ++m) { const size_t off = (size_t)(rb + ai * 128 + m * 16) * D + col0;
#pragma unroll
                for (int bj = 0; bj < 2; ++bj)
#pragma unroll
                    for (int n = 0; n < 2; ++n) {
#if defined(RESID_NT)
                        const pg8::f32x4 bs = __builtin_nontemporal_load((const pg8::f32x4*)(baseL + off + bj * 128 + n * 16)); __builtin_nontemporal_store(bs + gv[bj][n] * acc[ai][bj][m][n], (pg8::f32x4*)(outL + off + bj * 128 + n * 16));
#elif defined(RESID_NTL)
                        const pg8::f32x4 bs = __builtin_nontemporal_load((const pg8::f32x4*)(baseL + off + bj * 128 + n * 16)); *(pg8::f32x4*)(outL + off + bj * 128 + n * 16) = bs + gv[bj][n] * acc[ai][bj][m][n];
#else
                        const pg8::f32x4 bs = *(const pg8::f32x4*)(baseL + off + bj * 128 + n * 16); *(pg8::f32x4*)(outL + off + bj * 128 + n * 16) = bs + gv[bj][n] * acc[ai][bj][m][n];
#endif
                    }
                if (m & 1) asm volatile("" ::: "memory"); }
    }
};
__device__ __forceinline__ u32x4 pack8(const pg8::f32x4& a, const pg8::f32x4& b) { u32x4 w; w.x = pg8::cvt_pk_bf16(a[0], a[1]); w.y = pg8::cvt_pk_bf16(a[2], a[3]); w.z = pg8::cvt_pk_bf16(b[0], b[1]); w.w = pg8::cvt_pk_bf16(b[2], b[3]); return w; }
struct EpiInproj { static constexpr bool PERM = true, AFTER_DRAIN = false; bf16_t* pa; float* g32; bf16_t* pb;
    __device__ __forceinline__ void operator()(const pg8::f32x4 (&acc)[2][2][4][2], const Unit& u, int wr, int wc, int fr_, int fq_) const {
        int fr = fr_, fq = fq_; asm volatile("" : "+v"(fr), "+v"(fq));
        const int row0 = u.pm * 256 + wr * 64 + fr, c0 = wc * 32 + 8 * fq;
        if (u.pn == 3) {
            if (wc < 2) {
#pragma unroll
                for (int ai = 0; ai < 2; ++ai)
#pragma unroll
                    for (int m = 0; m < 4; ++m) { float* p = g32 + (size_t)(row0 + ai * 128 + m * 16) * 64 + c0; *(pg8::f32x4*)p = acc[ai][0][m][0]; *(pg8::f32x4*)(p + 4) = acc[ai][0][m][1]; }
            }
            return;
        }
        bf16_t* dst = u.pn < 3 ? pa + (size_t)row0 * 768 + u.pn * 256 + c0 : pb + (size_t)row0 * 1024 + (u.pn - 4) * 256 + c0; const size_t ld = u.pn < 3 ? 768 : 1024;
#pragma unroll
        for (int ai = 0; ai < 2; ++ai)
#pragma unroll
            for (int m = 0; m < 4; ++m)
#pragma unroll
                for (int bj = 0; bj < 2; ++bj) *(u32x4*)(dst + (size_t)(ai * 128 + m * 16) * ld + bj * 128) = pack8(acc[ai][bj][m][0], acc[ai][bj][m][1]);
    }
};
struct EpiUp { static constexpr bool PERM = true, AFTER_DRAIN = false; bf16_t* qup; bf16_t* kvup;
    __device__ __forceinline__ void operator()(const pg8::f32x4 (&acc)[2][2][4][2], const Unit& u, int wr, int wc, int fr_, int fq_) const {
        int fr = fr_, fq = fq_; asm volatile("" : "+v"(fr), "+v"(fq));
        const int row0 = u.pm * 256 + wr * 64 + fr, c0 = wc * 32 + 8 * fq;
        bf16_t* dst = (u.pn < 3 ? qup + u.pn * 256 : kvup + (u.pn - 3) * 256) + (size_t)row0 * 768 + c0;
#pragma unroll
        for (int ai = 0; ai < 2; ++ai)
#pragma unroll
            for (int m = 0; m < 4; ++m)
#pragma unroll
                for (int bj = 0; bj < 2; ++bj) *(u32x4*)(dst + (size_t)(ai * 128 + m * 16) * 768 + bj * 128) = pack8(acc[ai][bj][m][0], acc[ai][bj][m][1]);
    }
};

constexpr int LOCW = 2112, NCS = 68;
#define F_LOC ((float*)(F.ws + WS_LOC))
__device__ __forceinline__ int mls_cs(int isctx, int j, int dir) { return isctx ? (dir ? 3 - j : j) : 4 + (dir ? 63 - j : j); }
template <int NE>
__device__ __forceinline__ void ph_mlstm_m2(Frame& F, int widx, int nw) {
    OPAQUE_TID(F);
    constexpr int TPS = (2080 + NE - 1) / NE;
    const int g = widx * 512 + F.tid; if (g >= 32 * TPS) return;
    const int seq = g / TPS, r = g % TPS;
    float* base = F_LOC + (size_t)seq * NCS * LOCW + r;
    bool ok[NE]; float val[NE]; float m = 0.f;
#pragma unroll
    for (int j = 0; j < NE; ++j) { ok[j] = r + j * TPS < 2080; val[j] = 0.f; }
#pragma unroll 1
    for (int c0 = 0; c0 < NCS; c0 += 17) {
        float bl[17], ml[17], x[NE][17];
#pragma unroll
        for (int i = 0; i < 17; ++i) { const float* p = base + (size_t)(c0 + i) * LOCW; bl[i] = p[2080 - r]; ml[i] = p[2081 - r];
#pragma unroll
            for (int j = 0; j < NE; ++j) x[j][i] = p[ok[j] ? j * TPS : 0]; }
#pragma unroll
        for (int i = 0; i < 17; ++i) { float* p = base + (size_t)(c0 + i) * LOCW;
#pragma unroll
            for (int j = 0; j < NE; ++j) if (ok[j]) p[j * TPS] = val[j];
            if (r == 0) p[2082] = m;
            const float mn = fmaxf(bl[i] + m, ml[i]); const float a = __expf(bl[i] + m - mn), b = __expf(ml[i] - mn);
#pragma unroll
            for (int j = 0; j < NE; ++j) val[j] = a * val[j] + b * x[j][i];
            m = mn; }
    }
}

typedef short bf16x8 __attribute__((ext_vector_type(8)));
typedef short v4i16_t __attribute__((ext_vector_type(4)));
typedef float f32x16 __attribute__((ext_vector_type(16)));
#define MFMA32(a, b, c) __builtin_amdgcn_mfma_f32_32x32x16_bf16((a), (b), (c), 0, 0, 0)
__device__ __forceinline__ int crow(int r, int h) { return (r & 3) + 8 * (r >> 2) + 4 * h; }
__device__ __forceinline__ unsigned cvtpk(float lo, float hi) { typedef float f2_t __attribute__((ext_vector_type(2))); typedef __bf16 b2_t __attribute__((ext_vector_type(2))); f2_t v = {lo, hi}; b2_t b = __builtin_convertvector(v, b2_t); return __builtin_bit_cast(unsigned, b); }
__device__ __forceinline__ v4i16_t vtr(const LAS unsigned char* p) { return __builtin_amdgcn_ds_read_tr16_b64_v4i16((LAS v4i16_t*)p); }
__device__ __forceinline__ float max3f(float a, float b, float c) { float r; asm("v_max3_f32 %0, %1, %2, %3" : "=v"(r) : "v"(a), "v"(b), "v"(c)); return r; }
#ifdef PROBE_MLA2X
constexpr int MLA_NP = 2 * (TS / 128), MLA_WRAP = TS / 128;
#else
constexpr int MLA_NP = TS / 128, MLA_WRAP = 1 << 20;
#endif
constexpr float ATT_THR = 6.0f;

template <int DQK, bool BAND, bool SINK>
__device__ __forceinline__ void attn_unit256(Frame& F, const bf16_t* Qrows, const bf16_t* Kseq, const bf16_t* Vseq, int npairs, int qpos0, float sink2, bf16_t* Yout) {
    constexpr int NCH = DQK / 8, KSTR = DQK * 2 + 16, KST = 128 * KSTR, STAGE = KST + 16384, NKI = (128 * NCH) / 512, NKS = DQK / 16;
    static_assert((128 * NCH) % 512 == 0 && 2 * STAGE <= RING_BYTES, "attention staging / LDS");
    int tid_ = F.tid; asm volatile("" : "+v"(tid_));
    const int tid = tid_, lane = tid_ & 63, wave = F.wave, r32 = lane & 31, h = lane >> 5;
    LAS unsigned char* L = F.lds;
    bf16x8 qf[NKS];
#pragma unroll
    for (int ks = 0; ks < NKS; ++ks) qf[ks] = *(const bf16x8*)(Qrows + (size_t)(32 * wave + r32) * DQK + 16 * ks + 8 * h);
    const f32x16 z16 = {0.f, 0.f, 0.f, 0.f, 0.f, 0.f, 0.f, 0.f, 0.f, 0.f, 0.f, 0.f, 0.f, 0.f, 0.f, 0.f};
    f32x16 o0 = z16, o1 = z16;
    float l_run = (SINK && h == 0) ? __builtin_amdgcn_exp2f(sink2) : 0.f;
    u32x4 kreg[NKI], vreg[2];
#define ATT_SEQ0(p) ((BAND && (p) >= 2) ? (TC + qpos0 - 128 + 128 * ((p) - 2)) : 128 * ((p) % MLA_WRAP))
#define ATT_LOAD(p) do { const int seq0_ = ATT_SEQ0(p); \
        _Pragma("unroll") for (int i_ = 0; i_ < NKI; ++i_) { const int cid = tid + 512 * i_; const int key = cid / NCH, ch = cid % NCH; int sr = seq0_ + key; sr = sr < 0 ? 0 : (sr > TS - 1 ? TS - 1 : sr); \
            kreg[i_] = *(const u32x4*)(Kseq + (size_t)sr * DQK + ch * 8); } \
        _Pragma("unroll") for (int i_ = 0; i_ < 2; ++i_) { const int cid = tid + 512 * i_; const int key = cid >> 3, ch = cid & 7; int sr = seq0_ + key; sr = sr < 0 ? 0 : (sr > TS - 1 ? TS - 1 : sr); \
            vreg[i_] = *(const u32x4*)(Vseq + (size_t)sr * 64 + ch * 8); } } while (0)
#define ATT_STORE(st) do { LAS unsigned char* sb_ = L + (st) * STAGE; \
        _Pragma("unroll") for (int i_ = 0; i_ < NKI; ++i_) { const int cid = tid + 512 * i_; const int key = cid / NCH, ch = cid % NCH; *(LAS u32x4*)(sb_ + key * KSTR + ch * 16) = kreg[i_]; } \
        _Pragma("unroll") for (int i_ = 0; i_ < 2; ++i_) { const int cid = tid + 512 * i_; const int key = cid >> 3, ch = cid & 7; \
            *(LAS u32x4*)(sb_ + KST + (key >> 6) * 8192 + (ch >> 2) * 4096 + (key & 63) * 64 + (ch & 3) * 16) = vreg[i_]; } } while (0)
    ATT_LOAD(0); ATT_STORE(0); if (npairs > 1) ATT_LOAD(1);
    __syncthreads();
    const int trcol = ((lane >> 4) & 1) * 32 + (lane & 3) * 8, q4 = (lane & 15) >> 2;
    const int qpos = qpos0 + 32 * wave + r32;
    if (wave >= 4) __builtin_amdgcn_s_setprio(1);
#pragma unroll 1
    for (int p = 0; p < npairs; ++p) {
        const int st = p & 1;
        bool need = true;
        if (BAND && p >= 2) { const int k0 = qpos0 - 128 + 128 * (p - 2); const int r0 = qpos0 + 32 * wave; need = (k0 <= r0 + 31 + 128) && (k0 + 127 >= r0 - 128) && (k0 + 127 >= 0) && (k0 < T); }
        if (need) {
#ifdef ATT_ROT
            const int boff = (wave >> 2) * 2;
#else
            const int boff = 0;
#endif
            const LAS unsigned char* Kt = L + st * STAGE + r32 * KSTR + 16 * h;
            const LAS unsigned char* Vb = L + st * STAGE + KST + (4 * h + q4) * 64 + trcol;
            f32x16 sa, sb;
            bf16x8 kf[NKS];
#pragma unroll
            for (int ks = 0; ks < NKS; ++ks) kf[ks] = *(const LAS bf16x8*)(Kt + (32 * boff) * KSTR + 32 * ks);
            __builtin_amdgcn_sched_barrier(0);
            sa = MFMA32(kf[0], qf[0], z16);
#pragma unroll
            for (int ks = 1; ks < NKS; ++ks) sa = MFMA32(kf[ks], qf[ks], sa);
            float rs = 0.f;
#pragma unroll
            for (int blk = 0; blk < 4; ++blk) {
                const int bb = (blk + boff) & 3, bn = (blk + 1 + boff) & 3;
                const LAS unsigned char* vp = Vb + (bb >> 1) * 8192 + (32 * (bb & 1)) * 64;
                v4i16_t vl[2][2], vh[2][2];
#pragma unroll
                for (int s = 0; s < 2; ++s) { vl[0][s] = vtr(vp + (16 * s) * 64); vh[0][s] = vtr(vp + (16 * s + 8) * 64); vl[1][s] = vtr(vp + 4096 + (16 * s) * 64); vh[1][s] = vtr(vp + 4096 + (16 * s + 8) * 64); }
                if (blk < 3) {
#pragma unroll
                    for (int ks = 0; ks < NKS; ++ks) kf[ks] = *(const LAS bf16x8*)(Kt + (32 * bn) * KSTR + 32 * ks);
                }
#ifdef PROBE_LDS2
                { bf16x8 dk[NKS];
#pragma unroll
                  for (int ks = 0; ks < NKS; ++ks) { dk[ks] = *(const LAS bf16x8*)(Kt + (32 * bb) * KSTR + 32 * ks); asm volatile("" :: "v"(dk[ks])); } }
#endif
                __builtin_amdgcn_sched_barrier(0);
                if (BAND && p >= 2) {
                    const int kb0 = qpos0 - 128 + 128 * (p - 2) + 32 * bb;
#pragma unroll
                    for (int i = 0; i < 16; ++i) { const int kp = kb0 + crow(i, h); const int d0 = qpos - kp; if (!(kp >= 0 && kp < T && d0 <= 128 && d0 >= -128)) sa[i] = -INFINITY; }
                }
#pragma unroll
                for (int ks = 0; ks < NKS; ++ks) {
                    if (blk < 3) sb = MFMA32(kf[ks], qf[ks], ks == 0 ? z16 : sb);
#ifndef ATT_NOPIN
                    __builtin_amdgcn_sched_barrier(0);
#endif
#pragma unroll
                    for (int i = (16 * ks) / NKS; i < (16 * (ks + 1)) / NKS; ++i) { sa[i] = __builtin_amdgcn_exp2f(sa[i]); rs += sa[i]; }
#ifndef ATT_NOPIN
                    __builtin_amdgcn_sched_barrier(0);
#else
                    __builtin_amdgcn_sched_group_barrier(0x8, 1, 0); __builtin_amdgcn_sched_group_barrier(0x2, 6, 0);
#endif
                }
                bf16x8 pf[2];
#pragma unroll
                for (int s = 0; s < 2; ++s) { u32x4 a = {cvtpk(sa[8 * s], sa[8 * s + 1]), cvtpk(sa[8 * s + 2], sa[8 * s + 3]), cvtpk(sa[8 * s + 4], sa[8 * s + 5]), cvtpk(sa[8 * s + 6], sa[8 * s + 7])}; pf[s] = __builtin_bit_cast(bf16x8, a); }
                __builtin_amdgcn_sched_barrier(0);
#pragma unroll
                for (int s = 0; s < 2; ++s) {
                    const v4i16_t lo0 = vl[0][s], hi0 = vh[0][s], lo1 = vl[1][s], hi1 = vh[1][s];
                    const bf16x8 va0 = {lo0[0], lo0[1], lo0[2], lo0[3], hi0[0], hi0[1], hi0[2], hi0[3]}; const bf16x8 va1 = {lo1[0], lo1[1], lo1[2], lo1[3], hi1[0], hi1[1], hi1[2], hi1[3]};
                    o0 = MFMA32(va0, pf[s], o0); o1 = MFMA32(va1, pf[s], o1);
                }
                if (blk < 3) sa = sb;
            }
            l_run += rs;
        }
        if (p + 1 < npairs) ATT_STORE(st ^ 1);
        if (p + 2 < npairs) ATT_LOAD(p + 2);
        __syncthreads();
    }
#undef ATT_SEQ0
#undef ATT_LOAD
#undef ATT_STORE
    if (wave >= 4) __builtin_amdgcn_s_setprio(0);
    {
        const float inv = 1.f / xor32_sum(l_run);
        LAS unsigned char* osc = L + wave * (32 * 144) + r32 * 144;
#pragma unroll
        for (int i = 0; i < 16; i += 2) { *(LAS unsigned*)(osc + crow(i, h) * 2) = cvtpk(o0[i] * inv, o0[i + 1] * inv); *(LAS unsigned*)(osc + (32 + crow(i, h)) * 2) = cvtpk(o1[i] * inv, o1[i + 1] * inv); }
        LDS_WAIT();
        const LAS unsigned char* osr = L + wave * (32 * 144);
#pragma unroll
        for (int i = 0; i < 4; ++i) { const int row = i * 8 + (lane >> 3), ch = lane & 7; const u32x4 v = *(const LAS u32x4*)(osr + row * 144 + ch * 16);
            *(u32x4*)(Yout + (size_t)(32 * wave + row) * D + ch * 8) = v; }
    }
    __syncthreads();
}

__device__ __forceinline__ void mlstm_m1_mfma(Frame& F, int l, int item0) {
    constexpr int KT = 0, VT = 4096, SW = 12288, SST = 12800, HALFB = 16384;
    int tid_ = F.tid; asm volatile("" : "+v"(tid_)); const int tid = tid_, lane = tid & 63, wave = F.wave, hh = lane >> 5;
    const int half = wave >> 2, hw = wave & 3, htid = tid & 255;
    LAS unsigned char* L = F.lds + half * HALFB;
    const int itemr = item0 + half; const bool valid = itemr < 1024 + 64; const int item = valid ? itemr : item0;
    int isctx, b, h, j;
    if (item < 1024) { isctx = 0; b = item >> 8; h = (item >> 6) & 3; j = item & 63; } else { const int r = item - 1024; isctx = 1; b = r >> 4; h = (r >> 2) & 3; j = r & 3; }
    const int rbase = (isctx ? ML + b * TC : b * T) + 64 * j;
    const float* gate_b = F.in[I_GATEB] + l * 16;
    { const int tok = htid >> 2, ch = htid & 3; *(LAS u32x4*)(L + KT + tok * 64 + ch * 16) = *(const u32x4*)(F_P16A + (size_t)(rbase + tok) * 768 + 128 + h * 32 + ch * 8); }
#pragma unroll
    for (int i = 0; i < 2; ++i) { const int cid = htid + 256 * i, tok = cid >> 3, ch = cid & 7; *(LAS u32x4*)(L + VT + (ch >> 2) * 4096 + tok * 64 + (ch & 3) * 16) = *(const u32x4*)(F_P16A + (size_t)(rbase + tok) * 768 + 256 + h * 64 + ch * 8); }
    if (hw < 2) {
        const int dir = hw, p = lane, tok = dir ? 63 - p : p; const int gi = dir ? 2 : 0;
        const float* pr = F_G32 + (size_t)(rbase + tok) * 64; const float ig = pr[gi * 4 + h] + gate_b[gi * 4 + h]; const float lf = logsigmoidf_(pr[(gi + 1) * 4 + h] + gate_b[(gi + 1) * 4 + h]);
        const float v = scan_sum64(lf); const float blast = lane_bcast(v, 63); const float g = blast - v + ig; const float gm = lane_bcast(scan_max64(g), 63);
        ((LAS float*)(L + SW))[dir * 64 + tok] = __expf(g - gm);
        if (p == 0) { ((LAS float*)(L + SST))[2 * dir] = blast; ((LAS float*)(L + SST))[2 * dir + 1] = gm; }
    }
    __syncthreads();
    {
        const int dir = hw >> 1, eb = hw & 1;
        const int trcol = ((lane >> 4) & 1) * 32 + (lane & 3) * 8, q4 = (lane & 15) >> 2;
        const LAS float* wp = (const LAS float*)(L + SW) + dir * 64;
        const f32x16 z16 = {0.f, 0.f, 0.f, 0.f, 0.f, 0.f, 0.f, 0.f, 0.f, 0.f, 0.f, 0.f, 0.f, 0.f, 0.f, 0.f};
        f32x16 acc = z16, accn = z16;
        const bf16x8 ones = {0x3f80, 0x3f80, 0x3f80, 0x3f80, 0x3f80, 0x3f80, 0x3f80, 0x3f80};
#pragma unroll
        for (int ks = 0; ks < 4; ++ks) {
            const int s0 = 16 * ks + 8 * hh;
            const v4i16_t klo = vtr(L + KT + (s0 + q4) * 64 + trcol), khi = vtr(L + KT + (s0 + 4 + q4) * 64 + trcol);
            const v4i16_t vlo = vtr(L + VT + eb * 4096 + (s0 + q4) * 64 + trcol), vhi = vtr(L + VT + eb * 4096 + (s0 + 4 + q4) * 64 + trcol);
            const f32x4 w0 = *(const LAS f32x4*)(wp + s0), w1 = *(const LAS f32x4*)(wp + s0 + 4);
            u32x4 aw; aw.x = cvtpk(bf2f((bf16_t)klo[0]) * w0[0], bf2f((bf16_t)klo[1]) * w0[1]); aw.y = cvtpk(bf2f((bf16_t)klo[2]) * w0[2], bf2f((bf16_t)klo[3]) * w0[3]);
            aw.z = cvtpk(bf2f((bf16_t)khi[0]) * w1[0], bf2f((bf16_t)khi[1]) * w1[1]); aw.w = cvtpk(bf2f((bf16_t)khi[2]) * w1[2], bf2f((bf16_t)khi[3]) * w1[3]);
            const bf16x8 af = __builtin_bit_cast(bf16x8, aw); const bf16x8 vf = {vlo[0], vlo[1], vlo[2], vlo[3], vhi[0], vhi[1], vhi[2], vhi[3]};
            acc = MFMA32(af, vf, acc);
            if (eb == 0) accn = MFMA32(af, ones, accn);
        }
        float* Lp = F_LOC + ((size_t)((b * 4 + h) * 2 + dir) * NCS + mls_cs(isctx, j, dir)) * LOCW;
        const int e = 32 * eb + (lane & 31);
        if (valid) {
#pragma unroll
            for (int i = 0; i < 16; ++i) Lp[crow(i, hh) * 64 + e] = acc[i];
            if (eb == 0) {
                if ((lane & 31) == 0) {
#pragma unroll
                    for (int i = 0; i < 16; ++i) Lp[2048 + crow(i, hh)] = accn[i];
                }
                if (lane == 0) { Lp[2080] = ((LAS float*)(L + SST))[2 * dir]; Lp[2081] = ((LAS float*)(L + SST))[2 * dir + 1]; }
            }
        }
    }
    __syncthreads();
}
__device__ __forceinline__ void ph_mlstm_m1b(Frame& F, int l) { for (int it = 2 * F.vcu; it < 1024 + 64; it += 2 * F.G) mlstm_m1_mfma(F, l, it); }

__device__ __forceinline__ void mlstm_m3_mfma(Frame& F, int l, int item0) {
    constexpr int KT = 0, VT = 5120, CT = 13312, SN = 23552, SU = 23808, SM = 24320, SB = 24832, SMST = 25344, HB = 25600, HALFB = 45056;
    constexpr float QS = 0.17677669529663687f;
    int tid_ = F.tid; asm volatile("" : "+v"(tid_)); const int tid = tid_, lane = tid & 63, wave = F.wave, r32 = lane & 31, hh = lane >> 5;
    const int half = wave >> 2, hw = wave & 3, htid = tid & 255, tb = hw >> 1, eb = hw & 1;
    LAS unsigned char* L = F.lds + half * HALFB;
    const int item = item0 + half;
    int isctx, b, h, j;
    if (item < 1024) { isctx = 0; b = item >> 8; h = (item >> 6) & 3; j = item & 63; } else { const int r = item - 1024; isctx = 1; b = r >> 4; h = (r >> 2) & 3; j = r & 3; }
    const int rbase = (isctx ? ML + b * TC : b * T) + 64 * j;
    const float* gate_b = F.in[I_GATEB] + l * 16;
    const float* stf = F_LOC + ((size_t)((b * 4 + h) * 2) * NCS + mls_cs(isctx, j, 0)) * LOCW; const float* stb = F_LOC + ((size_t)((b * 4 + h) * 2 + 1) * NCS + mls_cs(isctx, j, 1)) * LOCW;
    bf16x8 qf[2][2];
#pragma unroll
    for (int dir = 0; dir < 2; ++dir) { const int tposq = 32 * (dir ? 1 - tb : tb) + r32; const int ttokq = dir ? 63 - tposq : tposq;
#pragma unroll
        for (int ks = 0; ks < 2; ++ks) qf[dir][ks] = *(const bf16x8*)(F_P16A + (size_t)(rbase + ttokq) * 768 + h * 32 + 16 * ks + 8 * hh); }
    { const int tok = htid >> 2, ch = htid & 3; *(LAS u32x4*)(L + KT + tok * 80 + ch * 16) = *(const u32x4*)(F_P16A + (size_t)(rbase + tok) * 768 + 128 + h * 32 + ch * 8); }
#pragma unroll
    for (int i = 0; i < 2; ++i) { const int cid = htid + 256 * i, tok = cid >> 3, ch = cid & 7; *(LAS u32x4*)(L + VT + (ch >> 2) * 4096 + tok * 64 + (ch & 3) * 16) = *(const u32x4*)(F_P16A + (size_t)(rbase + tok) * 768 + 256 + h * 64 + ch * 8); }
#pragma unroll
    for (int dir = 0; dir < 2; ++dir) { const float* st = dir ? stb : stf;
#pragma unroll
        for (int i = 0; i < 2; ++i) { const int idx = htid + 256 * i, d = idx >> 4, e0 = (idx & 15) * 4; const f32x4 c = *(const f32x4*)(st + d * 64 + e0);
            LAS unsigned char* cp = L + CT + dir * 5120 + e0 * 80 + d * 2;
            *(LAS bf16_t*)(cp) = f2bf(c.x); *(LAS bf16_t*)(cp + 80) = f2bf(c.y); *(LAS bf16_t*)(cp + 160) = f2bf(c.z); *(LAS bf16_t*)(cp + 240) = f2bf(c.w); } }
    if (htid < 64) { const int dir = htid >> 5, d = htid & 31; ((LAS float*)(L + SN))[dir * 32 + d] = (dir ? stb : stf)[2048 + d]; }
    if (hw < 2) { const int dir = hw, p = lane, tok = dir ? 63 - p : p; const int gi = dir ? 2 : 0;
        const float* pr = F_G32 + (size_t)(rbase + tok) * 64; const float ig = pr[gi * 4 + h] + gate_b[gi * 4 + h]; const float lf = logsigmoidf_(pr[(gi + 1) * 4 + h] + gate_b[(gi + 1) * 4 + h]);
        const float v = scan_sum64(lf);
        const float u0 = ig - v; const float cm = scan_max64(u0);
        const float m = (dir ? stb : stf)[2082];
        ((LAS float*)(L + SU))[dir * 64 + p] = u0; ((LAS float*)(L + SM))[dir * 64 + p] = fmaxf(m, cm); ((LAS float*)(L + SB))[dir * 64 + p] = v;
        if (p == 0) ((LAS float*)(L + SMST))[dir] = m; }
    const u32x4 og0 = *(const u32x4*)(F_P16A + (size_t)(rbase + (htid >> 2)) * 768 + 512 + h * 64 + (htid & 3) * 16), og1 = *(const u32x4*)(F_P16A + (size_t)(rbase + (htid >> 2)) * 768 + 512 + h * 64 + (htid & 3) * 16 + 8);
    __syncthreads();
    const int trcol = ((lane >> 4) & 1) * 32 + (lane & 3) * 8, q4 = (lane & 15) >> 2;
#pragma unroll
    for (int dir = 0; dir < 2; ++dir) {
        const int tbd = dir ? 1 - tb : tb; const int tpos = 32 * tbd + r32; const int ttok = dir ? 63 - tpos : tpos;
        const float Mt = ((LAS float*)(L + SM))[dir * 64 + tpos], bt = ((LAS float*)(L + SB))[dir * 64 + tpos], mst = ((LAS float*)(L + SMST))[dir];
        float nq = 0.f;
#pragma unroll
        for (int ks = 0; ks < 2; ++ks) { const LAS float* np = (LAS float*)(L + SN) + dir * 32 + 16 * ks + 8 * hh;
#pragma unroll
            for (int jj = 0; jj < 8; ++jj) nq += bf2f((bf16_t)qf[dir][ks][jj]) * np[jj]; }
        nq = xor32_sum(nq);
        const float at = __expf(mst - Mt) * QS;
        f32x16 o;
#pragma unroll
        for (int i = 0; i < 16; ++i) o[i] = 0.f;
#pragma unroll
        for (int ks = 0; ks < 2; ++ks) { const bf16x8 cf = *(const LAS bf16x8*)(L + CT + dir * 5120 + (32 * eb + r32) * 80 + (16 * ks + 8 * hh) * 2); o = MFMA32(cf, qf[dir][ks], o); }
#pragma unroll
        for (int i = 0; i < 16; ++i) o[i] *= at;
        float rs = 0.f;
#pragma unroll
        for (int sb = 0; sb < 2; ++sb) {
            if (sb <= tbd) {
                const int srow = 32 * sb + r32; const int stok = dir ? 63 - srow : srow;
                f32x16 s;
#pragma unroll
                for (int i = 0; i < 16; ++i) s[i] = 0.f;
#pragma unroll
                for (int ks = 0; ks < 2; ++ks) { const bf16x8 kf = *(const LAS bf16x8*)(L + KT + stok * 80 + (16 * ks + 8 * hh) * 2); s = MFMA32(kf, qf[dir][ks], s); }
#pragma unroll
                for (int g = 0; g < 4; ++g) { const f32x4 uv = *(const LAS f32x4*)((LAS float*)(L + SU) + dir * 64 + 32 * sb + 8 * g + 4 * hh);
#pragma unroll
                    for (int c = 0; c < 4; ++c) { const int spos = 32 * sb + 8 * g + 4 * hh + c; const float w = spos <= tpos ? __expf(uv[c] - Mt) * QS : 0.f; const float sw = s[4 * g + c] * w; s[4 * g + c] = sw; rs += sw; } }
#pragma unroll
                for (int s2 = 0; s2 < 2; ++s2) {
                    u32x4 pw = {cvtpk(s[8 * s2], s[8 * s2 + 1]), cvtpk(s[8 * s2 + 2], s[8 * s2 + 3]), cvtpk(s[8 * s2 + 4], s[8 * s2 + 5]), cvtpk(s[8 * s2 + 6], s[8 * s2 + 7])};
                    const bf16x8 pf = __builtin_bit_cast(bf16x8, pw);
                    const int p0 = 32 * sb + 16 * s2 + 4 * hh + q4, p1 = p0 + 8; const int t0 = dir ? 63 - p0 : p0, t1 = dir ? 63 - p1 : p1;
                    const v4i16_t lo = vtr(L + VT + eb * 4096 + t0 * 64 + trcol), hi = vtr(L + VT + eb * 4096 + t1 * 64 + trcol);
                    const bf16x8 va = {lo[0], lo[1], lo[2], lo[3], hi[0], hi[1], hi[2], hi[3]};
                    o = MFMA32(va, pf, o);
                }
            }
        }
        rs = xor32_sum(rs);
        const float den = (at * nq) + rs; const float idn = 1.f / fmaxf(fabsf(den), __expf(-(bt + Mt)));
        LAS float* hp = (LAS float*)(L + HB) + ttok * 65 + 32 * eb;
        if (dir == 0) {
#pragma unroll
            for (int i = 0; i < 16; ++i) hp[crow(i, hh)] = o[i] * idn;
        } else {
#pragma unroll
            for (int i = 0; i < 16; ++i) hp[crow(i, hh)] += o[i] * idn;
        }
    }
    __syncthreads();
    { const int t = htid >> 2, e0 = (htid & 3) * 16; const float* out_norm = F.in[I_OUTNORM] + l * 256 + h * 64 + e0; float hv[16]; float ss = 0.f;
      const LAS float* hb = (LAS float*)(L + HB) + t * 65 + e0;
#pragma unroll
      for (int i = 0; i < 16; ++i) { hv[i] = hb[i]; ss += hv[i] * hv[i]; }
      ss += dpp_f<0xB1>(ss); ss += dpp_f<0x4E>(ss);
      const float rstd = rsqrtf(ss * (1.f / 64.f) + EPS);
      const unsigned ogw[8] = {og0.x, og0.y, og0.z, og0.w, og1.x, og1.y, og1.z, og1.w};
      unsigned ow[8];
#pragma unroll
      for (int i = 0; i < 8; ++i) { const float g0 = __uint_as_float(ogw[i] << 16), g1 = __uint_as_float(ogw[i] & 0xffff0000u);
          const float r0 = hv[2 * i] * rstd * out_norm[2 * i] * __builtin_amdgcn_rcpf(1.f + __expf(-g0)), r1 = hv[2 * i + 1] * rstd * out_norm[2 * i + 1] * __builtin_amdgcn_rcpf(1.f + __expf(-g1));
          ow[i] = cvtpk(r0, r1); }
      u32x4 w0 = {ow[0], ow[1], ow[2], ow[3]}, w1 = {ow[4], ow[5], ow[6], ow[7]};
      bf16_t* yp = F_Y + (size_t)(rbase + t) * D + h * 64 + e0; *(u32x4*)yp = w0; *(u32x4*)(yp + 8) = w1; }
    __syncthreads();
}

__device__ __forceinline__ void attn_dispatch(Frame& F, int l, int idx) {
    constexpr float LOG2E = 1.4426950408889634f;
    if (idx < 384) { const int bh6 = idx >> 4, qb = idx & 15; const int b = bh6 / 6, h = bh6 % 6; const size_t bh = (size_t)bh6;
        attn_unit256<96, false, false>(F, F_QB + (bh * TS + TC + 256 * qb) * 96, F_KB + bh * TS * 96, F_VB + bh * TS * 64, MLA_NP, 0, 0.f, F_Y + (size_t)(b * T + 256 * qb) * D + 256 + h * 64); return; }
    idx -= 384;
    if (idx < 384) { const int bh6 = idx >> 4, qb = idx & 15; const int b = bh6 / 6, hq = bh6 % 6; const int kvh = hq / 3; const size_t bk = (size_t)b * 2 + kvh;
        attn_unit256<64, true, true>(F, F_QC + ((size_t)bh6 * TS + TC + 256 * qb) * 64, F_KC + bk * TS * 64, F_VC + bk * TS * 64, 6, 256 * qb, F.in[I_SINK][l * 6 + hq] * LOG2E, F_Y + (size_t)(b * T + 256 * qb) * D + 640 + hq * 64); return; }
    idx -= 384;
    if (idx < 24) { const int b = idx / 6, h = idx % 6; const size_t bh = (size_t)idx;
        attn_unit256<96, false, false>(F, F_QB + (bh * TS) * 96, F_KB + bh * TS * 96, F_VB + bh * TS * 64, 2, 0, 0.f, F_Y + (size_t)(ML + b * TC) * D + 256 + h * 64); return; }
    idx -= 24;
    { const int b = idx / 6, hq = idx % 6; const int kvh = hq / 3; const size_t bk = (size_t)b * 2 + kvh;
        attn_unit256<64, false, true>(F, F_QC + ((size_t)idx * TS) * 64, F_KC + bk * TS * 64, F_VC + bk * TS * 64, 2, 0, F.in[I_SINK][l * 6 + hq] * LOG2E, F_Y + (size_t)(ML + b * TC) * D + 640 + hq * 64); }
}
constexpr int CW_Q = 8192;
__device__ __forceinline__ void mix_unit(Frame& F, int l, int x, int li) {
    int idx; bool m3 = false; const int b = x >> 1, kvh = x & 1;
    if (li < 48) idx = (x + 8 * (li >> 4)) * 16 + (li & 15);
    else if (li < 96) { const int r = li - 48; idx = 384 + (b * 6 + kvh * 3 + (r >> 4)) * 16 + (r & 15); }
    else if (li < 160) { m3 = true; idx = x * 128 + 2 * (li - 96); }
    else if (li < 164) { m3 = true; idx = 1024 + x * 8 + 2 * (li - 160); }
    else if (li < 167) idx = 768 + x + 8 * (li - 164);
    else idx = 792 + b * 6 + kvh * 3 + (li - 167);
    if (m3) mlstm_m3_mfma(F, l, idx); else attn_dispatch(F, l, idx);
}
__device__ __forceinline__ void ph_mixers(Frame& F, int l, int rep) {
    OPAQUE_TID(F);
    const bool need_ctx = l + 1 < DEPTH;
    const int nloc = 160 + (need_ctx ? 10 : 0);
    unsigned* ctr0 = (unsigned*)(F.ws + WS_CTL) + CW_Q + 64 * 8 * (l + 2 * rep);
    volatile LAS int* slot = (volatile LAS int*)(F.lds + MISC_OFF + 64);
    const int x0 = (int)(xb_xcc_id() & 7u);
    for (int xs = 0; xs < 8; ++xs) {
        const int x = (x0 + xs) & 7;
        for (;;) {
            if (F.tid == 0) slot[0] = (int)__hip_atomic_fetch_add(ctr0 + 64 * x, 1u, __ATOMIC_RELAXED, __HIP_MEMORY_SCOPE_AGENT);
            __syncthreads();
            const int li = slot[0];
            __syncthreads();
            if (li >= nloc) break;
            mix_unit(F, l, x, li);
        }
    }
}

__global__ void __launch_bounds__(512, 2) fwd_mk(Args args) {
    extern __shared__ __attribute__((aligned(16))) unsigned char lds[];
    Frame F;
    F.lds = (LAS unsigned char*)lds;
    volatile LAS unsigned* MISC = (volatile LAS unsigned*)(F.lds + MISC_OFF);
    F.tid = threadIdx.x; F.lane = F.tid & 63; F.wave = __builtin_amdgcn_readfirstlane(F.tid >> 6);
    F.G = gridDim.x; { const int bx = blockIdx.x; F.vcu = (F.G % 8 == 0) ? (bx % 8) * (F.G / 8) + bx / 8 : bx; }
    F.in = args.in; F.out = args.out; F.ws = args.ws; unsigned char* ws = args.ws;
    for (int u = F.tid; u < (LDS_BYTES - LDSCTL_OFF) / 4; u += 512) ((LAS unsigned*)(F.lds + LDSCTL_OFF))[u] = 0u;
    __syncthreads();
    gu32* ctl = (gu32*)(ws + WS_CTL);
    XcdBarrier bar; bar.bar = (unsigned*)(ctl + CW_BAR); bar.x = 0; bar.st = nullptr;
    if (MK_N_LAUNCHES == 1) bar = xcd_barrier_post((unsigned*)(ctl + CW_BAR), MISC + 8);

    const int lo = args.ph_lo, hi = args.ph_hi;
    int rep = 0;
    for (int ph = lo; ph < hi; ++ph) {
        {
        int cv_l0 = 0, cv_r0 = 0, cv_n0 = 0, cv_nt = 0, cv_gw = 0, cv_ngw = 1;
        if (ph == 0) { p0_prologue(F);
            if (F.G == 256 && F.vcu >= 64) { cv_n0 = CV_P0; cv_nt = CV_P0; cv_gw = (F.vcu - 64) * 8 + F.wave; cv_ngw = 192 * 8; } }
        else {
            const int l = (ph - 1) / 13, sp = (ph - 1) % 13;
            const float* modl = F_MOD + (size_t)l * 5 * 9 * D;
            const bool first = (l == 0 && sp <= 2);
            const float* xl = first ? F.in[I_X] : F.out;
            const int Mrows = (l + 1 == DEPTH && sp >= 9) ? ML : M;
            float* slabD = (float*)(F.ws + WS_QUP); float* slabO = (float*)(F.ws + WS_QUP + 34 * MiB);
            switch (sp) {
            case 0: case 3: case 10: {
                int npend = 0; const float* pg = F_MOD; float pc = 0.f; const float* sl = slabD;
                if (sp == 0 && l > 0) { npend = 11; pg = modp(F_MOD, l - 1, 4, 8); pc = 0.5f; }
                if (sp == 3) { npend = 11; pg = modp(F_MOD, l, 4, 2); pc = 0.5f; }
                if (sp == 10 && Mrows == M) { npend = 4; pg = modp(F_MOD, l, 4, 5); pc = 1.0f; sl = slabO; }
                ph_modulate(F, xl, l, sp == 0 ? 0 : (sp == 3 ? 1 : 2), Mrows, rep ? 0 : npend, sl, pg, pc);
                if (l == 0 && sp == 0) {
                    static_assert(DEPTH == 2, "conversion lists");
                    const bool hosted = (F.G == 256); cv_r0 = hosted ? CV_P0 : 0; cv_n0 = hosted ? CV_NA - CV_P0 : CV_NA + CV_NB; cv_nt = hosted ? CV_NA - CV_P0 : 2 * (CV_NA + CV_NB); cv_gw = F.vcu * 8 + F.wave; cv_ngw = F.G * 8; } } break;
            case 1: case 11: {
                pg8::Gemm g{F_XN, F.wl(l, sp == 1 ? W_1I : W_2I), Mrows, 2 * DFF, D}; pg8::StaticOrder S; S.init(Mrows, 2 * DFF, F.G, (int)blockIdx.x, D);
                EpiSwiglu E{F_HID};
                #ifdef UP_SP2_OFF
                pg8::gemm_phase<EpiSwiglu, pg8::StaticOrder, true, false>(F.lds + RING_OFF, g, S, E);
#elif defined(UP_ALIGN_OFF)
                pg8::gemm_phase<EpiSwiglu, pg8::StaticOrder, false, true>(F.lds + RING_OFF, g, S, E);
#else
                pg8::gemm_phase<EpiSwiglu, pg8::StaticOrder, true, true>(F.lds + RING_OFF, g, S, E);
#endif
                } break;
            case 2: case 12: case 9: {
                const bool isout = sp == 9; const int K = isout ? D : DFF;
                pg8::Gemm g{isout ? F_Y : F_HID, F.wl(l, isout ? W_OUT : (sp == 2 ? W_1O : W_2O)), Mrows, D, K}; pg8::SplitOrder S; S.init(D, K, F.G, (int)blockIdx.x, Mrows == M ? (isout ? 4 : 11) : 0);
                EpiResid E{xl, F.out, isout ? slabO : slabD, modl, isout ? 5 : (sp == 2 ? 2 : 8), isout ? 1.0f : 0.5f};
#ifdef PROBE_DUP
                if (rep == 0 && sp == PROBE_DUP) E.coef = 0.f;
#endif
                pg8::gemm_phase<EpiResid, pg8::SplitOrder, true, true>(F.lds + RING_OFF, g, S, E); } break;
            case 4: {
                const bool split = (F.G == 256); const int Gg = split ? 184 : F.G;
                if ((int)blockIdx.x >= Gg) { cv_l0 = l; cv_r0 = CV_NA; cv_n0 = CV_NB; cv_nt = CV_NB + (l + 1 < DEPTH ? CV_NA : 0); cv_gw = ((int)blockIdx.x - Gg) * 8 + F.wave; cv_ngw = (F.G - Gg) * 8; break; }
                pg8::Gemm g{F_XN, F.wl(l, W_IN), M, 2048, D}; pg8::StaticOrder S; S.init(M, 2048, Gg, (int)blockIdx.x, D);
                EpiInproj E{F_P16A, F_G32, F_P16B};
                pg8::gemm_phase<EpiInproj, pg8::StaticOrder, true, true>(F.lds + RING_OFF, g, S, E); } break;
            case 5: {
#pragma unroll 1
                for (int s_ = 0; s_ < 2; ++s_) { if (((s_ ^ F.vcu) & 1) == 0) ph_prepA(F, l); else ph_mlstm_m1b(F, l); __syncthreads(); }
                } break;
            case 6: {
                const int Gg = (F.G == 256) ? 204 : F.G;
                if ((int)blockIdx.x >= Gg) { ph_mlstm_m2<3>(F, (int)blockIdx.x - Gg, F.G - Gg); break; }
                pg8::Gemm g{F_CKN, F.wl(l, W_UP), M, 1536, 384}; pg8::UpOrder S; S.init(Gg, (int)blockIdx.x);
                EpiUp E{F_QUP, F_KVUP};
                pg8::gemm_phase<EpiUp, pg8::UpOrder, true, true>(F.lds + RING_OFF, g, S, E); } break;
            case 7: { if (F.G != 256) ph_mlstm_m2<1>(F, F.vcu, F.G); ph_prepB(F, l);
#ifdef PROBE_PREPB2
                __syncthreads(); ph_prepB(F, l);
#endif
                } break;
            case 8: { ph_mixers(F, l, rep); } break;
            default: break;
            }
        }
        if (cv_nt > 0) { __syncthreads(); p0_weights(F, cv_l0, cv_r0, cv_n0, cv_nt, cv_gw, cv_ngw); }
        }
#ifdef PROBE_DUP
        if (rep == 0 && ((ph > 0 && (ph - 1) % 13 == PROBE_DUP) || (ph == 0 && PROBE_DUP == 100))) { rep = 1; --ph; xcd_barrier(bar); continue; }
        rep = 0;
#endif
        if (ph + 1 < hi) xcd_barrier(bar);
    }
}

extern "C" void kernel_launch(void* const* d_in, const int* in_sizes, int n_in, void* d_out, int out_size, void* d_ws, size_t ws_size, hipStream_t stream) {
    static int grid = 0;
    if (grid == 0) {
        if (n_in != 24 || ws_size < WS_END) { fprintf(stderr, "kernel_launch: unexpected n_in %d or ws_size %zu (< %zu)\n", n_in, ws_size, (size_t)WS_END); grid = -1; return; }
        int dev = 0, cus = 0, per_cu = 0;
        if (hipGetDevice(&dev) != hipSuccess || hipDeviceGetAttribute(&cus, hipDeviceAttributeMultiprocessorCount, dev) != hipSuccess) { grid = -1; return; }
        if (hipFuncSetAttribute((const void*)fwd_mk, hipFuncAttributeMaxDynamicSharedMemorySize, LDS_BYTES) != hipSuccess) { fprintf(stderr, "kernel_launch: hipFuncSetAttribute failed\n"); grid = -1; return; }
        if (hipOccupancyMaxActiveBlocksPerMultiprocessor(&per_cu, (const void*)fwd_mk, 512, LDS_BYTES) != hipSuccess || per_cu < 1) fprintf(stderr, "kernel_launch: occupancy query says %d per CU\n", per_cu);
        (void)hipGetLastError();
        grid = cus;
    }
    if (grid < 0) return;
    (void)hipMemsetAsync((char*)d_ws + WS_CTL, 0, CTL_ZERO_BYTES, stream);
    Args a{};
    for (int i = 0; i < 24; ++i) a.in[i] = (const float*)d_in[i];
    a.out = (float*)d_out; a.ws = (unsigned char*)d_ws;
#if MK_N_LAUNCHES == 1
    a.ph_lo = 0; a.ph_hi = NPH;
    hipLaunchKernelGGL(fwd_mk, dim3(grid), dim3(512), LDS_BYTES, stream, a);
#else
    for (int p = 0; p < NPH; ++p) { a.ph_lo = p; a.ph_hi = p + 1; hipLaunchKernelGGL(fwd_mk, dim3(grid), dim3(512), LDS_BYTES, stream, a); }
#endif
}
```

```cpp
#include <hip/hip_runtime.h>
#include <cstdio>
#include <cstdint>
#define MK_N_LAUNCHES 1
namespace pg8 {
#define PG8_LAS __attribute__((address_space(3)))
typedef unsigned short bf16_t;
typedef short bf16x8 __attribute__((ext_vector_type(8)));
typedef float f32x4 __attribute__((ext_vector_type(4)));
typedef unsigned u32x4 __attribute__((ext_vector_type(4)));
constexpr int BM = 256, BK = 64, HALF = 128, HTB = HALF * BK * 2  , STAGE_BYTES = 8 * HTB, NXCD = 8, WGM = 8;

__host__ __device__ __forceinline__ int lds_byte(int r, int c) { const int st = (r >> 4) * 2 + (c >> 5), rr = r & 15, cc = c & 31, ob = rr * 64 + cc * 2; return st * 1024 + (ob ^ (((ob >> 9) & 1) << 5)); }
__host__ __device__ __forceinline__ void stage_rc(int b, int& R, int& C) { const int st = b / 1024, sb = b % 1024, swz = sb ^ (((sb >> 9) & 1) << 5); R = (st >> 1) * 16 + swz / 64; C = (st & 1) * 32 + (swz % 64) / 2; }
__host__ __device__ __forceinline__ int perm32(int rho) { const int n = rho >> 4, i = rho & 15; return 8 * (i >> 2) + 4 * n + (i & 3); }

struct Unit { int pm, pn, kt0, nt, half; };
struct Gemm { const bf16_t* A; const bf16_t* Bt; int M, N, K; };

struct StaticOrder {
    int nM, nN, nwg, G, c, ntK, mgN;
    __host__ __device__ void init(int M, int N, int G_, int c_, int K_) { nM = M / BM; nN = N / BM; nwg = nM * nN; G = G_; c = c_; ntK = K_ / BK; mgN = (1 << 20) / nN + 1; }
    __host__ __device__ bool next(int i, Unit& u) const {
        const int L = i * G + c; if (L >= nwg) return false;
        int wgid = L; { const int q = nwg >> 3, r = nwg & 7, xcd = wgid & 7, off = wgid >> 3; wgid = (xcd < r ? xcd * (q + 1) : r * (q + 1) + (xcd - r) * q) + off; }
        static_assert(WGM == 8 && NXCD == 8, "shifts below");
        const int nig = WGM * nN, gid = ((wgid >> 3) * mgN) >> 20, rem = wgid - gid * nig, fm = gid * WGM, gsz = (nM - fm) < WGM ? (nM - fm) : WGM;
        int po, pq; if (gsz == 8) { po = rem & 7; pq = rem >> 3; } else if (gsz == 4) { po = rem & 3; pq = rem >> 2; } else { po = rem % gsz; pq = rem / gsz; }
        u.pm = fm + po; u.pn = pq; u.kt0 = 0; u.nt = ntK; u.half = 0; return true;
    }
    __device__ __forceinline__ void a_ready(const Unit&) const {}
    __device__ __forceinline__ void done(const Unit&) const {}
};

struct SplitOrder {
    StaticOrder lat; int NS, ntS, mgS;
    __host__ __device__ void init(int N, int K, int G_, int c_, int NS_) { lat.init(16384, N, G_, c_, K); NS = NS_; ntS = NS_ ? (K / BK) / NS_ : 0; mgS = NS_ ? (1 << 20) / NS_ + 1 : 0; }
    __host__ __device__ bool next(int i, Unit& u) const {
        const long L = (long)i * lat.G + lat.c; if (L < lat.nwg) return lat.next(i, u);
        const int idx = (int)(L - lat.nwg); if (idx >= 16 * NS) return false;
        const int tile = (idx * mgS) >> 20, sl = idx - tile * NS; u.pm = 64 + (tile >> 2); u.pn = tile & 3; u.kt0 = sl * ntS; u.nt = ntS; u.half = 0; return true;
    }
    __device__ __forceinline__ void a_ready(const Unit&) const {}
    __device__ __forceinline__ void done(const Unit&) const {}
};

struct InprojOrder {
    StaticOrder full7; int G, c;
    __host__ __device__ void init(int G_, int c_, int K) { full7.init(17408, 7 * 256, G_, c_, K); G = G_; c = c_; }
    __host__ __device__ bool next(int i, Unit& u) const {
        if (G != 256) { if (i > 0) return false; u.pm = 0; u.pn = 0; u.kt0 = 0; u.nt = full7.ntK; u.half = 0; return c == 0; }
        if (i == 0 || (i == 1 && c < 220)) { const bool ok = full7.next(i, u); if (ok && u.pn >= 3) u.pn += 1; return ok; }
        int hidx;
        if (i == 1) hidx = c - 220;
        else if (i == 2 && c >= 220 && c < 252) hidx = 36 + (c - 220);
        else return false;
        u.pm = hidx; u.pn = 3; u.kt0 = 0; u.nt = full7.ntK; u.half = 1; return true;
    }
    __device__ __forceinline__ void a_ready(const Unit&) const {}
    __device__ __forceinline__ void done(const Unit&) const {}
};

struct UpOrder {
    int G, c;
    __host__ __device__ void init(int G_, int c_) { G = G_; c = c_; }
    __host__ __device__ bool next(int i, Unit& u) const {
        const long L = (long)i * G + c; if (L >= 408) return false;
        const int kv = L >= 204, j = kv ? (int)L - 204 : (int)L;
        u.pm = j / 3; u.pn = (kv ? 3 : 0) + j % 3; u.kt0 = kv ? 4 : 0; u.nt = kv ? 2 : 4; u.half = 0; return true;
    }
    __device__ __forceinline__ void a_ready(const Unit&) const {}
    __device__ __forceinline__ void done(const Unit&) const {}
};

__device__ __forceinline__ unsigned cvt_pk_bf16(float lo, float hi) { unsigned r; asm volatile("v_cvt_pk_bf16_f32 %0, %1, %2" : "=v"(r) : "v"(lo), "v"(hi)); return r; }
template <class Epi, class Sched, bool ALIGN_EPI = false, bool SP2 = false>
__device__ __forceinline__ void gemm_phase(PG8_LAS unsigned char* lds, const Gemm g, const Sched& S, const Epi& E) {
    int tid_ = threadIdx.x; asm volatile("" : "+v"(tid_));
    const int tid = tid_, wid = __builtin_amdgcn_readfirstlane(tid >> 6), lane = tid & 63, wr = wid >> 2, wc = wid & 3, fr = lane & 15, fq = lane >> 4;
    int K_ = g.K; asm volatile("" : "+s"(K_));
    const int K = K_;
    unsigned voffA[2], voffB[2];
#pragma unroll
    for (int i = 0; i < 2; ++i) { int R, C; stage_rc(tid * 16 + i * 8192, R, C); const int Rb = Epi::PERM ? ((R & ~31) + perm32(R & 31)) : R;
        voffA[i] = (unsigned)(R * K + C) * 2u; voffB[i] = (unsigned)(Rb * K + C) * 2u; }
    const size_t kstep = (size_t)(BK * 2);
    const size_t hstep = (size_t)HALF * K * 2;
    const size_t tstep = 2 * hstep;
    const unsigned ldsw = (unsigned)wid * 1024u;
    const int aoff = lds_byte(wr * 64 + fr, fq * 8), boff = lds_byte(wc * 32 + fr, fq * 8);
#define PG8_SA(b, h) (((b) * 2 + (h)) * HTB)
#define PG8_SB(b, h) ((4 + (b) * 2 + (h)) * HTB)
#define PG8_STAGE(bufoff, gbase, voff) do { _Pragma("unroll") for (int _i = 0; _i < 2; ++_i) \
        __builtin_amdgcn_global_load_lds((const unsigned*)((const char*)(gbase) + (voff)[_i]), (PG8_LAS unsigned*)(lds + (bufoff) + ldsw + _i * 8192), 16, 0, 0); } while (0)
#define PG8_LDA(dst, b, h) do { _Pragma("unroll") for (int m = 0; m < 4; ++m) _Pragma("unroll") for (int k = 0; k < 2; ++k) dst[m][k] = *(const PG8_LAS bf16x8*)(lds + PG8_SA(b, h) + aoff + m * 2048 + k * 1024); } while (0)
#define PG8_LDB(dst, b, h) do { _Pragma("unroll") for (int n = 0; n < 2; ++n) _Pragma("unroll") for (int k = 0; k < 2; ++k) dst[n][k] = *(const PG8_LAS bf16x8*)(lds + PG8_SB(b, h) + boff + n * 2048 + k * 1024); } while (0)
#define PG8_MMA(ai, bj, At, Bt) do { __builtin_amdgcn_s_setprio(1); _Pragma("unroll") for (int m = 0; m < 4; ++m) _Pragma("unroll") for (int n = 0; n < 2; ++n) _Pragma("unroll") for (int k = 0; k < 2; ++k) \
        acc[ai][bj][m][n] = __builtin_amdgcn_mfma_f32_16x16x32_bf16(Bt[n][k], At[m][k], acc[ai][bj][m][n], 0, 0, 0); __builtin_amdgcn_s_setprio(0); } while (0)
#define PG8_WAIT_V(n) asm volatile("s_waitcnt vmcnt(" #n ")" ::: "memory")
#define PG8_WAIT_L(n) asm volatile("s_waitcnt lgkmcnt(" #n ")" ::: "memory")
#define PG8_BAR __builtin_amdgcn_s_barrier()
#define PG8_SCHED __builtin_amdgcn_sched_barrier(0)
    Unit cur, nxt; int ui = 0;
    if (!S.next(0, cur)) return;
    f32x4 acc[2][2][4][2];
#pragma unroll
    for (int a = 0; a < 2; ++a)
#pragma unroll
        for (int b = 0; b < 2; ++b)
#pragma unroll
            for (int m = 0; m < 4; ++m)
#pragma unroll
                for (int n = 0; n < 2; ++n) acc[a][b][m][n] = (f32x4){0.f, 0.f, 0.f, 0.f};
    bf16x8 At[4][2], B0[2][2], B1[2][2];
    const char* cA = (const char*)g.A + (size_t)cur.pm * tstep + (size_t)cur.kt0 * kstep; const char* cB = (const char*)g.Bt + (size_t)cur.pn * tstep + (size_t)cur.kt0 * kstep;
    S.a_ready(cur);
    if constexpr (SP2) {
        PG8_STAGE(PG8_SB(0, 0), cB, voffB); PG8_STAGE(PG8_SB(0, 1), cB + hstep, voffB); PG8_STAGE(PG8_SA(0, 0), cA, voffA); PG8_STAGE(PG8_SA(0, 1), cA + hstep, voffA);
        if (wr == 1) PG8_BAR;
        PG8_WAIT_V(2); PG8_BAR;
        PG8_STAGE(PG8_SB(1, 0), cB + kstep, voffB); PG8_STAGE(PG8_SA(1, 0), cA + kstep, voffA); PG8_STAGE(PG8_SB(1, 1), cB + hstep + kstep, voffB);
        PG8_WAIT_V(6); PG8_BAR;
    } else {
        PG8_STAGE(PG8_SB(0, 0), cB, voffB); PG8_STAGE(PG8_SA(0, 0), cA, voffA); PG8_STAGE(PG8_SB(0, 1), cB + hstep, voffB); PG8_STAGE(PG8_SA(0, 1), cA + hstep, voffA);
        if (wr == 1) PG8_BAR;
        PG8_WAIT_V(4); PG8_BAR;
        PG8_STAGE(PG8_SB(1, 0), cB + kstep, voffB); PG8_STAGE(PG8_SA(1, 0), cA + kstep, voffA); PG8_STAGE(PG8_SB(1, 1), cB + hstep + kstep, voffB);
        PG8_WAIT_V(6); PG8_BAR;
    }
    for (;;) {
        const bool has_next = S.next(ui + 1, nxt);
        const char* nA = has_next ? (const char*)g.A + (size_t)nxt.pm * tstep + (size_t)nxt.kt0 * kstep : cA; const char* nB = has_next ? (const char*)g.Bt + (size_t)nxt.pn * tstep + (size_t)nxt.kt0 * kstep : cB;
        const int ntc = cur.nt; const bool full = !cur.half;
        for (int t = 0; t < ntc; t += 2) {
            const bool last = (t == ntc - 2);
            const char* a1 = cA + (size_t)(t + 1) * kstep;
            const char* a2 = last ? nA : cA + (size_t)(t + 2) * kstep; const char* b2 = last ? nB : cB + (size_t)(t + 2) * kstep;
            const char* a3 = a2 + kstep; const char* b3 = b2 + kstep;
            if (last && has_next) S.a_ready(nxt);
            if constexpr (SP2) {
            PG8_LDB(B0, 0, 0); PG8_LDB(B1, 0, 1); PG8_SCHED; PG8_LDA(At, 0, 0); PG8_STAGE(PG8_SA(1, 1), a1 + hstep, voffA);
            PG8_WAIT_V(8); PG8_WAIT_L(0); PG8_BAR; PG8_MMA(0, 0, At, B0); if (full) PG8_MMA(0, 1, At, B1); PG8_BAR; PG8_SCHED;
            PG8_LDA(At, 0, 1); PG8_STAGE(PG8_SB(0, 0), b2, voffB); PG8_STAGE(PG8_SB(0, 1), b2 + hstep, voffB); PG8_STAGE(PG8_SA(0, 0), a2, voffA);
            PG8_WAIT_V(8); PG8_WAIT_L(0); PG8_BAR; PG8_MMA(1, 0, At, B0); if (full) PG8_MMA(1, 1, At, B1); PG8_BAR; PG8_SCHED;
            PG8_LDB(B0, 1, 0); PG8_LDB(B1, 1, 1); PG8_SCHED; PG8_LDA(At, 1, 0); PG8_STAGE(PG8_SA(0, 1), a2 + hstep, voffA);
            PG8_WAIT_V(8); PG8_WAIT_L(0); PG8_BAR; PG8_MMA(0, 0, At, B0); if (full) PG8_MMA(0, 1, At, B1); PG8_BAR; PG8_SCHED;
            PG8_LDA(At, 1, 1); PG8_STAGE(PG8_SB(1, 0), b3, voffB); PG8_STAGE(PG8_SB(1, 1), b3 + hstep, voffB); PG8_STAGE(PG8_SA(1, 0), a3, voffA);
            PG8_WAIT_V(8); PG8_WAIT_L(0); PG8_BAR; PG8_MMA(1, 0, At, B0); if (full) PG8_MMA(1, 1, At, B1); PG8_BAR; PG8_SCHED;
            } else {
            PG8_LDB(B0, 0, 0); PG8_SCHED; PG8_LDA(At, 0, 0); PG8_STAGE(PG8_SA(1, 1), a1 + hstep, voffA);
            PG8_WAIT_L(8); PG8_BAR; PG8_WAIT_L(0); PG8_MMA(0, 0, At, B0); PG8_BAR; PG8_SCHED;
            PG8_LDB(B1, 0, 1); PG8_STAGE(PG8_SB(0, 0), b2, voffB);
            PG8_BAR; PG8_WAIT_L(0); PG8_MMA(0, 1, At, B1); PG8_BAR;
            PG8_LDA(At, 0, 1); PG8_STAGE(PG8_SA(0, 0), a2, voffA);
            PG8_BAR; PG8_WAIT_L(0); PG8_MMA(1, 0, At, B0); PG8_BAR; PG8_SCHED;
            PG8_STAGE(PG8_SB(0, 1), b2 + hstep, voffB);
            PG8_WAIT_V(6); PG8_BAR; PG8_MMA(1, 1, At, B1); PG8_BAR;
            PG8_LDB(B0, 1, 0); PG8_SCHED; PG8_LDA(At, 1, 0); PG8_STAGE(PG8_SA(0, 1), a2 + hstep, voffA);
            PG8_WAIT_L(8); PG8_BAR; PG8_WAIT_L(0); PG8_MMA(0, 0, At, B0); PG8_BAR; PG8_SCHED;
            PG8_LDB(B1, 1, 1); PG8_STAGE(PG8_SB(1, 0), b3, voffB);
            PG8_BAR; PG8_WAIT_L(0); PG8_MMA(0, 1, At, B1); PG8_BAR;
            PG8_LDA(At, 1, 1); PG8_STAGE(PG8_SA(1, 0), a3, voffA);
            PG8_BAR; PG8_WAIT_L(0); PG8_MMA(1, 0, At, B0); PG8_BAR; PG8_SCHED;
            PG8_STAGE(PG8_SB(1, 1), b3 + hstep, voffB);
            PG8_WAIT_V(6); PG8_BAR; PG8_MMA(1, 1, At, B1); PG8_BAR;
            }
        }
        if constexpr (ALIGN_EPI) { if (wr == 0) PG8_BAR; }
        if constexpr (!Epi::AFTER_DRAIN) { E(acc, cur, wr, wc, fr, fq); S.done(cur); }
        if (!has_next) break;
#pragma unroll
        for (int a = 0; a < 2; ++a)
#pragma unroll
            for (int b = 0; b < 2; ++b)
#pragma unroll
                for (int m = 0; m < 4; ++m)
#pragma unroll
                    for (int n = 0; n < 2; ++n) acc[a][b][m][n] = (f32x4){0.f, 0.f, 0.f, 0.f};
        cur = nxt; cA = nA; cB = nB; ++ui;
        if constexpr (ALIGN_EPI) { if (wr == 1) PG8_BAR; }
    }
    PG8_WAIT_V(0);
    if constexpr (!ALIGN_EPI) { if (wr == 0) PG8_BAR; }
    PG8_BAR;
    if constexpr (Epi::AFTER_DRAIN) { E.fused(acc, cur, wr, wc, fr, fq, lds, wid, lane); S.done(cur); }
#undef PG8_SA
#undef PG8_SB
#undef PG8_STAGE
#undef PG8_LDA
#undef PG8_LDB
#undef PG8_MMA
#undef PG8_WAIT_V
#undef PG8_WAIT_L
#undef PG8_BAR
#undef PG8_SCHED
}
}

#ifndef MK_N_LAUNCHES
#define MK_N_LAUNCHES 1
#endif
namespace cf {
constexpr int D = 1024, NB = 4, T = 4096, TC = 256, ML = NB * T, MC = NB * TC, M = ML + MC, TS = T + TC;
constexpr int DFF = 2816, DIN = 1840, DEPTH = 2;
constexpr float EPS = 1e-6f;
constexpr int NPH = 1 + 13 * DEPTH;
}
using namespace cf;
typedef unsigned short bf16_t;
typedef float f32x4 __attribute__((ext_vector_type(4)));
typedef unsigned u32x4 __attribute__((ext_vector_type(4)));
#define GAS __attribute__((address_space(1)))
#define LAS __attribute__((address_space(3)))
typedef GAS unsigned gu32;
#define RLX_AGENT __ATOMIC_RELAXED, __HIP_MEMORY_SCOPE_AGENT
#define LDS_WAIT() asm volatile("s_waitcnt lgkmcnt(0)" ::: "memory")
#define VM_WAIT() asm volatile("s_waitcnt vmcnt(0)" ::: "memory")

constexpr size_t MiB = 1u << 20;
constexpr size_t WS_CTL = 0, CTL_ZERO_BYTES = 64 * 1024;
constexpr size_t WS_MOD = 1 * MiB;
constexpr size_t WS_XBC = 5 * MiB;
constexpr size_t WS_W = 9 * MiB;
constexpr size_t W_1I = 0, W_1O = W_1I + (size_t)5632 * 1024, W_2I = W_1O + (size_t)1024 * 2816, W_2O = W_2I + (size_t)5632 * 1024, W_IN = W_2O + (size_t)1024 * 2816,
                 W_OUT = W_IN + (size_t)2048 * 1024, W_UP = W_OUT + (size_t)1024 * 1024, WL_STRIDE = W_UP + (size_t)1536 * 384;
static_assert(WS_W + 2 * WL_STRIDE * 2 <= 90 * MiB, "weights");
constexpr size_t WS_XN = 90 * MiB;
constexpr size_t WS_HID = 124 * MiB;
constexpr size_t WS_P16A = 124 * MiB;
constexpr size_t WS_G32 = WS_P16A + (size_t)M * 768 * 2;
constexpr size_t WS_P16B = 154 * MiB;
constexpr size_t WS_MLA = 154 * MiB;
constexpr size_t WS_LOC = 205 * MiB;
constexpr size_t WS_QUP = 223 * MiB;
constexpr size_t WS_END = 274 * MiB;
static_assert(WS_G32 + (size_t)M * 64 * 4 <= WS_P16B && WS_MLA + ((size_t)NB * 6 * TS * (96 + 96 + 64)) * 2 <= WS_LOC && WS_LOC + (size_t)32 * 68 * 2112 * 4 <= WS_QUP && WS_QUP + (size_t)M * 768 * 4 <= WS_END, "ws map");
static_assert(WS_HID + (size_t)M * DFF * 2 <= WS_QUP, "ws map 2");
constexpr int CW_BAR = 1024;

constexpr int RING_OFF = 0, RING_BYTES = 131072, LDSCTL_OFF = RING_BYTES, MISC_OFF = LDSCTL_OFF + 320, LDS_BYTES = 147456;

__device__ __forceinline__ float bf2f(bf16_t v) { return __uint_as_float(((unsigned)v) << 16); }
__device__ __forceinline__ bf16_t f2bf(float f) { unsigned u = __float_as_uint(f); u += 0x7fffu + ((u >> 16) & 1u); return (bf16_t)(u >> 16); }
__device__ __forceinline__ unsigned pk2(float lo, float hi) { typedef float f2_t_ __attribute__((ext_vector_type(2))); typedef __bf16 b2_t_ __attribute__((ext_vector_type(2))); f2_t_ v = {lo, hi}; b2_t_ b = __builtin_convertvector(v, b2_t_); return __builtin_bit_cast(unsigned, b); }
__device__ __forceinline__ float siluf(float x) { return x / (1.f + expf(-x)); }
__device__ __forceinline__ float silu_fast(float x) { return x * __builtin_amdgcn_rcpf(1.f + __expf(-x)); }
__device__ __forceinline__ float sigmoidf_(float x) { return 1.f / (1.f + expf(-x)); }
__device__ __forceinline__ float logsigmoidf_(float x) { return x >= 0.f ? -log1pf(expf(-x)) : x - log1pf(expf(x)); }
struct RowInfo { int b, t, isctx, s, sp; };
__device__ __forceinline__ RowInfo rowinfo(int m) {
    RowInfo r;
    if (m < ML) { r.b = m / T; r.t = m % T; r.isctx = 0; r.s = r.b; r.sp = TC + r.t; }
    else { int q = m - ML; r.b = q / TC; r.t = q % TC; r.isctx = 1; r.s = 4; r.sp = r.t; }
    return r;
}
template <int CTRL> __device__ __forceinline__ float dpp_f(float v) { return __int_as_float(__builtin_amdgcn_update_dpp(0, __float_as_int(v), CTRL, 0xF, 0xF, true)); }
__device__ __forceinline__ float sum16(float v) { v += dpp_f<0x128>(v); v += dpp_f<0x124>(v); v += dpp_f<0x122>(v); v += dpp_f<0x121>(v); return v; }
__device__ __forceinline__ float xor16_sum(float v) { auto r = __builtin_amdgcn_permlane16_swap(__float_as_uint(v), __float_as_uint(v), false, false); return __uint_as_float(r[0]) + __uint_as_float(r[1]); }
__device__ __forceinline__ float xor32_sum(float v) { auto r = __builtin_amdgcn_permlane32_swap(__float_as_uint(v), __float_as_uint(v), false, false); return __uint_as_float(r[0]) + __uint_as_float(r[1]); }
__device__ __forceinline__ float sum32(float v) { return xor16_sum(sum16(v)); }
__device__ __forceinline__ float wave_sum(float v) { return xor32_sum(xor16_sum(sum16(v))); }
template <int CTRL, int RMASK> __device__ __forceinline__ float dpp_id(float v, float ident) { return __int_as_float(__builtin_amdgcn_update_dpp(__float_as_int(ident), __float_as_int(v), CTRL, RMASK, 0xF, false)); }
__device__ __forceinline__ float scan_sum64(float v) {
    v += dpp_id<0x111, 0xF>(v, 0.f); v += dpp_id<0x112, 0xF>(v, 0.f); v += dpp_id<0x114, 0xF>(v, 0.f); v += dpp_id<0x118, 0xF>(v, 0.f);
    v += dpp_id<0x142, 0xA>(v, 0.f); v += dpp_id<0x143, 0xC>(v, 0.f); return v; }
__device__ __forceinline__ float scan_max64(float v) {
    const float NI = -INFINITY;
    v = fmaxf(v, dpp_id<0x111, 0xF>(v, NI)); v = fmaxf(v, dpp_id<0x112, 0xF>(v, NI)); v = fmaxf(v, dpp_id<0x114, 0xF>(v, NI)); v = fmaxf(v, dpp_id<0x118, 0xF>(v, NI));
    v = fmaxf(v, dpp_id<0x142, 0xA>(v, NI)); v = fmaxf(v, dpp_id<0x143, 0xC>(v, NI)); return v; }
__device__ __forceinline__ float lane_bcast(float v, int lane_const) { return __int_as_float(__builtin_amdgcn_readlane(__float_as_int(v), lane_const)); }
__device__ __forceinline__ float xchg4(float v, int l16) { const float up = dpp_f<0x104>(v)  , dn = dpp_f<0x114>(v)  ; return (l16 & 4) ? dn : up; }
__device__ __forceinline__ float xchg2(float v) { return dpp_f<0x4E>(v); }
__device__ __forceinline__ void sincos_b(float a, float& s, float& c) {
    const float inv2pi = 0.15915494309189535f;
    float k = rintf(a * inv2pi);
    float r = fmaf(-k, 6.28125f, a);
    r = fmaf(-k, 1.9353071795864769e-3f, r);
    float rev = r * inv2pi;
    s = __builtin_amdgcn_sinf(rev); c = __builtin_amdgcn_cosf(rev);
}
__device__ __forceinline__ const float* modp(const float* MOD, int l, int s, int n) { return MOD + ((size_t)(l * 5 + s) * 9 + n) * D; }
#define XB_TMO      128
#define XB_XCNT(j)  (256  + 64 * (j))
#define XB_XSUB(j)  (1280 + 64 * (j))
#define XB_XGEN(j)  (2304 + 64 * (j))
#define XB_TOP      3328
#define XB_TOPGEN   3392
#define XCD_BAR_WORDS 3456
#define XB_SPIN_CAP (1u << 18)

__device__ __forceinline__ unsigned xb_ld(unsigned* p)              { return __hip_atomic_load(p, __ATOMIC_RELAXED, __HIP_MEMORY_SCOPE_AGENT); }
__device__ __forceinline__ unsigned xb_add(unsigned* p, unsigned v) { return __hip_atomic_fetch_add(p, v, __ATOMIC_RELAXED, __HIP_MEMORY_SCOPE_AGENT); }
__device__ __forceinline__ unsigned xb_xcc_id() { return (unsigned)__builtin_amdgcn_s_getreg((3 << 11) | 20) & 0xFu; }
#define XB_SPIN(cond, bar) do { unsigned _sp = 0; while (cond) { __builtin_amdgcn_s_sleep(1); \
    if ((++_sp & 255u) == 0u) { if (xb_ld(&(bar)[XB_TMO])) break; if (_sp > XB_SPIN_CAP) { atomicAdd(&(bar)[XB_TMO], 1u); break; } } } } while (0)

struct XcdBarrier {
    unsigned* bar; unsigned x;
    volatile LAS unsigned* st;
};

__device__ __forceinline__ XcdBarrier xcd_barrier_post(unsigned* bar, volatile LAS unsigned* st) {
    XcdBarrier b; b.bar = bar; b.x = xb_xcc_id(); b.st = st;
    if (threadIdx.x == 0) (void)xb_add(&bar[XB_XCNT(b.x)], 1u);
    return b;
}
__device__ __forceinline__ void xcd_barrier_complete(unsigned* bar, unsigned x, unsigned& nloc, unsigned& nx) {
    const unsigned G = gridDim.x * gridDim.y * gridDim.z;
    unsigned sum, cnt, mine, sp = 0u;
    for (;;) {
        sum = 0u; cnt = 0u; mine = 0u;
#pragma unroll
        for (unsigned j = 0; j < 16; ++j) { const unsigned c = xb_ld(&bar[XB_XCNT(j)]); sum += c; cnt += (c > 0u) ? 1u : 0u; mine = (j == x) ? c : mine; }
        if (sum == G) break;
        __builtin_amdgcn_s_sleep(1);
        if ((++sp & 255u) == 0u) { if (xb_ld(&bar[XB_TMO])) break; if (sp > XB_SPIN_CAP) { atomicAdd(&bar[XB_TMO], 1u); break; } }
    }
    nloc = mine > 0u ? mine : 1u; nx = cnt > 0u ? cnt : 1u;
}

__device__ __forceinline__ void xcd_barrier(const XcdBarrier& b) {
    asm volatile("s_waitcnt vmcnt(0)" ::: "memory");
    __syncthreads();
    if (threadIdx.x == 0) {
        unsigned* bar = b.bar;
        __builtin_amdgcn_s_waitcnt(0);
        unsigned nloc = b.st[0], nx = b.st[1];
        if (nloc == 0u) { xcd_barrier_complete(bar, b.x, nloc, nx); b.st[0] = nloc; b.st[1] = nx; }
        const unsigned old = xb_add(&bar[XB_XSUB(b.x)], 1u);
        const unsigned gen = old / nloc;
        if (old + 1u == (gen + 1u) * nloc) {
            __builtin_amdgcn_fence(__ATOMIC_RELEASE, "agent");
            asm volatile("s_waitcnt vmcnt(0)" ::: "memory");
            const unsigned og = xb_add(&bar[XB_TOP], 1u);
            const unsigned tg = og / nx;
            if (og + 1u == (tg + 1u) * nx) xb_add(&bar[XB_TOPGEN], 1u);
            else XB_SPIN(xb_ld(&bar[XB_TOPGEN]) == tg, bar);
            __builtin_amdgcn_fence(__ATOMIC_ACQUIRE, "agent");
            xb_add(&bar[XB_XGEN(b.x)], 1u);
            asm volatile("s_waitcnt vmcnt(0)" ::: "memory");
        } else {
            XB_SPIN(xb_ld(&bar[XB_XGEN(b.x)]) == gen, bar);
            __builtin_amdgcn_fence(__ATOMIC_ACQUIRE, "agent");
            asm volatile("s_waitcnt vmcnt(0)" ::: "memory");
        }
    }
    __syncthreads();
}

struct Args { const float* in[24]; float* out; unsigned char* ws; int ph_lo, ph_hi; };
struct Frame {
    LAS unsigned char* lds; int tid, lane, wave, vcu, G;
    const float* const* in; float* out; unsigned char* ws;
    __device__ __forceinline__ bf16_t* wl(int l, size_t off) const { return (bf16_t*)(ws + WS_W) + (size_t)l * WL_STRIDE + off; }
};
#define OPAQUE_TID(F) do { int t_ = (F).tid; asm volatile("" : "+v"(t_)); (F).tid = t_; (F).lane = t_ & 63; } while (0)
#define F_MOD   ((float*)(F.ws + WS_MOD))
#define F_XBC   ((float*)(F.ws + WS_XBC))
#define F_XN    ((bf16_t*)(F.ws + WS_XN))
#define F_HID   ((bf16_t*)(F.ws + WS_HID))
#define F_P16A  ((bf16_t*)(F.ws + WS_P16A))
#define F_G32   ((float*)(F.ws + WS_G32))
#define F_P16B  ((bf16_t*)(F.ws + WS_P16B))
#define F_Y     ((bf16_t*)(F.ws + WS_QUP))
#define F_QUP   ((bf16_t*)(F.ws + WS_QUP))
#define F_KVUP  ((bf16_t*)(F.ws + WS_QUP) + (size_t)M * 768)
#define F_QC    ((bf16_t*)(F.ws + WS_XN))
#define F_KC    (F_QC + (size_t)NB * 6 * TS * 64)
#define F_VC    (F_KC + (size_t)NB * 2 * TS * 64)
#define F_CKN   (F_VC + (size_t)NB * 2 * TS * 64)
#define F_QB    ((bf16_t*)(F.ws + WS_MLA))
#define F_KB    (F_QB + (size_t)NB * 6 * TS * 96)
#define F_VB    (F_KB + (size_t)NB * 6 * TS * 96)
enum InIdx { I_X = 0, I_C, I_CTX, I_CCTX, I_ADAW, I_ADAB, I_NORMG, I_F1WI, I_F1WO, I_F2WI, I_F2WO, I_WIN, I_WOUT, I_GATEB, I_OUTNORM, I_CQN, I_CKVN, I_WUQ, I_WUKV, I_MQN, I_MKN, I_GQN, I_GKN, I_SINK };

template <class Map>
__device__ __forceinline__ void transpose_item(const float* W, int ldw, int Nsrc, int k0, int n0, bf16_t* WT, int ldt, int koff, Map map, LAS float* scr, int lane, float sc = 1.f) {
    int nsrc = n0 + (lane & 31); nsrc = nsrc < Nsrc ? nsrc : Nsrc - 1;
    float tv[32];
#pragma unroll
    for (int i = 0; i < 32; ++i) { const int kk = 2 * i + (lane >> 5); tv[i] = W[(size_t)(k0 + kk) * ldw + nsrc]; }
#pragma unroll
    for (int i = 0; i < 32; ++i) { const int kk = 2 * i + (lane >> 5); scr[kk * 33 + (lane & 31)] = tv[i]; }
    LDS_WAIT(); asm volatile("" ::: "memory");
    const int c = lane & 7;
#pragma unroll
    for (int j = 0; j < 4; ++j) { const int nn = (lane >> 3) + 8 * j; const LAS float* s = scr + (8 * c) * 33 + nn;
        u32x4 o; o.x = pk2(s[0 * 33] * sc, s[1 * 33] * sc); o.y = pk2(s[2 * 33] * sc, s[3 * 33] * sc); o.z = pk2(s[4 * 33] * sc, s[5 * 33] * sc); o.w = pk2(s[6 * 33] * sc, s[7 * 33] * sc);
        if (n0 + nn < Nsrc) *(u32x4*)(WT + (size_t)map(n0 + nn) * ldt + koff + k0 + 8 * c) = o; }
    LDS_WAIT(); asm volatile("" ::: "memory");
}
constexpr float SW_GSC = 1.4426950408889634f, SW_USC = 0.6931471805599453f;
static_assert(DFF % 32 == 0, "a conversion item never straddles the gate/up boundary");
struct MapId { __device__ __forceinline__ int operator()(int n) const { return n; } };
struct MapWi { __device__ __forceinline__ int operator()(int n) const { return n < DFF ? 256 * (n >> 7) + (n & 127) : 256 * ((n - DFF) >> 7) + 128 + ((n - DFF) & 127); } };
__host__ __device__ __forceinline__ int pcol(int n) {
    if (n < 784) return n;
    if (n < 1040) return 1024 + (n - 784);
    if (n < 1168) return 1280 + (n - 1040);
    if (n < 1200) return 784 + (n - 1168);
    if (n < 1584) return 1408 + (n - 1200);
    if (n < 1712) return 1792 + (n - 1584);
    return 1920 + (n - 1712);
}
struct MapWin { __device__ __forceinline__ int operator()(int n) const { return pcol(n); } };
struct MapUq { __device__ __forceinline__ int operator()(int n) const { return 128 * (n / 96) + (n % 96); } };
struct MapUkv { __device__ __forceinline__ int operator()(int n) const { return 768 + n; } };

__device__ __forceinline__ void p0_prologue(Frame& F) {
    OPAQUE_TID(F);
    {
        LAS float* sc = (LAS float*)(F.lds);
        LAS float* red = (LAS float*)(F.lds + 20480);
        for (int i = F.tid; i < 5 * 1024; i += 512) { int s = i >> 10, k = i & 1023; float v = s < 4 ? F.in[I_C][s * D + k] : F.in[I_CCTX][k]; sc[i] = siluf(v); }
        __syncthreads();
        for (int it = F.vcu; it < 576; it += F.G) {
            const int l = it / 288, cb = it % 288; const int kk = F.lane >> 3, c4 = F.lane & 7; const int kb = F.wave * 128;
            const float* w = F.in[I_ADAW] + (size_t)l * D * 9216 + (size_t)(kb + kk) * 9216 + cb * 32 + 4 * c4;
            f32x4 a[5] = {{0.f, 0.f, 0.f, 0.f}, {0.f, 0.f, 0.f, 0.f}, {0.f, 0.f, 0.f, 0.f}, {0.f, 0.f, 0.f, 0.f}, {0.f, 0.f, 0.f, 0.f}};
#pragma unroll 16
            for (int i = 0; i < 16; ++i) { const f32x4 wv = *(const f32x4*)(w + (size_t)(8 * i) * 9216); const int k = kb + kk + 8 * i;
#pragma unroll
                for (int s = 0; s < 5; ++s) a[s] += wv * sc[s * 1024 + k]; }
#pragma unroll
            for (int s = 0; s < 5; ++s) {
#pragma unroll
                for (int c = 0; c < 4; ++c) { float t = a[s][c]; t += dpp_f<0x128>(t); t = xor32_sum(xor16_sum(t)); a[s][c] = t; } }
            if (kk == 0) { LAS float* r = red + F.wave * 160 + 4 * c4;
#pragma unroll
                for (int s = 0; s < 5; ++s) *(LAS f32x4*)(r + 32 * s) = a[s]; }
            __syncthreads();
            if (F.tid < 160) { const int s = F.tid >> 5, col = F.tid & 31; float acc = F.in[I_ADAB][l * 9216 + cb * 32 + col];
#pragma unroll
                for (int wv = 0; wv < 8; ++wv) acc += red[wv * 160 + s * 32 + col];
                F_MOD[(size_t)(l * 5 + s) * 9216 + cb * 32 + col] = acc; }
            __syncthreads();
        }
    }
    { const int gt = F.vcu * 512 + F.tid, NGT = F.G * 512; for (int i = gt; i < MC * D / 4; i += NGT) ((f32x4*)F_XBC)[i] = ((const f32x4*)F.in[I_CTX])[i]; }
    {
        const int gt = F.vcu * 512 + F.tid, NGT = F.G * 512; const u32x4 z = {0u, 0u, 0u, 0u};
        for (int i = gt; i < 2 * (768 * 16 + 768 * 32); i += NGT) {
            const int l = i / (768 * 48); int r = i % (768 * 48);
            bf16_t* wu = F.wl(l, W_UP);
            if (r < 768 * 16) { const int row = r >> 4, ch = r & 15; *(u32x4*)(wu + (size_t)row * 384 + 256 + 8 * ch) = z; }
            else { r -= 768 * 16; const int row = 768 + (r >> 5), ch = r & 31; *(u32x4*)(wu + (size_t)row * 384 + 8 * ch) = z; }
        }
    }
}

constexpr int CV_WI = 16 * 176, CV_WO = 44 * 32, CV_IN = 16 * 58, CV_OUT = 16 * 32, CV_UQ = 4 * 18, CV_UKV = 2 * 24;
constexpr int CV_NA = CV_WI + CV_WO + CV_IN + CV_UQ + CV_UKV, CV_NB = CV_WI + CV_WO + CV_OUT, CV_P0 = CV_NA;
static_assert(CV_P0 <= CV_NA, "phase-0 share");
__device__ __forceinline__ void p0_weights(Frame& F, int l0, int r0, int n0, int ntot, int gw, int NGW) {
    OPAQUE_TID(F);
    LAS float* scr = (LAS float*)(F.lds + F.wave * 16384);
    for (int t = gw; t < ntot; t += NGW) {
        const int l = t < n0 ? l0 : l0 + 1; int r = t < n0 ? r0 + t : t - n0;
        if (r < CV_WI) { transpose_item(F.in[I_F1WI] + (size_t)l * D * 2 * DFF, 2 * DFF, 2 * DFF, 64 * (r / 176), 32 * (r % 176), F.wl(l, W_1I), 1024, 0, MapWi(), scr, F.lane, (r % 176) < 88 ? SW_GSC : SW_USC); continue; } r -= CV_WI;
        if (r < CV_WO) { transpose_item(F.in[I_F1WO] + (size_t)l * DFF * D, D, D, 64 * (r / 32), 32 * (r % 32), F.wl(l, W_1O), DFF, 0, MapId(), scr, F.lane); continue; } r -= CV_WO;
        if (r < CV_IN) { transpose_item(F.in[I_WIN] + (size_t)l * D * DIN, DIN, DIN, 64 * (r / 58), 32 * (r % 58), F.wl(l, W_IN), 1024, 0, MapWin(), scr, F.lane); continue; } r -= CV_IN;
        if (r < CV_UQ) { transpose_item(F.in[I_WUQ] + (size_t)l * 256 * 576, 576, 576, 64 * (r / 18), 32 * (r % 18), F.wl(l, W_UP), 384, 0, MapUq(), scr, F.lane); continue; } r -= CV_UQ;
        if (r < CV_UKV) { transpose_item(F.in[I_WUKV] + (size_t)l * 128 * 768, 768, 768, 64 * (r / 24), 32 * (r % 24), F.wl(l, W_UP), 384, 256, MapUkv(), scr, F.lane); continue; } r -= CV_UKV;
        if (r < CV_WI) { transpose_item(F.in[I_F2WI] + (size_t)l * D * 2 * DFF, 2 * DFF, 2 * DFF, 64 * (r / 176), 32 * (r % 176), F.wl(l, W_2I), 1024, 0, MapWi(), scr, F.lane, (r % 176) < 88 ? SW_GSC : SW_USC); continue; } r -= CV_WI;
        if (r < CV_WO) { transpose_item(F.in[I_F2WO] + (size_t)l * DFF * D, D, D, 64 * (r / 32), 32 * (r % 32), F.wl(l, W_2O), DFF, 0, MapId(), scr, F.lane); continue; } r -= CV_WO;
        transpose_item(F.in[I_WOUT] + (size_t)l * D * D, D, D, 64 * (r / 32), 32 * (r % 32), F.wl(l, W_OUT), 1024, 0, MapId(), scr, F.lane);
    }
}
__device__ __forceinline__ void ph_modulate(Frame& F, const float* xl, int l, int which, int Mrows, int npend, const float* slab, const float* pgate, float pcoef) {
    OPAQUE_TID(F);
    const int gw = F.vcu * 8 + F.wave, NGW = F.G * 8, lane = F.lane;
    const f32x4* g4 = (const f32x4*)(F.in[I_NORMG] + (l * 3 + which) * D);
    {
        f32x4 cur[4];
        if (gw < ML) {
#pragma unroll
            for (int j = 0; j < 4; ++j) cur[j] = ((const f32x4*)(xl + (size_t)gw * D))[lane + 64 * j];
        }
        for (int m = gw; m < ML; m += NGW) {
            const int mn = (m + NGW < ML) ? m + NGW : m; f32x4 nxt[4];
#pragma unroll
            for (int j = 0; j < 4; ++j) nxt[j] = ((const f32x4*)(xl + (size_t)mn * D))[lane + 64 * j];
            const int s = m / T;
            const f32x4* sh4 = (const f32x4*)modp(F_MOD, l, s, 3 * which); const f32x4* sc4 = (const f32x4*)modp(F_MOD, l, s, 3 * which + 1);
            f32x4 gs[4], sh[4];
#pragma unroll
            for (int j = 0; j < 4; ++j) { const f32x4 g = g4[lane + 64 * j], sc = sc4[lane + 64 * j]; sh[j] = sh4[lane + 64 * j]; gs[j] = g * (sc + 1.f); }
            float ss = 0.f;
#pragma unroll
            for (int j = 0; j < 4; ++j) ss += cur[j].x * cur[j].x + cur[j].y * cur[j].y + cur[j].z * cur[j].z + cur[j].w * cur[j].w;
            ss = wave_sum(ss);
            const float rstd = rsqrtf(ss * (1.f / D) + EPS);
            uint2* o = (uint2*)(F_XN + (size_t)m * D);
#pragma unroll
            for (int j = 0; j < 4; ++j) { const f32x4 y = cur[j] * rstd * gs[j] + sh[j]; uint2 r; r.x = pk2(y.x, y.y); r.y = pk2(y.z, y.w); o[lane + 64 * j] = r; }
#pragma unroll
            for (int j = 0; j < 4; ++j) cur[j] = nxt[j];
        }
    }
    if (Mrows > ML) {
        LAS float* xs = (LAS float*)(F.lds);
        for (int r0 = F.vcu * 4; r0 < MC; r0 += F.G * 4) {
            const int row = r0 + (F.wave >> 1), hf = F.wave & 1;
            f32x4* xr = (f32x4*)(F_XBC + (size_t)row * D) + hf * 128;
            f32x4 v[2];
#pragma unroll
            for (int j = 0; j < 2; ++j) v[j] = xr[2 * lane + j];
            if (npend > 0) {
                u32x4 t[11];
#pragma unroll
                for (int s = 0; s < 11; ++s) { const int sc_ = s < npend ? s : npend - 1; t[s] = ((const u32x4*)((const bf16_t*)slab + ((size_t)sc_ * MC + row) * D + hf * 512))[lane]; }
                f32x4 a8[2] = {{0.f, 0.f, 0.f, 0.f}, {0.f, 0.f, 0.f, 0.f}};
#pragma unroll
                for (int s = 0; s < 11; ++s) { const float w = s < npend ? 1.f : 0.f;
                    a8[0] += (f32x4){__uint_as_float(t[s].x << 16), __uint_as_float(t[s].x & 0xffff0000u), __uint_as_float(t[s].y << 16), __uint_as_float(t[s].y & 0xffff0000u)} * w;
                    a8[1] += (f32x4){__uint_as_float(t[s].z << 16), __uint_as_float(t[s].z & 0xffff0000u), __uint_as_float(t[s].w << 16), __uint_as_float(t[s].w & 0xffff0000u)} * w; }
#pragma unroll
                for (int j = 0; j < 2; ++j) { v[j] += ((const f32x4*)pgate)[hf * 128 + 2 * lane + j] * pcoef * a8[j]; xr[2 * lane + j] = v[j]; }
            }
            float ss = 0.f;
#pragma unroll
            for (int j = 0; j < 2; ++j) ss += v[j].x * v[j].x + v[j].y * v[j].y + v[j].z * v[j].z + v[j].w * v[j].w;
            ss = wave_sum(ss);
            __syncthreads();
            if (lane == 0) xs[F.wave] = ss;
            __syncthreads();
            ss = xs[F.wave] + xs[F.wave ^ 1];
            const float rstd = rsqrtf(ss * (1.f / D) + EPS);
            const f32x4* sh4 = (const f32x4*)modp(F_MOD, l, 4, 3 * which) + hf * 128; const f32x4* sc4 = (const f32x4*)modp(F_MOD, l, 4, 3 * which + 1) + hf * 128;
            uint2* o = (uint2*)(F_XN + (size_t)(ML + row) * D) + hf * 128;
#pragma unroll
            for (int j = 0; j < 2; ++j) {
                f32x4 g = g4[hf * 128 + 2 * lane + j], sh = sh4[2 * lane + j], sc = sc4[2 * lane + j];
                uint2 r; r.x = pk2(v[j].x * rstd * g.x * (1.f + sc.x) + sh.x, v[j].y * rstd * g.y * (1.f + sc.y) + sh.y);
                r.y = pk2(v[j].z * rstd * g.z * (1.f + sc.z) + sh.z, v[j].w * rstd * g.w * (1.f + sc.w) + sh.w);
                o[2 * lane + j] = r;
            }
        }
    }
}
__device__ __forceinline__ f32x4 ld_bf4(const bf16_t* p) { uint2 w = *(const uint2*)p; f32x4 r; r.x = __uint_as_float(w.x << 16); r.y = __uint_as_float(w.x & 0xffff0000u); r.z = __uint_as_float(w.y << 16); r.w = __uint_as_float(w.y & 0xffff0000u); return r; }
__device__ __forceinline__ f32x4 cvt_bf4(uint2 w) { f32x4 r; r.x = __uint_as_float(w.x << 16); r.y = __uint_as_float(w.x & 0xffff0000u); r.z = __uint_as_float(w.y << 16); r.w = __uint_as_float(w.y & 0xffff0000u); return r; }
__device__ __forceinline__ void st_bf4(bf16_t* p, float a, float b, float c, float d) { uint2 r; r.x = pk2(a, b); r.y = pk2(c, d); *(uint2*)p = r; }

__device__ __forceinline__ void rope64(float (&v)[4], int l16, int prow, int pcolp) {
    int d0 = 4 * l16; int pos = d0 < 32 ? prow : pcolp; int dd0 = d0 & 31; bool first = dd0 < 16;
#pragma unroll
    for (int i = 0; i < 4; ++i) {
        float other = xchg4(v[i], l16);
        int fi = (dd0 & 15) + i;
        float inv = exp2f(-(float)fi * (13.287712379549449f / 16.f));
        float s, c; sincos_b((float)pos * inv, s, c);
        v[i] = first ? (v[i] * c - other * s) : (other * s + v[i] * c);
    }
}
__device__ __forceinline__ void rope32(float (&v)[4], int l8, int prow, int pcolp) {
    int rd0 = 4 * l8; int pos = rd0 < 16 ? prow : pcolp; int r16 = rd0 & 15; bool first = r16 < 8;
#pragma unroll
    for (int i = 0; i < 4; ++i) {
        float other = xchg2(v[i]);
        int fi = (r16 & 7) + i;
        float inv = exp2f(-(float)fi * (13.287712379549449f / 8.f));
        float s, c; sincos_b((float)pos * inv, s, c);
        v[i] = first ? (v[i] * c - other * s) : (other * s + v[i] * c);
    }
}
__device__ __forceinline__ void ph_prepA(Frame& F, int l) {
    OPAQUE_TID(F);
    const int gw = F.vcu * 8 + F.wave, NGW = F.G * 8, lane = F.lane, l16 = lane & 15;
    const float* cq_norm = F.in[I_CQN] + l * 256; const float* ckv_norm = F.in[I_CKVN] + l * 128; const float* gq_norm = F.in[I_GQN] + l * 64; const float* gk_norm = F.in[I_GKN] + l * 64;
    uint2 nraw[4];
    { const bf16_t* pr = F_P16B + (size_t)(gw < M ? gw : 0) * 1024 + 4 * lane;
#pragma unroll
      for (int j = 0; j < 4; ++j) nraw[j] = *(const uint2*)(pr + 256 * j); }
    for (int m = gw; m < M; m += NGW) {
        RowInfo ri = rowinfo(m); const bool lat = !ri.isctx; const int prow = ri.t >> 6, pcl = ri.t & 63;
        const f32x4 v0 = cvt_bf4(nraw[0]), v1 = cvt_bf4(nraw[1]), v2 = cvt_bf4(nraw[2]), v3 = cvt_bf4(nraw[3]);
        { const int mn = m + NGW < M ? m + NGW : m; const bf16_t* pr = F_P16B + (size_t)mn * 1024 + 4 * lane;
#pragma unroll
          for (int j = 0; j < 4; ++j) nraw[j] = *(const uint2*)(pr + 256 * j); }
        { float ss = wave_sum(v0.x * v0.x + v0.y * v0.y + v0.z * v0.z + v0.w * v0.w); float rstd = rsqrtf(ss * (1.f / 256.f) + EPS);
          f32x4 g = ((const f32x4*)cq_norm)[lane]; st_bf4(F_CKN + (size_t)(__umul24((unsigned)m, 384u) + 4u * lane), v0.x * rstd * g.x, v0.y * rstd * g.y, v0.z * rstd * g.z, v0.w * rstd * g.w); }
        { float p = lane < 32 ? (v1.x * v1.x + v1.y * v1.y + v1.z * v1.z + v1.w * v1.w) : 0.f; float ss = wave_sum(p); float rstd = rsqrtf(ss * (1.f / 128.f) + EPS);
          if (lane < 32) { f32x4 g = ((const f32x4*)ckv_norm)[lane]; st_bf4(F_CKN + (size_t)(__umul24((unsigned)m, 384u) + 256u + 4u * lane), v1.x * rstd * g.x, v1.y * rstd * g.y, v1.z * rstd * g.z, v1.w * rstd * g.w); } }
#pragma unroll
        for (int part = 0; part < 2; ++part) {
            f32x4 x = part ? v2 : v1; const bool ok = part ? true : lane >= 32; const int hq = part ? 2 + (lane >> 4) : ((lane >> 4) & 1);
            float ss = x.x * x.x + x.y * x.y + x.z * x.z + x.w * x.w;
            ss = sum16(ss);
            float rstd = rsqrtf(ss * (1.f / 64.f) + EPS); f32x4 g = ((const f32x4*)gq_norm)[l16];
            float v[4] = {x.x * rstd * g.x, x.y * rstd * g.y, x.z * rstd * g.z, x.w * rstd * g.w};
            float vr[4] = {v[0], v[1], v[2], v[3]}; rope64(vr, l16, prow, pcl);
            if (lat) { v[0] = vr[0]; v[1] = vr[1]; v[2] = vr[2]; v[3] = vr[3]; }
            constexpr float QSC = 0.125f * 1.4426950408889634f;
            if (ok) st_bf4(F_QC + (size_t)(__umul24(__umul24((unsigned)(ri.b * 6 + hq), (unsigned)TS) + (unsigned)ri.sp, 64u) + 4u * l16), v[0] * QSC, v[1] * QSC, v[2] * QSC, v[3] * QSC);
        }
        { const int kvh = (lane & 31) >> 4; const bool isk = lane < 32; f32x4 x = v3;
          float ss = x.x * x.x + x.y * x.y + x.z * x.z + x.w * x.w;
          ss = sum16(ss);
          float rstd = rsqrtf(ss * (1.f / 64.f) + EPS); f32x4 g = ((const f32x4*)gk_norm)[l16];
          float v[4] = {x.x * rstd * g.x, x.y * rstd * g.y, x.z * rstd * g.z, x.w * rstd * g.w};
          float vr[4] = {v[0], v[1], v[2], v[3]}; rope64(vr, l16, prow, pcl);
          if (lat) { v[0] = vr[0]; v[1] = vr[1]; v[2] = vr[2]; v[3] = vr[3]; }
          const size_t off = (size_t)(__umul24(__umul24((unsigned)(ri.b * 2 + kvh), (unsigned)TS) + (unsigned)ri.sp, 64u) + 4u * l16);
          if (isk) st_bf4(F_KC + off, v[0], v[1], v[2], v[3]); else st_bf4(F_VC + off, x.x, x.y, x.z, x.w); }
    }
}
__device__ __forceinline__ void ph_prepB(Frame& F, int l) {
    OPAQUE_TID(F);
    const int gw = ((F.vcu + F.G / 2) % F.G) * 8 + F.wave, NGW = F.G * 8, lane = F.lane, l32 = lane & 31, d0 = 4 * l32;
    const float* q_norm = F.in[I_MQN] + l * 96; const float* k_norm = F.in[I_MKN] + l * 96;
    const int KVC_ = 4 * lane - ((lane & 16) ? 64 : 0);
    f32x4 nkr; uint2 nq[3], nkv[3];
    { const int m0 = gw < M ? gw : 0; nkr = *(const f32x4*)(F_G32 + (size_t)m0 * 64 + 16 + 4 * (lane & 7));
#pragma unroll
      for (int j = 0; j < 3; ++j) { nq[j] = *(const uint2*)(F_QUP + (size_t)m0 * 768 + 256 * j + 4 * lane); nkv[j] = *(const uint2*)(F_KVUP + (size_t)m0 * 768 + 256 * j + KVC_); } }
    for (int m = gw; m < M; m += NGW) {
        RowInfo ri = rowinfo(m); const bool lat = !ri.isctx; const int prow = ri.t >> 6, pcl = ri.t & 63;
        const f32x4 kra = nkr;
        f32x4 kr = kra; if (lane >= 8) kr = (f32x4){0.f, 0.f, 0.f, 0.f};
        uint2 qraw[3], kvraw[3];
#pragma unroll
        for (int j = 0; j < 3; ++j) { qraw[j] = nq[j]; kvraw[j] = nkv[j]; }
        { const int mn = m + NGW < M ? m + NGW : m; nkr = *(const f32x4*)(F_G32 + (size_t)mn * 64 + 16 + 4 * (lane & 7));
#pragma unroll
          for (int j = 0; j < 3; ++j) { nq[j] = *(const uint2*)(F_QUP + (size_t)mn * 768 + 256 * j + 4 * lane); nkv[j] = *(const uint2*)(F_KVUP + (size_t)mn * 768 + 256 * j + KVC_); } }
        float krr[4];
        { f32x4 gk = ((const f32x4*)k_norm)[16 + (lane & 7)]; float kv_[4] = {kra.x * gk.x, kra.y * gk.y, kra.z * gk.z, kra.w * gk.w}; float kvr_[4] = {kv_[0], kv_[1], kv_[2], kv_[3]};
          rope32(kvr_, lane & 7, prow, pcl);
#pragma unroll
          for (int i = 0; i < 4; ++i) krr[i] = lat ? kvr_[i] : kv_[i]; }
        float sskr = kr.x * kr.x + kr.y * kr.y + kr.z * kr.z + kr.w * kr.w; sskr = __int_as_float(__builtin_amdgcn_readfirstlane(__float_as_int(sum16(sskr))));
        float rk[6];
#pragma unroll
        for (int j = 0; j < 3; ++j) {
            const int h = 2 * j + (lane >> 5);
            { f32x4 xq = cvt_bf4(qraw[j]);
              float x[4] = {xq.x, xq.y, xq.z, xq.w}; if (d0 >= 96) { x[0] = x[1] = x[2] = x[3] = 0.f; }
              float ss = x[0] * x[0] + x[1] * x[1] + x[2] * x[2] + x[3] * x[3];
              ss = sum32(ss);
              float rstd = rsqrtf(ss * (1.f / 96.f) + EPS);
              f32x4 g = {0.f, 0.f, 0.f, 0.f}; if (d0 < 96) g = ((const f32x4*)q_norm)[l32];
              float v[4] = {x[0] * rstd * g.x, x[1] * rstd * g.y, x[2] * rstd * g.z, x[3] * rstd * g.w};
              float vr[4] = {v[0], v[1], v[2], v[3]};
              rope32(vr, (l32 - 16) & 7, prow, pcl);
              if (lat && l32 >= 16 && l32 < 24) { v[0] = vr[0]; v[1] = vr[1]; v[2] = vr[2]; v[3] = vr[3]; }
              constexpr float QSB = 0.10206207261596575f * 1.4426950408889634f;
              if (d0 < 96) st_bf4(F_QB + (size_t)(__umul24(__umul24((unsigned)(ri.b * 6 + h), (unsigned)TS) + (unsigned)ri.sp, 96u) + (unsigned)d0), v[0] * QSB, v[1] * QSB, v[2] * QSB, v[3] * QSB); }
            { f32x4 xk = cvt_bf4(kvraw[j]);
              float x[4] = {xk.x, xk.y, xk.z, xk.w};
              float ss = d0 < 64 ? (x[0] * x[0] + x[1] * x[1] + x[2] * x[2] + x[3] * x[3]) : 0.f;
              ss = sum32(ss);
              float rstd = rsqrtf((ss + sskr) * (1.f / 96.f) + EPS);
              const size_t kbase = (size_t)__umul24(__umul24((unsigned)(ri.b * 6 + h), (unsigned)TS) + (unsigned)ri.sp, 96u);
              if (d0 < 64) { f32x4 g = ((const f32x4*)k_norm)[l32]; st_bf4(F_KB + kbase + d0, x[0] * rstd * g.x, x[1] * rstd * g.y, x[2] * rstd * g.z, x[3] * rstd * g.w); }

              rk[2 * j] = __int_as_float(__builtin_amdgcn_readlane(__float_as_int(rstd), 0)); rk[2 * j + 1] = __int_as_float(__builtin_amdgcn_readlane(__float_as_int(rstd), 32)); }
        }
        { const int g = lane >> 3; const float rs = g == 0 ? rk[0] : (g == 1 ? rk[1] : (g == 2 ? rk[2] : (g == 3 ? rk[3] : (g == 4 ? rk[4] : rk[5]))));
          if (lane < 48) st_bf4(F_KB + (size_t)(__umul24(__umul24((unsigned)(ri.b * 6 + g), (unsigned)TS) + (unsigned)ri.sp, 96u) + 64u + 4u * (lane & 7)), krr[0] * rs, krr[1] * rs, krr[2] * rs, krr[3] * rs); }
    }
}
using pg8::Unit;
__device__ __forceinline__ float swg(float g, float u) { return (g * u) * __builtin_amdgcn_rcpf(1.f + __builtin_amdgcn_exp2f(-g)); }
struct EpiSwiglu { static constexpr bool PERM = true, AFTER_DRAIN = false; bf16_t* hid;
    __device__ __forceinline__ void operator()(const pg8::f32x4 (&acc)[2][2][4][2], const Unit& u, int wr, int wc, int fr_, int fq_) const {
        int fr = fr_, fq = fq_; asm volatile("" : "+v"(fr), "+v"(fq));
#ifdef PROBE_EPI2
        for (int rep_ = 0; rep_ < 2; ++rep_) { asm volatile("" ::: "memory");
#endif
        const int row0 = u.pm * 256 + wr * 64 + fr, hc = u.pn * 128 + wc * 32 + 8 * fq;
#pragma unroll
        for (int ai = 0; ai < 2; ++ai)
#pragma unroll
            for (int m = 0; m < 4; ++m) { const pg8::f32x4 g0 = acc[ai][0][m][0], g1 = acc[ai][0][m][1], u0 = acc[ai][1][m][0], u1 = acc[ai][1][m][1];
                u32x4 w; w.x = pg8::cvt_pk_bf16(swg(g0[0], u0[0]), swg(g0[1], u0[1])); w.y = pg8::cvt_pk_bf16(swg(g0[2], u0[2]), swg(g0[3], u0[3]));
                w.z = pg8::cvt_pk_bf16(swg(g1[0], u1[0]), swg(g1[1], u1[1])); w.w = pg8::cvt_pk_bf16(swg(g1[2], u1[2]), swg(g1[3], u1[3]));
                *(u32x4*)(hid + (size_t)(row0 + ai * 128 + m * 16) * DFF + hc) = w; }
#ifdef PROBE_EPI2
        }
#endif
    }
};
struct EpiResid { static constexpr bool PERM = false, AFTER_DRAIN = false; const float* baseL; float* outL; float* slab; const float* modl  ; int gate; float coef;
    __device__ __forceinline__ void operator()(const pg8::f32x4 (&acc)[2][2][4][2], const Unit& u, int wr, int wc, int fr_, int fq_) const {
        int fr = fr_, fq = fq_; asm volatile("" : "+v"(fr), "+v"(fq));
        const int col0 = u.pn * 256 + wc * 32 + 4 * fq;
        if (u.pm >= ML / 256) {
            bf16_t* sp = (bf16_t*)slab + ((size_t)(u.kt0 / u.nt) * MC + (u.pm * 256 - ML) + wr * 64 + fr) * D + col0;
#pragma unroll
            for (int ai = 0; ai < 2; ++ai)
#pragma unroll
                for (int m = 0; m < 4; ++m)
#pragma unroll
                    for (int bj = 0; bj < 2; ++bj)
#pragma unroll
                        for (int n = 0; n < 2; ++n) { const pg8::f32x4 a = acc[ai][bj][m][n]; uint2 w; w.x = pg8::cvt_pk_bf16(a[0], a[1]); w.y = pg8::cvt_pk_bf16(a[2], a[3]);
                            *(uint2*)(sp + (size_t)(ai * 128 + m * 16) * D + bj * 128 + n * 16) = w; }
            return;
        }
        const int s = u.pm / (T / 256); const int rb = u.pm * 256 + wr * 64 + fr;
        const float* gp = modl + ((size_t)s * 9 + gate) * D;
        pg8::f32x4 gv[2][2];
#pragma unroll
        for (int bj = 0; bj < 2; ++bj)
#pragma unroll
            for (int n = 0; n < 2; ++n) gv[bj][n] = *(const pg8::f32x4*)(gp + col0 + bj * 128 + n * 16) * coef;
#ifdef PROBE_EPIR2
#pragma unroll 1
        for (int rep_ = 0; rep_ < 2; ++rep_) { asm volatile("" ::: "memory"); const float cz = rep_ ? 1.f : 0.f; const float* baseL = rep_ ? this->outL : this->baseL;
#pragma unroll
        for (int ai = 0; ai < 2; ++ai)
#pragma unroll
            for (int m = 0; m < 4; ++m) { const size_t off = (size_t)(rb + ai * 128 + m * 16) * D + col0;
#pragma unroll
                for (int bj = 0; bj < 2; ++bj)
#pragma unroll
                    for (int n = 0; n < 2; ++n) { const pg8::f32x4 bs = *(const pg8::f32x4*)(baseL + off + bj * 128 + n * 16); *(pg8::f32x4*)(outL + off + bj * 128 + n * 16) = bs + gv[bj][n] * cz * acc[ai][bj][m][n]; }
                if (m & 1) asm volatile("" ::: "memory"); }
        }
        return;
#endif
#pragma unroll
        for (int ai = 0; ai < 2; ++ai)
#pragma unroll
            for (int m = 0; m < 4; ++m) { const size_t off = (size_t)(rb + ai * 128 + m * 16) * D + col0;
#pragma unroll
                for (int bj = 0; bj < 2; ++bj)
#pragma unroll
                    for (int n = 0; n < 2; ++n) {
#if defined(RESID_NT)
                        const pg8::f32x4 bs = __builtin_nontemporal_load((const pg8::f32x4*)(baseL + off + bj * 128 + n * 16)); __builtin_nontemporal_store(bs + gv[bj][n] * acc[ai][bj][m][n], (pg8::f32x4*)(outL + off + bj * 128 + n * 16));
#elif defined(RESID_NTL)
                        const pg8::f32x4 bs = __builtin_nontemporal_load((const pg8::f32x4*)(baseL + off + bj * 128 + n * 16)); *(pg8::f32x4*)(outL + off + bj * 128 + n * 16) = bs + gv[bj][n] * acc[ai][bj][m][n];
#else
                        const pg8::f32x4 bs = *(const pg8::f32x4*)(baseL + off + bj * 128 + n * 16); *(pg8::f32x4*)(outL + off + bj * 128 + n * 16) = bs + gv[bj][n] * acc[ai][bj][m][n];
#endif
                    }
                if (m & 1) asm volatile("" ::: "memory"); }
    }
};
__device__ __forceinline__ u32x4 pack8(const pg8::f32x4& a, const pg8::f32x4& b) { u32x4 w; w.x = pg8::cvt_pk_bf16(a[0], a[1]); w.y = pg8::cvt_pk_bf16(a[2], a[3]); w.z = pg8::cvt_pk_bf16(b[0], b[1]); w.w = pg8::cvt_pk_bf16(b[2], b[3]); return w; }
struct EpiInproj { static constexpr bool PERM = true, AFTER_DRAIN = false; bf16_t* pa; float* g32; bf16_t* pb;
    __device__ __forceinline__ void operator()(const pg8::f32x4 (&acc)[2][2][4][2], const Unit& u, int wr, int wc, int fr_, int fq_) const {
        int fr = fr_, fq = fq_; asm volatile("" : "+v"(fr), "+v"(fq));
        const int row0 = u.pm * 256 + wr * 64 + fr, c0 = wc * 32 + 8 * fq;
        if (u.pn == 3) {
            if (wc < 2) {
#pragma unroll
                for (int ai = 0; ai < 2; ++ai)
#pragma unroll
                    for (int m = 0; m < 4; ++m) { float* p = g32 + (size_t)(row0 + ai * 128 + m * 16) * 64 + c0; *(pg8::f32x4*)p = acc[ai][0][m][0]; *(pg8::f32x4*)(p + 4) = acc[ai][0][m][1]; }
            }
            return;
        }
        bf16_t* dst = u.pn < 3 ? pa + (size_t)row0 * 768 + u.pn * 256 + c0 : pb + (size_t)row0 * 1024 + (u.pn - 4) * 256 + c0; const size_t ld = u.pn < 3 ? 768 : 1024;
#pragma unroll
        for (int ai = 0; ai < 2; ++ai)
#pragma unroll
            for (int m = 0; m < 4; ++m)
#pragma unroll
                for (int bj = 0; bj < 2; ++bj) *(u32x4*)(dst + (size_t)(ai * 128 + m * 16) * ld + bj * 128) = pack8(acc[ai][bj][m][0], acc[ai][bj][m][1]);
    }
};
struct EpiUp { static constexpr bool PERM = true, AFTER_DRAIN = false; bf16_t* qup; bf16_t* kvup; bf16_t* vb;
    __device__ __forceinline__ void operator()(const pg8::f32x4 (&acc)[2][2][4][2], const Unit& u, int wr, int wc, int fr_, int fq_) const {
        int fr = fr_, fq = fq_; asm volatile("" : "+v"(fr), "+v"(fq));
        const int row0 = u.pm * 256 + wr * 64 + fr, c0 = wc * 32 + 8 * fq;
        if (u.pn >= 3 && wc >= 2) {
#pragma unroll
            for (int ai = 0; ai < 2; ++ai)
#pragma unroll
                for (int m = 0; m < 4; ++m) { const RowInfo ri = rowinfo(row0 + ai * 128 + m * 16);
#pragma unroll
                    for (int bj = 0; bj < 2; ++bj) *(u32x4*)(vb + (size_t)(__umul24(__umul24((unsigned)(ri.b * 6 + 2 * (u.pn - 3) + bj), (unsigned)TS) + (unsigned)ri.sp, 64u) + (unsigned)(c0 - 64))) = pack8(acc[ai][bj][m][0], acc[ai][bj][m][1]); }
            return;
        }
        bf16_t* dst = (u.pn < 3 ? qup + u.pn * 256 : kvup + (u.pn - 3) * 256) + (size_t)row0 * 768 + c0;
#pragma unroll
        for (int ai = 0; ai < 2; ++ai)
#pragma unroll
            for (int m = 0; m < 4; ++m)
#pragma unroll
                for (int bj = 0; bj < 2; ++bj) *(u32x4*)(dst + (size_t)(ai * 128 + m * 16) * 768 + bj * 128) = pack8(acc[ai][bj][m][0], acc[ai][bj][m][1]);
    }
};

constexpr int LOCW = 2112, NCS = 68;
#define F_LOC ((float*)(F.ws + WS_LOC))
__device__ __forceinline__ int mls_cs(int isctx, int j, int dir) { return isctx ? (dir ? 3 - j : j) : 4 + (dir ? 63 - j : j); }
template <int NE>
__device__ __forceinline__ void ph_mlstm_m2(Frame& F, int widx, int nw) {
    OPAQUE_TID(F);
    constexpr int TPS = (2080 + NE - 1) / NE;
    const int g = widx * 512 + F.tid; if (g >= 32 * TPS) return;
    const int seq = g / TPS, r = g % TPS;
    float* base = F_LOC + (size_t)seq * NCS * LOCW + r;
    bool ok[NE]; float val[NE]; float m = 0.f;
#pragma unroll
    for (int j = 0; j < NE; ++j) { ok[j] = r + j * TPS < 2080; val[j] = 0.f; }
#pragma unroll 1
    for (int c0 = 0; c0 < NCS; c0 += 17) {
        float bl[17], ml[17], x[NE][17];
#pragma unroll
        for (int i = 0; i < 17; ++i) { const float* p = base + (size_t)(c0 + i) * LOCW; bl[i] = p[2080 - r]; ml[i] = p[2081 - r];
#pragma unroll
            for (int j = 0; j < NE; ++j) x[j][i] = p[ok[j] ? j * TPS : 0]; }
#pragma unroll
        for (int i = 0; i < 17; ++i) { float* p = base + (size_t)(c0 + i) * LOCW;
#pragma unroll
            for (int j = 0; j < NE; ++j) if (ok[j]) p[j * TPS] = val[j];
            if (r == 0) p[2082] = m;
            const float mn = fmaxf(bl[i] + m, ml[i]); const float a = __expf(bl[i] + m - mn), b = __expf(ml[i] - mn);
#pragma unroll
            for (int j = 0; j < NE; ++j) val[j] = a * val[j] + b * x[j][i];
            m = mn; }
    }
}

typedef short bf16x8 __attribute__((ext_vector_type(8)));
typedef short v4i16_t __attribute__((ext_vector_type(4)));
typedef float f32x16 __attribute__((ext_vector_type(16)));
#define MFMA32(a, b, c) __builtin_amdgcn_mfma_f32_32x32x16_bf16((a), (b), (c), 0, 0, 0)
__device__ __forceinline__ int crow(int r, int h) { return (r & 3) + 8 * (r >> 2) + 4 * h; }
__device__ __forceinline__ unsigned cvtpk(float lo, float hi) { typedef float f2_t __attribute__((ext_vector_type(2))); typedef __bf16 b2_t __attribute__((ext_vector_type(2))); f2_t v = {lo, hi}; b2_t b = __builtin_convertvector(v, b2_t); return __builtin_bit_cast(unsigned, b); }
__device__ __forceinline__ v4i16_t vtr(const LAS unsigned char* p) { return __builtin_amdgcn_ds_read_tr16_b64_v4i16((LAS v4i16_t*)p); }
__device__ __forceinline__ float max3f(float a, float b, float c) { float r; asm("v_max3_f32 %0, %1, %2, %3" : "=v"(r) : "v"(a), "v"(b), "v"(c)); return r; }
#ifdef PROBE_MLA2X
constexpr int MLA_NP = 2 * (TS / 128), MLA_WRAP = TS / 128;
#else
constexpr int MLA_NP = TS / 128, MLA_WRAP = 1 << 20;
#endif
constexpr float ATT_THR = 6.0f;

template <int DQK, bool BAND, bool SINK>
__device__ __forceinline__ void attn_unit256(Frame& F, const bf16_t* Qrows, const bf16_t* Kseq, const bf16_t* Vseq, int npairs, int qpos0, float sink2, bf16_t* Yout) {
    constexpr int NCH = DQK / 8, KSTR = DQK * 2 + 16, KST = 128 * KSTR, STAGE = KST + 16384, NKI = (128 * NCH) / 512, NKS = DQK / 16;
    static_assert((128 * NCH) % 512 == 0 && 2 * STAGE <= RING_BYTES, "attention staging / LDS");
    int tid_ = F.tid; asm volatile("" : "+v"(tid_));
    const int tid = tid_, lane = tid_ & 63, wave = F.wave, r32 = lane & 31, h = lane >> 5;
    LAS unsigned char* L = F.lds;
    bf16x8 qf[NKS];
#pragma unroll
    for (int ks = 0; ks < NKS; ++ks) qf[ks] = *(const bf16x8*)(Qrows + (size_t)(32 * wave + r32) * DQK + 16 * ks + 8 * h);
    const f32x16 z16 = {0.f, 0.f, 0.f, 0.f, 0.f, 0.f, 0.f, 0.f, 0.f, 0.f, 0.f, 0.f, 0.f, 0.f, 0.f, 0.f};
    f32x16 o0 = z16, o1 = z16;
    float l_run = (SINK && h == 0) ? __builtin_amdgcn_exp2f(sink2) : 0.f;
    u32x4 kreg[NKI], vreg[2];
#define ATT_SEQ0(p) ((BAND && (p) >= 2) ? (TC + qpos0 - 128 + 128 * ((p) - 2)) : 128 * ((p) % MLA_WRAP))
#define ATT_LOAD(p) do { const int seq0_ = ATT_SEQ0(p); \
        _Pragma("unroll") for (int i_ = 0; i_ < NKI; ++i_) { const int cid = tid + 512 * i_; const int key = cid / NCH, ch = cid % NCH; int sr = seq0_ + key; sr = sr < 0 ? 0 : (sr > TS - 1 ? TS - 1 : sr); \
            kreg[i_] = *(const u32x4*)(Kseq + (size_t)sr * DQK + ch * 8); } \
        _Pragma("unroll") for (int i_ = 0; i_ < 2; ++i_) { const int cid = tid + 512 * i_; const int key = cid >> 3, ch = cid & 7; int sr = seq0_ + key; sr = sr < 0 ? 0 : (sr > TS - 1 ? TS - 1 : sr); \
            vreg[i_] = *(const u32x4*)(Vseq + (size_t)sr * 64 + ch * 8); } } while (0)
#define ATT_STORE(st) do { LAS unsigned char* sb_ = L + (st) * STAGE; \
        _Pragma("unroll") for (int i_ = 0; i_ < NKI; ++i_) { const int cid = tid + 512 * i_; const int key = cid / NCH, ch = cid % NCH; *(LAS u32x4*)(sb_ + key * KSTR + ch * 16) = kreg[i_]; } \
        _Pragma("unroll") for (int i_ = 0; i_ < 2; ++i_) { const int cid = tid + 512 * i_; const int key = cid >> 3, ch = cid & 7; \
            *(LAS u32x4*)(sb_ + KST + (key >> 6) * 8192 + (ch >> 2) * 4096 + (key & 63) * 64 + (ch & 3) * 16) = vreg[i_]; } } while (0)
    ATT_LOAD(0); ATT_STORE(0); if (npairs > 1) ATT_LOAD(1);
    __syncthreads();
    const int trcol = ((lane >> 4) & 1) * 32 + (lane & 3) * 8, q4 = (lane & 15) >> 2;
    const int qpos = qpos0 + 32 * wave + r32;
    if (wave >= 4) __builtin_amdgcn_s_setprio(1);
#pragma unroll 1
    for (int p = 0; p < npairs; ++p) {
        const int st = p & 1;
        bool need = true;
        if (BAND && p >= 2) { const int k0 = qpos0 - 128 + 128 * (p - 2); const int r0 = qpos0 + 32 * wave; need = (k0 <= r0 + 31 + 128) && (k0 + 127 >= r0 - 128) && (k0 + 127 >= 0) && (k0 < T); }
        if (need) {
#ifdef ATT_ROT
            const int boff = (wave >> 2) * 2;
#else
            const int boff = 0;
#endif
            const LAS unsigned char* Kt = L + st * STAGE + r32 * KSTR + 16 * h;
            const LAS unsigned char* Vb = L + st * STAGE + KST + (4 * h + q4) * 64 + trcol;
            f32x16 sa, sb;
            bf16x8 kf[NKS];
#pragma unroll
            for (int ks = 0; ks < NKS; ++ks) kf[ks] = *(const LAS bf16x8*)(Kt + (32 * boff) * KSTR + 32 * ks);
            __builtin_amdgcn_sched_barrier(0);
            sa = MFMA32(kf[0], qf[0], z16);
#pragma unroll
            for (int ks = 1; ks < NKS; ++ks) sa = MFMA32(kf[ks], qf[ks], sa);
            float rs = 0.f;
#pragma unroll
            for (int blk = 0; blk < 4; ++blk) {
                const int bb = (blk + boff) & 3, bn = (blk + 1 + boff) & 3;
                const LAS unsigned char* vp = Vb + (bb >> 1) * 8192 + (32 * (bb & 1)) * 64;
                v4i16_t vl[2][2], vh[2][2];
#pragma unroll
                for (int s = 0; s < 2; ++s) { vl[0][s] = vtr(vp + (16 * s) * 64); vh[0][s] = vtr(vp + (16 * s + 8) * 64); vl[1][s] = vtr(vp + 4096 + (16 * s) * 64); vh[1][s] = vtr(vp + 4096 + (16 * s + 8) * 64); }
                if (blk < 3) {
#pragma unroll
                    for (int ks = 0; ks < NKS; ++ks) kf[ks] = *(const LAS bf16x8*)(Kt + (32 * bn) * KSTR + 32 * ks);
                }
#ifdef PROBE_LDS2
                { bf16x8 dk[NKS];
#pragma unroll
                  for (int ks = 0; ks < NKS; ++ks) { dk[ks] = *(const LAS bf16x8*)(Kt + (32 * bb) * KSTR + 32 * ks); asm volatile("" :: "v"(dk[ks])); } }
#endif
                __builtin_amdgcn_sched_barrier(0);
                if (BAND && p >= 2) {
                    const int kb0 = qpos0 - 128 + 128 * (p - 2) + 32 * bb;
                    const int r0w = qpos0 + 32 * wave; const bool inside = kb0 >= 0 && kb0 + 31 < T && kb0 >= r0w + 31 - 128 && kb0 + 31 <= r0w + 128;
                    if (!inside) {
#pragma unroll
                        for (int i = 0; i < 16; ++i) { const int kp = kb0 + crow(i, h); const int d0 = qpos - kp; if (!(kp >= 0 && kp < T && d0 <= 128 && d0 >= -128)) sa[i] = -INFINITY; }
                    }
                }
#pragma unroll
                for (int ks = 0; ks < NKS; ++ks) {
                    if (blk < 3) sb = MFMA32(kf[ks], qf[ks], ks == 0 ? z16 : sb);
#ifndef ATT_NOPIN
                    __builtin_amdgcn_sched_barrier(0);
#endif
#pragma unroll
                    for (int i = (16 * ks) / NKS; i < (16 * (ks + 1)) / NKS; ++i) { sa[i] = __builtin_amdgcn_exp2f(sa[i]); rs += sa[i]; }
#ifndef ATT_NOPIN
                    __builtin_amdgcn_sched_barrier(0);
#else
                    __builtin_amdgcn_sched_group_barrier(0x8, 1, 0); __builtin_amdgcn_sched_group_barrier(0x2, 6, 0);
#endif
                }
                bf16x8 pf[2];
#pragma unroll
                for (int s = 0; s < 2; ++s) { u32x4 a = {cvtpk(sa[8 * s], sa[8 * s + 1]), cvtpk(sa[8 * s + 2], sa[8 * s + 3]), cvtpk(sa[8 * s + 4], sa[8 * s + 5]), cvtpk(sa[8 * s + 6], sa[8 * s + 7])}; pf[s] = __builtin_bit_cast(bf16x8, a); }
                __builtin_amdgcn_sched_barrier(0);
#pragma unroll
                for (int s = 0; s < 2; ++s) {
                    const v4i16_t lo0 = vl[0][s], hi0 = vh[0][s], lo1 = vl[1][s], hi1 = vh[1][s];
                    const bf16x8 va0 = {lo0[0], lo0[1], lo0[2], lo0[3], hi0[0], hi0[1], hi0[2], hi0[3]}; const bf16x8 va1 = {lo1[0], lo1[1], lo1[2], lo1[3], hi1[0], hi1[1], hi1[2], hi1[3]};
                    o0 = MFMA32(va0, pf[s], o0); o1 = MFMA32(va1, pf[s], o1);
                }
                if (blk < 3) sa = sb;
            }
            l_run += rs;
        }
        if (p + 1 < npairs) ATT_STORE(st ^ 1);
        if (p + 2 < npairs) ATT_LOAD(p + 2);
        __syncthreads();
    }
#undef ATT_SEQ0
#undef ATT_LOAD
#undef ATT_STORE
    if (wave >= 4) __builtin_amdgcn_s_setprio(0);
    {
        const float inv = 1.f / xor32_sum(l_run);
        LAS unsigned char* osc = L + wave * (32 * 144) + r32 * 144;
#pragma unroll
        for (int i = 0; i < 16; i += 2) { *(LAS unsigned*)(osc + crow(i, h) * 2) = cvtpk(o0[i] * inv, o0[i + 1] * inv); *(LAS unsigned*)(osc + (32 + crow(i, h)) * 2) = cvtpk(o1[i] * inv, o1[i + 1] * inv); }
        LDS_WAIT();
        const LAS unsigned char* osr = L + wave * (32 * 144);
#pragma unroll
        for (int i = 0; i < 4; ++i) { const int row = i * 8 + (lane >> 3), ch = lane & 7; const u32x4 v = *(const LAS u32x4*)(osr + row * 144 + ch * 16);
            *(u32x4*)(Yout + (size_t)(32 * wave + row) * D + ch * 8) = v; }
    }
    __syncthreads();
}

__device__ __forceinline__ void mlstm_m1_mfma(Frame& F, int l, int item0) {
    constexpr int KT = 0, VT = 4096, SW = 12288, SST = 12800, HALFB = 16384;
    int tid_ = F.tid; asm volatile("" : "+v"(tid_)); const int tid = tid_, lane = tid & 63, wave = F.wave, hh = lane >> 5;
    const int half = wave >> 2, hw = wave & 3, htid = tid & 255;
    LAS unsigned char* L = F.lds + half * HALFB;
    const int itemr = item0 + half; const bool valid = itemr < 1024 + 64; const int item = valid ? itemr : item0;
    int isctx, b, h, j;
    if (item < 1024) { isctx = 0; b = item >> 8; h = (item >> 6) & 3; j = item & 63; } else { const int r = item - 1024; isctx = 1; b = r >> 4; h = (r >> 2) & 3; j = r & 3; }
    const int rbase = (isctx ? ML + b * TC : b * T) + 64 * j;
    const float* gate_b = F.in[I_GATEB] + l * 16;
    { const int tok = htid >> 2, ch = htid & 3; *(LAS u32x4*)(L + KT + tok * 64 + ch * 16) = *(const u32x4*)(F_P16A + (size_t)(rbase + tok) * 768 + 128 + h * 32 + ch * 8); }
#pragma unroll
    for (int i = 0; i < 2; ++i) { const int cid = htid + 256 * i, tok = cid >> 3, ch = cid & 7; *(LAS u32x4*)(L + VT + (ch >> 2) * 4096 + tok * 64 + (ch & 3) * 16) = *(const u32x4*)(F_P16A + (size_t)(rbase + tok) * 768 + 256 + h * 64 + ch * 8); }
    if (hw < 2) {
        const int dir = hw, p = lane, tok = dir ? 63 - p : p; const int gi = dir ? 2 : 0;
        const float* pr = F_G32 + (size_t)(rbase + tok) * 64; const float ig = pr[gi * 4 + h] + gate_b[gi * 4 + h]; const float lf = logsigmoidf_(pr[(gi + 1) * 4 + h] + gate_b[(gi + 1) * 4 + h]);
        const float v = scan_sum64(lf); const float blast = lane_bcast(v, 63); const float g = blast - v + ig; const float gm = lane_bcast(scan_max64(g), 63);
        ((LAS float*)(L + SW))[dir * 64 + tok] = __expf(g - gm);
        if (p == 0) { ((LAS float*)(L + SST))[2 * dir] = blast; ((LAS float*)(L + SST))[2 * dir + 1] = gm; }
    }
    __syncthreads();
    {
        const int dir = hw >> 1, eb = hw & 1;
        const int trcol = ((lane >> 4) & 1) * 32 + (lane & 3) * 8, q4 = (lane & 15) >> 2;
        const LAS float* wp = (const LAS float*)(L + SW) + dir * 64;
        const f32x16 z16 = {0.f, 0.f, 0.f, 0.f, 0.f, 0.f, 0.f, 0.f, 0.f, 0.f, 0.f, 0.f, 0.f, 0.f, 0.f, 0.f};
        f32x16 acc = z16, accn = z16;
        const bf16x8 ones = {0x3f80, 0x3f80, 0x3f80, 0x3f80, 0x3f80, 0x3f80, 0x3f80, 0x3f80};
#pragma unroll
        for (int ks = 0; ks < 4; ++ks) {
            const int s0 = 16 * ks + 8 * hh;
            const v4i16_t klo = vtr(L + KT + (s0 + q4) * 64 + trcol), khi = vtr(L + KT + (s0 + 4 + q4) * 64 + trcol);
            const v4i16_t vlo = vtr(L + VT + eb * 4096 + (s0 + q4) * 64 + trcol), vhi = vtr(L + VT + eb * 4096 + (s0 + 4 + q4) * 64 + trcol);
            const f32x4 w0 = *(const LAS f32x4*)(wp + s0), w1 = *(const LAS f32x4*)(wp + s0 + 4);
            u32x4 aw; aw.x = cvtpk(bf2f((bf16_t)klo[0]) * w0[0], bf2f((bf16_t)klo[1]) * w0[1]); aw.y = cvtpk(bf2f((bf16_t)klo[2]) * w0[2], bf2f((bf16_t)klo[3]) * w0[3]);
            aw.z = cvtpk(bf2f((bf16_t)khi[0]) * w1[0], bf2f((bf16_t)khi[1]) * w1[1]); aw.w = cvtpk(bf2f((bf16_t)khi[2]) * w1[2], bf2f((bf16_t)khi[3]) * w1[3]);
            const bf16x8 af = __builtin_bit_cast(bf16x8, aw); const bf16x8 vf = {vlo[0], vlo[1], vlo[2], vlo[3], vhi[0], vhi[1], vhi[2], vhi[3]};
            acc = MFMA32(af, vf, acc);
            if (eb == 0) accn = MFMA32(af, ones, accn);
        }
        float* Lp = F_LOC + ((size_t)((b * 4 + h) * 2 + dir) * NCS + mls_cs(isctx, j, dir)) * LOCW;
        const int e = 32 * eb + (lane & 31);
        if (valid) {
#pragma unroll
            for (int i = 0; i < 16; ++i) Lp[crow(i, hh) * 64 + e] = acc[i];
            if (eb == 0) {
                if ((lane & 31) == 0) {
#pragma unroll
                    for (int i = 0; i < 16; ++i) Lp[2048 + crow(i, hh)] = accn[i];
                }
                if (lane == 0) { Lp[2080] = ((LAS float*)(L + SST))[2 * dir]; Lp[2081] = ((LAS float*)(L + SST))[2 * dir + 1]; }
            }
        }
    }
    __syncthreads();
}
__device__ __forceinline__ void ph_mlstm_m1b(Frame& F, int l) { for (int it = 2 * F.vcu; it < 1024 + 64; it += 2 * F.G) mlstm_m1_mfma(F, l, it); }

__device__ __forceinline__ void mlstm_m3_mfma(Frame& F, int l, int item0) {
    constexpr int KT = 0, VT = 5120, CT = 13312, SN = 23552, SU = 23808, SM = 24320, SB = 24832, SMST = 25344, HB = 25600, HALFB = 45056;
    constexpr float QS = 0.17677669529663687f;
    int tid_ = F.tid; asm volatile("" : "+v"(tid_)); const int tid = tid_, lane = tid & 63, wave = F.wave, r32 = lane & 31, hh = lane >> 5;
    const int half = wave >> 2, hw = wave & 3, htid = tid & 255, tb = hw >> 1, eb = hw & 1;
    LAS unsigned char* L = F.lds + half * HALFB;
    const int item = item0 + half;
    int isctx, b, h, j;
    if (item < 1024) { isctx = 0; b = item >> 8; h = (item >> 6) & 3; j = item & 63; } else { const int r = item - 1024; isctx = 1; b = r >> 4; h = (r >> 2) & 3; j = r & 3; }
    const int rbase = (isctx ? ML + b * TC : b * T) + 64 * j;
    const float* gate_b = F.in[I_GATEB] + l * 16;
    const float* stf = F_LOC + ((size_t)((b * 4 + h) * 2) * NCS + mls_cs(isctx, j, 0)) * LOCW; const float* stb = F_LOC + ((size_t)((b * 4 + h) * 2 + 1) * NCS + mls_cs(isctx, j, 1)) * LOCW;
    bf16x8 qf[2][2];
#pragma unroll
    for (int dir = 0; dir < 2; ++dir) { const int tposq = 32 * (dir ? 1 - tb : tb) + r32; const int ttokq = dir ? 63 - tposq : tposq;
#pragma unroll
        for (int ks = 0; ks < 2; ++ks) qf[dir][ks] = *(const bf16x8*)(F_P16A + (size_t)(rbase + ttokq) * 768 + h * 32 + 16 * ks + 8 * hh); }
    { const int tok = htid >> 2, ch = htid & 3; *(LAS u32x4*)(L + KT + tok * 80 + ch * 16) = *(const u32x4*)(F_P16A + (size_t)(rbase + tok) * 768 + 128 + h * 32 + ch * 8); }
#pragma unroll
    for (int i = 0; i < 2; ++i) { const int cid = htid + 256 * i, tok = cid >> 3, ch = cid & 7; *(LAS u32x4*)(L + VT + (ch >> 2) * 4096 + tok * 64 + (ch & 3) * 16) = *(const u32x4*)(F_P16A + (size_t)(rbase + tok) * 768 + 256 + h * 64 + ch * 8); }
#pragma unroll
    for (int dir = 0; dir < 2; ++dir) { const float* st = dir ? stb : stf;
#pragma unroll
        for (int i = 0; i < 2; ++i) { const int idx = htid + 256 * i, d = idx >> 4, e0 = (idx & 15) * 4; const f32x4 c = *(const f32x4*)(st + d * 64 + e0);
            LAS unsigned char* cp = L + CT + dir * 5120 + e0 * 80 + d * 2;
            *(LAS bf16_t*)(cp) = f2bf(c.x); *(LAS bf16_t*)(cp + 80) = f2bf(c.y); *(LAS bf16_t*)(cp + 160) = f2bf(c.z); *(LAS bf16_t*)(cp + 240) = f2bf(c.w); } }
    if (htid < 64) { const int dir = htid >> 5, d = htid & 31; ((LAS float*)(L + SN))[dir * 32 + d] = (dir ? stb : stf)[2048 + d]; }
    if (hw < 2) { const int dir = hw, p = lane, tok = dir ? 63 - p : p; const int gi = dir ? 2 : 0;
        const float* pr = F_G32 + (size_t)(rbase + tok) * 64; const float ig = pr[gi * 4 + h] + gate_b[gi * 4 + h]; const float lf = logsigmoidf_(pr[(gi + 1) * 4 + h] + gate_b[(gi + 1) * 4 + h]);
        const float v = scan_sum64(lf);
        const float u0 = ig - v; const float cm = scan_max64(u0);
        const float m = (dir ? stb : stf)[2082];
        ((LAS float*)(L + SU))[dir * 64 + p] = u0; ((LAS float*)(L + SM))[dir * 64 + p] = fmaxf(m, cm); ((LAS float*)(L + SB))[dir * 64 + p] = v;
        if (p == 0) ((LAS float*)(L + SMST))[dir] = m; }
    const u32x4 og0 = *(const u32x4*)(F_P16A + (size_t)(rbase + (htid >> 2)) * 768 + 512 + h * 64 + (htid & 3) * 16), og1 = *(const u32x4*)(F_P16A + (size_t)(rbase + (htid >> 2)) * 768 + 512 + h * 64 + (htid & 3) * 16 + 8);
    __syncthreads();
    const int trcol = ((lane >> 4) & 1) * 32 + (lane & 3) * 8, q4 = (lane & 15) >> 2;
#pragma unroll
    for (int dir = 0; dir < 2; ++dir) {
        const int tbd = dir ? 1 - tb : tb; const int tpos = 32 * tbd + r32; const int ttok = dir ? 63 - tpos : tpos;
        const float Mt = ((LAS float*)(L + SM))[dir * 64 + tpos], bt = ((LAS float*)(L + SB))[dir * 64 + tpos], mst = ((LAS float*)(L + SMST))[dir];
        float nq = 0.f;
#pragma unroll
        for (int ks = 0; ks < 2; ++ks) { const LAS float* np = (LAS float*)(L + SN) + dir * 32 + 16 * ks + 8 * hh;
#pragma unroll
            for (int jj = 0; jj < 8; ++jj) nq += bf2f((bf16_t)qf[dir][ks][jj]) * np[jj]; }
        nq = xor32_sum(nq);
        const float at = __expf(mst - Mt) * QS;
        f32x16 o;
#pragma unroll
        for (int i = 0; i < 16; ++i) o[i] = 0.f;
#pragma unroll
        for (int ks = 0; ks < 2; ++ks) { const bf16x8 cf = *(const LAS bf16x8*)(L + CT + dir * 5120 + (32 * eb + r32) * 80 + (16 * ks + 8 * hh) * 2); o = MFMA32(cf, qf[dir][ks], o); }
#pragma unroll
        for (int i = 0; i < 16; ++i) o[i] *= at;
        float rs = 0.f;
#pragma unroll
        for (int sb = 0; sb < 2; ++sb) {
            if (sb <= tbd) {
                const int srow = 32 * sb + r32; const int stok = dir ? 63 - srow : srow;
                f32x16 s;
#pragma unroll
                for (int i = 0; i < 16; ++i) s[i] = 0.f;
#pragma unroll
                for (int ks = 0; ks < 2; ++ks) { const bf16x8 kf = *(const LAS bf16x8*)(L + KT + stok * 80 + (16 * ks + 8 * hh) * 2); s = MFMA32(kf, qf[dir][ks], s); }
#pragma unroll
                for (int g = 0; g < 4; ++g) { const f32x4 uv = *(const LAS f32x4*)((LAS float*)(L + SU) + dir * 64 + 32 * sb + 8 * g + 4 * hh);
#pragma unroll
                    for (int c = 0; c < 4; ++c) { const int spos = 32 * sb + 8 * g + 4 * hh + c; const float w = spos <= tpos ? __expf(uv[c] - Mt) * QS : 0.f; const float sw = s[4 * g + c] * w; s[4 * g + c] = sw; rs += sw; } }
#pragma unroll
                for (int s2 = 0; s2 < 2; ++s2) {
                    u32x4 pw = {cvtpk(s[8 * s2], s[8 * s2 + 1]), cvtpk(s[8 * s2 + 2], s[8 * s2 + 3]), cvtpk(s[8 * s2 + 4], s[8 * s2 + 5]), cvtpk(s[8 * s2 + 6], s[8 * s2 + 7])};
                    const bf16x8 pf = __builtin_bit_cast(bf16x8, pw);
                    const int p0 = 32 * sb + 16 * s2 + 4 * hh + q4, p1 = p0 + 8; const int t0 = dir ? 63 - p0 : p0, t1 = dir ? 63 - p1 : p1;
                    const v4i16_t lo = vtr(L + VT + eb * 4096 + t0 * 64 + trcol), hi = vtr(L + VT + eb * 4096 + t1 * 64 + trcol);
                    const bf16x8 va = {lo[0], lo[1], lo[2], lo[3], hi[0], hi[1], hi[2], hi[3]};
                    o = MFMA32(va, pf, o);
                }
            }
        }
        rs = xor32_sum(rs);
        const float den = (at * nq) + rs; const float idn = 1.f / fmaxf(fabsf(den), __expf(-(bt + Mt)));
        LAS float* hp = (LAS float*)(L + HB) + ttok * 65 + 32 * eb;
        if (dir == 0) {
#pragma unroll
            for (int i = 0; i < 16; ++i) hp[crow(i, hh)] = o[i] * idn;
        } else {
#pragma unroll
            for (int i = 0; i < 16; ++i) hp[crow(i, hh)] += o[i] * idn;
        }
    }
    __syncthreads();
    { const int t = htid >> 2, e0 = (htid & 3) * 16; const float* out_norm = F.in[I_OUTNORM] + l * 256 + h * 64 + e0; float hv[16]; float ss = 0.f;
      const LAS float* hb = (LAS float*)(L + HB) + t * 65 + e0;
#pragma unroll
      for (int i = 0; i < 16; ++i) { hv[i] = hb[i]; ss += hv[i] * hv[i]; }
      ss += dpp_f<0xB1>(ss); ss += dpp_f<0x4E>(ss);
      const float rstd = rsqrtf(ss * (1.f / 64.f) + EPS);
      const unsigned ogw[8] = {og0.x, og0.y, og0.z, og0.w, og1.x, og1.y, og1.z, og1.w};
      unsigned ow[8];
#pragma unroll
      for (int i = 0; i < 8; ++i) { const float g0 = __uint_as_float(ogw[i] << 16), g1 = __uint_as_float(ogw[i] & 0xffff0000u);
          const float r0 = hv[2 * i] * rstd * out_norm[2 * i] * __builtin_amdgcn_rcpf(1.f + __expf(-g0)), r1 = hv[2 * i + 1] * rstd * out_norm[2 * i + 1] * __builtin_amdgcn_rcpf(1.f + __expf(-g1));
          ow[i] = cvtpk(r0, r1); }
      u32x4 w0 = {ow[0], ow[1], ow[2], ow[3]}, w1 = {ow[4], ow[5], ow[6], ow[7]};
      bf16_t* yp = F_Y + (size_t)(rbase + t) * D + h * 64 + e0; *(u32x4*)yp = w0; *(u32x4*)(yp + 8) = w1; }
    __syncthreads();
}

__device__ __forceinline__ void attn_dispatch(Frame& F, int l, int idx) {
    constexpr float LOG2E = 1.4426950408889634f;
    if (idx < 384) { const int bh6 = idx >> 4, qb = idx & 15; const int b = bh6 / 6, h = bh6 % 6; const size_t bh = (size_t)bh6;
        attn_unit256<96, false, false>(F, F_QB + (bh * TS + TC + 256 * qb) * 96, F_KB + bh * TS * 96, F_VB + bh * TS * 64, MLA_NP, 0, 0.f, F_Y + (size_t)(b * T + 256 * qb) * D + 256 + h * 64); return; }
    idx -= 384;
    if (idx < 384) { const int bh6 = idx >> 4, qb = idx & 15; const int b = bh6 / 6, hq = bh6 % 6; const int kvh = hq / 3; const size_t bk = (size_t)b * 2 + kvh;
        attn_unit256<64, true, true>(F, F_QC + ((size_t)bh6 * TS + TC + 256 * qb) * 64, F_KC + bk * TS * 64, F_VC + bk * TS * 64, 6, 256 * qb, F.in[I_SINK][l * 6 + hq] * LOG2E, F_Y + (size_t)(b * T + 256 * qb) * D + 640 + hq * 64); return; }
    idx -= 384;
    if (idx < 24) { const int b = idx / 6, h = idx % 6; const size_t bh = (size_t)idx;
        attn_unit256<96, false, false>(F, F_QB + (bh * TS) * 96, F_KB + bh * TS * 96, F_VB + bh * TS * 64, 2, 0, 0.f, F_Y + (size_t)(ML + b * TC) * D + 256 + h * 64); return; }
    idx -= 24;
    { const int b = idx / 6, hq = idx % 6; const int kvh = hq / 3; const size_t bk = (size_t)b * 2 + kvh;
        attn_unit256<64, false, true>(F, F_QC + ((size_t)idx * TS) * 64, F_KC + bk * TS * 64, F_VC + bk * TS * 64, 2, 0, F.in[I_SINK][l * 6 + hq] * LOG2E, F_Y + (size_t)(ML + b * TC) * D + 640 + hq * 64); }
}
constexpr int CW_Q = 8192;
__device__ __forceinline__ void mix_unit(Frame& F, int l, int x, int li) {
    int idx; bool m3 = false; const int b = x >> 1, kvh = x & 1;
    if (li < 48) idx = (x + 8 * (li >> 4)) * 16 + (li & 15);
    else if (li < 96) { const int r = li - 48; idx = 384 + (b * 6 + kvh * 3 + (r >> 4)) * 16 + (r & 15); }
    else if (li < 160) { m3 = true; idx = x * 128 + 2 * (li - 96); }
    else if (li < 164) { m3 = true; idx = 1024 + x * 8 + 2 * (li - 160); }
    else if (li < 167) idx = 768 + x + 8 * (li - 164);
    else idx = 792 + b * 6 + kvh * 3 + (li - 167);
    if (m3) mlstm_m3_mfma(F, l, idx); else attn_dispatch(F, l, idx);
}
__device__ __forceinline__ void ph_mixers(Frame& F, int l, int rep) {
    OPAQUE_TID(F);
    const bool need_ctx = l + 1 < DEPTH;
    const int nloc = 160 + (need_ctx ? 10 : 0);
    unsigned* ctr0 = (unsigned*)(F.ws + WS_CTL) + CW_Q + 64 * 8 * (l + 2 * rep);
    volatile LAS int* slot = (volatile LAS int*)(F.lds + MISC_OFF + 64);
    const int x0 = (int)(xb_xcc_id() & 7u);
    for (int xs = 0; xs < 8; ++xs) {
        const int x = (x0 + xs) & 7;
        for (;;) {
            if (F.tid == 0) slot[0] = (int)__hip_atomic_fetch_add(ctr0 + 64 * x, 1u, __ATOMIC_RELAXED, __HIP_MEMORY_SCOPE_AGENT);
            __syncthreads();
            const int li = slot[0];
            __syncthreads();
            if (li >= nloc) break;
            mix_unit(F, l, x, li);
        }
    }
}

__global__ void __launch_bounds__(512, 2) fwd_mk(Args args) {
    extern __shared__ __attribute__((aligned(16))) unsigned char lds[];
    Frame F;
    F.lds = (LAS unsigned char*)lds;
    volatile LAS unsigned* MISC = (volatile LAS unsigned*)(F.lds + MISC_OFF);
    F.tid = threadIdx.x; F.lane = F.tid & 63; F.wave = __builtin_amdgcn_readfirstlane(F.tid >> 6);
    F.G = gridDim.x; { const int bx = blockIdx.x; F.vcu = (F.G % 8 == 0) ? (bx % 8) * (F.G / 8) + bx / 8 : bx; }
    F.in = args.in; F.out = args.out; F.ws = args.ws; unsigned char* ws = args.ws;
    for (int u = F.tid; u < (LDS_BYTES - LDSCTL_OFF) / 4; u += 512) ((LAS unsigned*)(F.lds + LDSCTL_OFF))[u] = 0u;
    __syncthreads();
    gu32* ctl = (gu32*)(ws + WS_CTL);
    XcdBarrier bar; bar.bar = (unsigned*)(ctl + CW_BAR); bar.x = 0; bar.st = nullptr;
    if (MK_N_LAUNCHES == 1) bar = xcd_barrier_post((unsigned*)(ctl + CW_BAR), MISC + 8);

    const int lo = args.ph_lo, hi = args.ph_hi;
    int rep = 0;
    for (int ph = lo; ph < hi; ++ph) {
        {
        int cv_l0 = 0, cv_r0 = 0, cv_n0 = 0, cv_nt = 0, cv_gw = 0, cv_ngw = 1;
        if (ph == 0) { p0_prologue(F);
            if (F.G == 256 && F.vcu >= 64) { cv_n0 = CV_P0; cv_nt = CV_P0; cv_gw = (F.vcu - 64) * 8 + F.wave; cv_ngw = 192 * 8; } }
        else {
            const int l = (ph - 1) / 13, sp = (ph - 1) % 13;
            const float* modl = F_MOD + (size_t)l * 5 * 9 * D;
            const bool first = (l == 0 && sp <= 2);
            const float* xl = first ? F.in[I_X] : F.out;
            const int Mrows = (l + 1 == DEPTH && sp >= 9) ? ML : M;
            float* slabD = (float*)(F.ws + WS_QUP); float* slabO = (float*)(F.ws + WS_QUP + 34 * MiB);
            switch (sp) {
            case 0: case 3: case 10: {
                int npend = 0; const float* pg = F_MOD; float pc = 0.f; const float* sl = slabD;
                if (sp == 0 && l > 0) { npend = 11; pg = modp(F_MOD, l - 1, 4, 8); pc = 0.5f; }
                if (sp == 3) { npend = 11; pg = modp(F_MOD, l, 4, 2); pc = 0.5f; }
                if (sp == 10 && Mrows == M) { npend = 4; pg = modp(F_MOD, l, 4, 5); pc = 1.0f; sl = slabO; }
                ph_modulate(F, xl, l, sp == 0 ? 0 : (sp == 3 ? 1 : 2), Mrows, rep ? 0 : npend, sl, pg, pc);
                if (l == 0 && sp == 0) {
                    static_assert(DEPTH == 2, "conversion lists");
                    const bool hosted = (F.G == 256); cv_r0 = hosted ? CV_P0 : 0; cv_n0 = hosted ? CV_NA - CV_P0 : CV_NA + CV_NB; cv_nt = hosted ? CV_NA - CV_P0 : 2 * (CV_NA + CV_NB); cv_gw = F.vcu * 8 + F.wave; cv_ngw = F.G * 8; } } break;
            case 1: case 11: {
                pg8::Gemm g{F_XN, F.wl(l, sp == 1 ? W_1I : W_2I), Mrows, 2 * DFF, D}; pg8::StaticOrder S; S.init(Mrows, 2 * DFF, F.G, (int)blockIdx.x, D);
                EpiSwiglu E{F_HID};
                #ifdef UP_SP2_OFF
                pg8::gemm_phase<EpiSwiglu, pg8::StaticOrder, true, false>(F.lds + RING_OFF, g, S, E);
#elif defined(UP_ALIGN_OFF)
                pg8::gemm_phase<EpiSwiglu, pg8::StaticOrder, false, true>(F.lds + RING_OFF, g, S, E);
#else
                pg8::gemm_phase<EpiSwiglu, pg8::StaticOrder, true, true>(F.lds + RING_OFF, g, S, E);
#endif
                } break;
            case 2: case 12: case 9: {
                const bool isout = sp == 9; const int K = isout ? D : DFF;
                pg8::Gemm g{isout ? F_Y : F_HID, F.wl(l, isout ? W_OUT : (sp == 2 ? W_1O : W_2O)), Mrows, D, K}; pg8::SplitOrder S; S.init(D, K, F.G, (int)blockIdx.x, Mrows == M ? (isout ? 4 : 11) : 0);
                EpiResid E{xl, F.out, isout ? slabO : slabD, modl, isout ? 5 : (sp == 2 ? 2 : 8), isout ? 1.0f : 0.5f};
#ifdef PROBE_DUP
                if (rep == 0 && sp == PROBE_DUP) E.coef = 0.f;
#endif
                pg8::gemm_phase<EpiResid, pg8::SplitOrder, true, true>(F.lds + RING_OFF, g, S, E); } break;
            case 4: {
                const bool split = (F.G == 256); const int Gg = split ? 184 : F.G;
                if ((int)blockIdx.x >= Gg) { cv_l0 = l; cv_r0 = CV_NA; cv_n0 = CV_NB; cv_nt = CV_NB + (l + 1 < DEPTH ? CV_NA : 0); cv_gw = ((int)blockIdx.x - Gg) * 8 + F.wave; cv_ngw = (F.G - Gg) * 8; break; }
                pg8::Gemm g{F_XN, F.wl(l, W_IN), M, 2048, D}; pg8::StaticOrder S; S.init(M, 2048, Gg, (int)blockIdx.x, D);
                EpiInproj E{F_P16A, F_G32, F_P16B};
                pg8::gemm_phase<EpiInproj, pg8::StaticOrder, true, true>(F.lds + RING_OFF, g, S, E); } break;
            case 5: {
#pragma unroll 1
                for (int s_ = 0; s_ < 2; ++s_) { if (((s_ ^ F.vcu) & 1) == 0) ph_prepA(F, l); else ph_mlstm_m1b(F, l); __syncthreads(); }
                } break;
            case 6: {
                const int Gg = (F.G == 256) ? 204 : F.G;
                if ((int)blockIdx.x >= Gg) { ph_mlstm_m2<3>(F, (int)blockIdx.x - Gg, F.G - Gg); break; }
                pg8::Gemm g{F_CKN, F.wl(l, W_UP), M, 1536, 384}; pg8::UpOrder S; S.init(Gg, (int)blockIdx.x);
                EpiUp E{F_QUP, F_KVUP, F_VB};
                pg8::gemm_phase<EpiUp, pg8::UpOrder, true, true>(F.lds + RING_OFF, g, S, E); } break;
            case 7: { if (F.G != 256) ph_mlstm_m2<1>(F, F.vcu, F.G); ph_prepB(F, l);
#ifdef PROBE_PREPB2
                __syncthreads(); ph_prepB(F, l);
#endif
                } break;
            case 8: { ph_mixers(F, l, rep); } break;
            default: break;
            }
        }
        if (cv_nt > 0) { __syncthreads(); p0_weights(F, cv_l0, cv_r0, cv_n0, cv_nt, cv_gw, cv_ngw); }
        }
#ifdef PROBE_DUP
        if (rep == 0 && ((ph > 0 && (ph - 1) % 13 == PROBE_DUP) || (ph == 0 && PROBE_DUP == 100))) { rep = 1; --ph; xcd_barrier(bar); continue; }
        rep = 0;
#endif
        if (ph + 1 < hi) xcd_barrier(bar);
    }
}

extern "C" void kernel_launch(void* const* d_in, const int* in_sizes, int n_in, void* d_out, int out_size, void* d_ws, size_t ws_size, hipStream_t stream) {
    static int grid = 0;
    if (grid == 0) {
        if (n_in != 24 || ws_size < WS_END) { fprintf(stderr, "kernel_launch: unexpected n_in %d or ws_size %zu (< %zu)\n", n_in, ws_size, (size_t)WS_END); grid = -1; return; }
        int dev = 0, cus = 0, per_cu = 0;
        if (hipGetDevice(&dev) != hipSuccess || hipDeviceGetAttribute(&cus, hipDeviceAttributeMultiprocessorCount, dev) != hipSuccess) { grid = -1; return; }
        if (hipFuncSetAttribute((const void*)fwd_mk, hipFuncAttributeMaxDynamicSharedMemorySize, LDS_BYTES) != hipSuccess) { fprintf(stderr, "kernel_launch: hipFuncSetAttribute failed\n"); grid = -1; return; }
        if (hipOccupancyMaxActiveBlocksPerMultiprocessor(&per_cu, (const void*)fwd_mk, 512, LDS_BYTES) != hipSuccess || per_cu < 1) fprintf(stderr, "kernel_launch: occupancy query says %d per CU\n", per_cu);
        (void)hipGetLastError();
        grid = cus;
    }
    if (grid < 0) return;
    (void)hipMemsetAsync((char*)d_ws + WS_CTL, 0, CTL_ZERO_BYTES, stream);
    Args a{};
    for (int i = 0; i < 24; ++i) a.in[i] = (const float*)d_in[i];
    a.out = (float*)d_out; a.ws = (unsigned char*)d_ws;
#if MK_N_LAUNCHES == 1
    a.ph_lo = 0; a.ph_hi = NPH;
    hipLaunchKernelGGL(fwd_mk, dim3(grid), dim3(512), LDS_BYTES, stream, a);
#else
    for (int p = 0; p < NPH; ++p) { a.ph_lo = p; a.ph_hi = p + 1; hipLaunchKernelGGL(fwd_mk, dim3(grid), dim3(512), LDS_BYTES, stream, a); }
#endif
}
```
